# Optimizing an MI355X kernel written in HIP

```python
import math
import jax, jax.numpy as jnp
from jax import lax
import numpy as np

D_MODEL = 1024
BATCH = 8
SEQ = 4096
DEPTH = 2

GRID_W = 64
CTX_LEN = 256
N_EVEN = (DEPTH + 1) // 2
N_ODD = DEPTH // 2
DN_ALPHA = (2 * DEPTH) ** 0.25
DN_BETA = (8 * DEPTH) ** -0.25
LN_EPS = 1e-5
F32 = jnp.float32

GLA_HEADS = 4
GLA_DK = 64
GLA_DV = 128
GLA_QK = GLA_HEADS * GLA_DK
GLA_V = GLA_HEADS * GLA_DV
GLA_GATE_RANK = 16
GLA_GATE_NORM = 16.0
CHUNK = 64
HG_HEADS = 4
HG_EXPAND = 128
HG_W = HG_HEADS * HG_EXPAND
EVEN_COLS = (GLA_QK, GLA_QK, GLA_V, GLA_V, GLA_GATE_RANK, GLA_GATE_RANK, HG_W, HG_W, HG_W, HG_W, HG_W)
EVEN_WIDTH = sum(EVEN_COLS)
HY_CH = 512
HY_ORDER = 2
HY_WIDTH = (HY_ORDER + 1) * HY_CH
HY_SHORT = 3
HY_EMB = 33
HY_FILTER_HIDDEN = 64
HY_FAST_DECAY = 0.3
HY_SLOW_DECAY = 1.5
HY_TARGET = 1e-2
RW_HEADS = 8
RW_HEAD_DIM = 64
RW_W = RW_HEADS * RW_HEAD_DIM
RW_DECAY_LORA = 64
RW_AAA_LORA = 64
RW_GATE_LORA = 128
RW_GN_EPS = 64e-5
RW_COLS = (RW_W, RW_W, RW_W, RW_DECAY_LORA, RW_DECAY_LORA, RW_AAA_LORA, RW_GATE_LORA)
RW_WIDTH = sum(RW_COLS)
ODD_WIDTH = HY_WIDTH + RW_WIDTH
N_EXPERTS = 256
TOP_K = 8
N_GROUPS = 8
TOPK_GROUPS = 4
EXPERT_FF = 256
SHARED_FF = 256
ROUTED_SCALE = 2.5
MOE_BLOCK = 128

kernel_name = 'hybrid_gla_hgrn2_hyena_rwkv7_moe_dit'


def split_cols(t, sizes):
    return jnp.split(t, np.cumsum(sizes)[:-1].tolist(), axis=-1)


def layer_norm(x, g, b, eps=LN_EPS):
    xf = x.astype(F32)
    mu = xf.mean(-1, keepdims=True)
    var = jnp.square(xf - mu).mean(-1, keepdims=True)
    return ((xf - mu) * lax.rsqrt(var + eps)).astype(x.dtype) * g + b


def rms_norm(x, g, eps=1e-6):
    xf = x.astype(F32)
    return (xf * lax.rsqrt(jnp.mean(xf * xf, -1, keepdims=True) + eps)).astype(x.dtype) * g


def to_heads(t, n_heads):
    B, L, _ = t.shape
    return t.reshape(B, L, n_heads, -1).transpose(0, 2, 1, 3)


def from_heads(t):
    B, H, L, d = t.shape
    return t.transpose(0, 2, 1, 3).reshape(B, L, H * d)


def stack_dirs(t_fwd, t_bwd, axis):
    return jnp.stack([t_fwd, jnp.flip(t_bwd, axis)], 0)


def merge_dirs(o, axis):
    return o[0] + jnp.flip(o[1], axis)


def chunked_gated_recurrence(q, k, v, log_a, s0):
    L = q.shape[-2]
    nc = L // CHUNK

    def blocks(t):
        t = t.astype(F32)
        return jnp.moveaxis(t.reshape(t.shape[:-2] + (nc, CHUNK, t.shape[-1])), -3, 0)

    qc, kc, vc, ac = blocks(q), blocks(k), blocks(v), blocks(log_a)
    b = jnp.cumsum(ac, axis=-2)
    b_ref = b[..., CHUNK // 2:CHUNK // 2 + 1, :]
    b_last = b[..., -1:, :]
    scores = jnp.einsum('n...id,n...jd->n...ij', qc * jnp.exp(b - b_ref), kc * jnp.exp(b_ref - b))
    lower = jnp.tril(jnp.ones((CHUNK, CHUNK), bool))
    o_intra = jnp.einsum('n...ij,n...jv->n...iv', jnp.where(lower, scores, 0.0), vc)
    q_in = qc * jnp.exp(b)
    k_out = kc * jnp.exp(b_last - b)
    dec = jnp.exp(b_last[..., 0, :])

    def step(S, xs):
        q_t, k_t, v_t, d_t = xs
        o = jnp.einsum('...id,...dv->...iv', q_t, S)
        S = S * d_t[..., :, None] + jnp.einsum('...jd,...jv->...dv', k_t, v_t)
        return S, o

    S_fin, o_inter = lax.scan(step, s0.astype(F32), (q_in, k_out, vc, dec))
    o = jnp.moveaxis(o_intra + o_inter, 0, -3)
    return o.reshape(o.shape[:-3] + (L, o.shape[-1])), S_fin


def bidir_chunked(ctx_in, lat_in):
    def stacked(q, k_f, k_b, v, la_f, la_b):
        return (stack_dirs(q, q, -2), stack_dirs(k_f, k_b, -2), stack_dirs(v, v, -2), stack_dirs(la_f, la_b, -2))

    qc, kc, vc, lac = stacked(*ctx_in)
    s0 = jnp.zeros(kc.shape[:-2] + (kc.shape[-1], vc.shape[-1]), F32)
    o_c, s_c = chunked_gated_recurrence(qc, kc, vc, lac, s0)
    o_l, _ = chunked_gated_recurrence(*stacked(*lat_in), s_c)
    return merge_dirs(o_c, -2), merge_dirs(o_l, -2)


def gla_hgrn_mixer(h, hc, w_in, w_out, gate_w2, gate_b, gla_g, lb, hg_g):
    def prep(hh):
        q, k, v, r, a_f, a_b, hq, hf_f, hf_b, hi, hgate = split_cols(hh @ w_in, EVEN_COLS)
        la = [jax.nn.log_sigmoid((a @ gate_w2[d] + gate_b[d]).astype(F32)) / GLA_GATE_NORM
              for d, a in enumerate((a_f, a_b))]
        gla = (to_heads(q * GLA_DK ** -0.5, GLA_HEADS), to_heads(k, GLA_HEADS), to_heads(k, GLA_HEADS),
               to_heads(v, GLA_HEADS), to_heads(la[0], GLA_HEADS), to_heads(la[1], GLA_HEADS))
        f = [lb[d] + (1.0 - lb[d]) * jax.nn.sigmoid(z.astype(F32)) for d, z in enumerate((hf_f, hf_b))]
        hg = (to_heads(jax.nn.silu(hq), HG_HEADS), to_heads(1.0 - f[0], HG_HEADS), to_heads(1.0 - f[1], HG_HEADS),
              to_heads(hi, HG_HEADS), to_heads(jnp.log(f[0]), HG_HEADS), to_heads(jnp.log(f[1]), HG_HEADS))
        return gla, hg, r, hgate

    gla_c, hg_c, r_c, gt_c = prep(hc)
    gla_l, hg_l, r_l, gt_l = prep(h)
    o_gla_c, o_gla_l = bidir_chunked(gla_c, gla_l)
    o_hg_c, o_hg_l = bidir_chunked(hg_c, hg_l)

    def readout(o_gla, o_hg, r, gt, dtype):
        y = jnp.concatenate([from_heads(rms_norm(o_gla, gla_g)) * jax.nn.silu(r),
                             from_heads(rms_norm(o_hg, hg_g)) * jax.nn.silu(gt)], -1)
        return (y @ w_out).astype(dtype)

    return readout(o_gla_l, o_hg_l, r_l, gt_l, h.dtype), readout(o_gla_c, o_hg_c, r_c, gt_c, hc.dtype)


def hyena_filters(L, w1, b1, w2, b2, w3, sin_freq):
    t = jnp.linspace(0.0, 1.0, L, dtype=F32)[:, None]
    bands = (HY_EMB - 1) // 2
    wpos = 2.0 * math.pi * jnp.arange(L, dtype=F32)[:, None] / L
    fr = jnp.linspace(1e-4, bands - 1, bands, dtype=F32)[None, :]
    z = jnp.concatenate([t, jnp.cos(fr * wpos), -jnp.sin(fr * wpos)], -1)
    hdn = jnp.sin(sin_freq[0] * (z @ w1 + b1))
    hdn = jnp.sin(sin_freq[1] * (hdn @ w2 + b2))
    filt = (hdn @ w3).reshape(L, HY_ORDER, 2, HY_CH)
    max_decay = math.log(HY_TARGET) / HY_FAST_DECAY
    min_decay = math.log(HY_TARGET) / HY_SLOW_DECAY
    deltas = jnp.linspace(min_decay, max_decay, HY_CH, dtype=F32)
    window = jnp.exp(-t * jnp.abs(deltas))
    return filt * window[:, None, None, :]


def centred_long_conv(u, h_fwd, h_bwd):
    L = u.shape[1]
    filt_full = jnp.concatenate([h_fwd, jnp.zeros_like(h_fwd[:1]), jnp.flip(h_bwd[1:], 0)], 0)
    uf = jnp.fft.rfft(u.astype(F32), n=2 * L, axis=1)
    ff = jnp.fft.rfft(filt_full.astype(F32), n=2 * L, axis=0)
    return jnp.fft.irfft(uf * ff[None], n=2 * L, axis=1)[:, :L].astype(u.dtype)


def hyena(P, conv_w, conv_b, f_w1, f_b1, f_w2, f_b2, f_w3, sin_freq, hy_bias):
    L = P.shape[1]
    u = lax.conv_general_dilated(P, conv_w[:, None, :], window_strides=(1,),
                                 padding=[(HY_SHORT // 2, HY_SHORT // 2)],
                                 dimension_numbers=('NWC', 'WIO', 'NWC'),
                                 feature_group_count=HY_WIDTH) + conv_b
    v, x1, x2 = jnp.split(u, HY_ORDER + 1, axis=-1)
    filt = hyena_filters(L, f_w1, f_b1, f_w2, f_b2, f_w3, sin_freq)
    z = v
    for n, gate in enumerate((x1, x2)):
        z = gate * (centred_long_conv(z, filt[:, n, 0], filt[:, n, 1]) + z * hy_bias[n])
    return z


def grid_shift(t):
    B, L, C = t.shape
    rows = L // GRID_W
    g = jnp.pad(t.reshape(B, rows, GRID_W, C), ((0, 0), (1, 1), (1, 1), (0, 0)))
    g = g.reshape(B, rows + 2, GRID_W + 2, C // 4, 4)
    out = jnp.stack([g[:, 1:-1, :-2, :, 0], g[:, 1:-1, 2:, :, 1],
                     g[:, :-2, 1:-1, :, 2], g[:, 2:, 1:-1, :, 3]], -1)
    return out.reshape(B, L, C)


def seq_shift(t):
    B, L, C = t.shape
    p = jnp.pad(t, ((0, 0), (1, 1), (0, 0))).reshape(B, L + 2, C // 2, 2)
    return jnp.stack([p[:, :-2, :, 0], p[:, 2:, :, 1]], -1).reshape(B, L, C)


def rwkv_streams(P, shift_fn, mu, w0, w2, a0, a2, g2, k_k, k_a):
    P = P + mu * (shift_fn(P) - P)
    r, k, v, wl_f, wl_b, al, gl = split_cols(P, RW_COLS)

    def heads(t):
        return t.reshape(t.shape[:-1] + (RW_HEADS, RW_HEAD_DIM))

    def log_decay(wl, d):
        w = -jax.nn.softplus(-(w0[d] + jnp.tanh(wl) @ w2[d]).astype(F32)) - 0.5
        return heads(-jnp.exp(w))

    a = jax.nn.sigmoid(a0 + al @ a2)
    g = jax.nn.sigmoid(gl) @ g2
    kk = heads(k * k_k).astype(F32)
    kk = kk / jnp.maximum(jnp.linalg.norm(kk, axis=-1, keepdims=True), 1e-12)
    k = k * (1.0 + (a - 1.0) * k_a)
    return (heads(r), heads(k), heads(v), kk, heads(a), g, log_decay(wl_f, 0), log_decay(wl_b, 1))


def rwkv_bidir_scan(st, s0, emit):
    r, k, v, kk, a, g, ld_f, ld_b = st

    def tm(t_f, t_b=None):
        t_b = t_f if t_b is None else t_b
        return jnp.moveaxis(stack_dirs(t_f, t_b, 1), 2, 0).astype(F32)

    xs = (tm(jnp.exp(ld_f), jnp.exp(ld_b)), tm(k), tm(v), tm(kk), tm(kk * a)) + ((tm(r),) if emit else ())

    def step(S, xt):
        d_t, k_t, v_t, kk_t, b_t = xt[:5]
        S = (S * d_t[..., None, :]
             - jnp.einsum('...vk,...k->...v', S, kk_t)[..., None] * b_t[..., None, :]
             + v_t[..., :, None] * k_t[..., None, :])
        return S, (jnp.einsum('...vk,...k->...v', S, xt[5]) if emit else None)

    S, o = lax.scan(step, s0, xs)
    if emit:
        o = merge_dirs(jnp.moveaxis(o, 0, 2), 1)
    return S, o


def rwkv_readout(o, st, r_k, ln_g, ln_b):
    r, k, v, kk, a, g, _, _ = st
    B, L = o.shape[:2]
    on = layer_norm(o, ln_g, ln_b, RW_GN_EPS)
    bonus = jnp.sum(r * k * r_k, -1, keepdims=True) * v
    return (on + bonus).reshape(B, L, RW_W) * g


def hyena_rwkv_mixer(h, hc, need_ctx_out, w_in, w_out, conv_w, conv_b, f_w1, f_b1, f_w2, f_b2, f_w3,
                     sin_freq, hy_bias, mu, w0, w2, a0, a2, g2, k_k, k_a, r_k, ln_g, ln_b):
    w_hy, w_rw = w_in[:, :HY_WIDTH], w_in[:, HY_WIDTH:]
    rw_args = (mu, w0, w2, a0, a2, g2, k_k, k_a)
    st_c = rwkv_streams(hc @ w_rw, seq_shift, *rw_args)
    st_l = rwkv_streams(h @ w_rw, grid_shift, *rw_args)
    s0 = jnp.zeros((2, h.shape[0], RW_HEADS, RW_HEAD_DIM, RW_HEAD_DIM), F32)
    s_c, o_c = rwkv_bidir_scan(st_c, s0, need_ctx_out)
    _, o_l = rwkv_bidir_scan(st_l, s_c, True)
    hy_args = (conv_w, conv_b, f_w1, f_b1, f_w2, f_b2, f_w3, sin_freq, hy_bias)

    def readout(hh, st, o):
        y = jnp.concatenate([hyena(hh @ w_hy, *hy_args), rwkv_readout(o, st, r_k, ln_g, ln_b)], -1)
        return (y @ w_out).astype(hh.dtype)

    y_c = readout(hc, st_c, o_c) if need_ctx_out else None
    return readout(h, st_l, o_l), y_c


def routed_experts(u, eidx, gate, w13, w2):
    T, D = u.shape
    N = T * TOP_K
    flat_e = eidx.reshape(N)
    order = jnp.argsort(flat_e)
    sorted_e = flat_e[order]
    counts = jnp.bincount(flat_e, length=N_EXPERTS)
    padded = (counts + MOE_BLOCK - 1) // MOE_BLOCK * MOE_BLOCK
    pad_end = jnp.cumsum(padded)
    pad_start = pad_end - padded
    cnt_start = jnp.cumsum(counts) - counts
    dest = pad_start[sorted_e] + jnp.arange(N) - cnt_start[sorted_e]
    n_blocks = -(-N // MOE_BLOCK) + N_EXPERTS
    slot_tok = jnp.full((n_blocks * MOE_BLOCK,), T, jnp.int32).at[dest].set((order // TOP_K).astype(jnp.int32))
    slot_gate = jnp.zeros((n_blocks * MOE_BLOCK,), u.dtype).at[dest].set(gate.reshape(N)[order])
    blk_exp = jnp.minimum(jnp.searchsorted(pad_end, jnp.arange(n_blocks) * MOE_BLOCK, side='right'), N_EXPERTS - 1)
    u_pad = jnp.concatenate([u, jnp.zeros((1, D), u.dtype)], 0)

    def body(acc, xs):
        tok, gt, e = xs
        h13 = u_pad[tok] @ w13[e]
        yb = (jax.nn.silu(h13[:, :EXPERT_FF]) * h13[:, EXPERT_FF:]) @ w2[e]
        return acc.at[tok].add(yb * gt[:, None]), None

    acc, _ = lax.scan(body, jnp.zeros((T + 1, D), u.dtype),
                      (slot_tok.reshape(n_blocks, MOE_BLOCK), slot_gate.reshape(n_blocks, MOE_BLOCK), blk_exp))
    return acc[:T]


def moe(u, router_w, router_bias, exp_w13, exp_w2, sh_w13, sh_w2):
    T = u.shape[0]
    per_group = N_EXPERTS // N_GROUPS
    scores = jax.nn.sigmoid((u @ router_w).astype(F32))
    sel = scores + router_bias.astype(F32)
    grp_score = lax.top_k(sel.reshape(T, N_GROUPS, per_group), 2)[0].sum(-1)
    _, grp_idx = lax.top_k(grp_score, TOPK_GROUPS)
    grp_mask = jax.nn.one_hot(grp_idx, N_GROUPS, dtype=F32).sum(1) > 0
    sel = jnp.where(jnp.repeat(grp_mask, per_group, axis=1), sel, -jnp.inf)
    _, eidx = lax.top_k(sel, TOP_K)
    gate = jnp.take_along_axis(scores, eidx, 1)
    gate = gate / gate.sum(-1, keepdims=True) * ROUTED_SCALE
    routed = routed_experts(u, eidx, gate.astype(u.dtype), exp_w13, exp_w2)
    hs = u @ sh_w13
    shared = (jax.nn.silu(hs[:, :SHARED_FF]) * hs[:, SHARED_FF:]) @ sh_w2
    return routed + shared


def setup_inputs(seed: int = 0) -> dict:
    key = jax.random.key(seed)
    ks = iter(jax.random.split(key, 64))
    D = D_MODEL

    def nrm(shape, scale):
        return jax.random.normal(next(ks), shape, jnp.float32) * scale

    def gain(shape):
        return 1.0 + nrm(shape, 0.02)

    return {
        'x': nrm((BATCH, SEQ, D), 1.0),
        'c': nrm((BATCH, D), 1.0),
        'ctx': nrm((BATCH, CTX_LEN, D), 1.0),
        'c_ctx': nrm((D,), 1.0),
        'mod_w': nrm((DEPTH, D, 6 * D), 0.5 * D ** -0.5),
        'mod_b': nrm((DEPTH, 6 * D), 0.02),
        'ln1_g': gain((DEPTH, D)),
        'ln1_b': nrm((DEPTH, D), 0.02),
        'ln2_g': gain((DEPTH, D)),
        'ln2_b': nrm((DEPTH, D), 0.02),
        'ev_w_in': nrm((N_EVEN, D, EVEN_WIDTH), D ** -0.5),
        'ev_w_out': nrm((N_EVEN, GLA_V + HG_W, D), (GLA_V + HG_W) ** -0.5 * DN_BETA),
        'gla_gate_w2': nrm((N_EVEN, 2, GLA_GATE_RANK, GLA_QK), GLA_GATE_RANK ** -0.5),
        'gla_gate_b': nrm((N_EVEN, 2, GLA_QK), 0.1),
        'gla_norm_g': gain((N_EVEN, GLA_DV)),
        'hg_lb_logits': nrm((N_EVEN + 1, 2, HG_W), 0.1),
        'hg_norm_g': gain((N_EVEN, HG_EXPAND)),
        'od_w_in': nrm((N_ODD, D, ODD_WIDTH), D ** -0.5),
        'od_w_out': nrm((N_ODD, HY_CH + RW_W, D), (HY_CH + RW_W) ** -0.5 * DN_BETA),
        'hy_conv_w': nrm((N_ODD, HY_SHORT, HY_WIDTH), HY_SHORT ** -0.5),
        'hy_conv_b': nrm((N_ODD, HY_WIDTH), 0.02),
        'hy_ffn_w1': nrm((N_ODD, HY_EMB, HY_FILTER_HIDDEN), HY_EMB ** -0.5),
        'hy_ffn_b1': nrm((N_ODD, HY_FILTER_HIDDEN), 0.02),
        'hy_ffn_w2': nrm((N_ODD, HY_FILTER_HIDDEN, HY_FILTER_HIDDEN), HY_FILTER_HIDDEN ** -0.5),
        'hy_ffn_b2': nrm((N_ODD, HY_FILTER_HIDDEN), 0.02),
        'hy_ffn_w3': nrm((N_ODD, HY_FILTER_HIDDEN, HY_ORDER * 2 * HY_CH), 0.1 * HY_FILTER_HIDDEN ** -0.5),
        'hy_sin_freq': 1.0 + nrm((N_ODD, 2, HY_FILTER_HIDDEN), 0.1),
        'hy_bias': nrm((N_ODD, HY_ORDER, HY_CH), 0.5),
        'rw_mu': jax.random.uniform(next(ks), (N_ODD, RW_WIDTH), jnp.float32),
        'rw_w0': jax.random.uniform(next(ks), (N_ODD, 2, RW_W), jnp.float32, -6.5, -1.5),
        'rw_w2': nrm((N_ODD, 2, RW_DECAY_LORA, RW_W), 0.1 * RW_DECAY_LORA ** -0.5),
        'rw_a0': nrm((N_ODD, RW_W), 0.1),
        'rw_a2': nrm((N_ODD, RW_AAA_LORA, RW_W), 0.1 * RW_AAA_LORA ** -0.5),
        'rw_g2': nrm((N_ODD, RW_GATE_LORA, RW_W), RW_GATE_LORA ** -0.5),
        'rw_k_k': 0.85 + nrm((N_ODD, RW_W), 0.05),
        'rw_k_a': 1.0 + nrm((N_ODD, RW_W), 0.05),
        'rw_r_k': nrm((N_ODD, RW_HEADS, RW_HEAD_DIM), 0.1),
        'rw_ln_g': gain((N_ODD, RW_HEADS, RW_HEAD_DIM)),
        'rw_ln_b': nrm((N_ODD, RW_HEADS, RW_HEAD_DIM), 0.02),
        'router_w': nrm((DEPTH, D, N_EXPERTS), D ** -0.5),
        'router_bias': nrm((DEPTH, N_EXPERTS), 0.01),
        'exp_w13': nrm((DEPTH, N_EXPERTS, D, 2 * EXPERT_FF), D ** -0.5),
        'exp_w2': nrm((DEPTH, N_EXPERTS, EXPERT_FF, D), EXPERT_FF ** -0.5 * DN_BETA),
        'sh_w13': nrm((DEPTH, D, 2 * SHARED_FF), D ** -0.5),
        'sh_w2': nrm((DEPTH, SHARED_FF, D), SHARED_FF ** -0.5 * DN_BETA),
    }


def reference(x, c, ctx, c_ctx, mod_w, mod_b, ln1_g, ln1_b, ln2_g, ln2_b,
              ev_w_in, ev_w_out, gla_gate_w2, gla_gate_b, gla_norm_g, hg_lb_logits, hg_norm_g,
              od_w_in, od_w_out, hy_conv_w, hy_conv_b, hy_ffn_w1, hy_ffn_b1, hy_ffn_w2, hy_ffn_b2,
              hy_ffn_w3, hy_sin_freq, hy_bias, rw_mu, rw_w0, rw_w2, rw_a0, rw_a2, rw_g2, rw_k_k,
              rw_k_a, rw_r_k, rw_ln_g, rw_ln_b, router_w, router_bias, exp_w13, exp_w2, sh_w13, sh_w2):
    B, L, D = x.shape
    Lc = ctx.shape[1]
    hg_lb = jnp.cumsum(jax.nn.softmax(hg_lb_logits.astype(F32), axis=0), axis=0)
    xl, xc = x, ctx
    for l in range(DEPTH):
        last = l == DEPTH - 1
        j = l // 2
        m = jax.nn.silu(c) @ mod_w[l] + mod_b[l]
        mc = jax.nn.silu(c_ctx) @ mod_w[l] + mod_b[l]
        sh1, sc1, g1, sh2, sc2, g2 = jnp.split(m[:, None, :], 6, -1)
        sh1c, sc1c, g1c, sh2c, sc2c, g2c = jnp.split(mc, 6, -1)
        h = xl * (1.0 + sc1) + sh1
        hc = xc * (1.0 + sc1c) + sh1c
        if l % 2 == 0:
            y, yc = gla_hgrn_mixer(h, hc, ev_w_in[j], ev_w_out[j], gla_gate_w2[j], gla_gate_b[j],
                                   gla_norm_g[j], hg_lb[j], hg_norm_g[j])
        else:
            y, yc = hyena_rwkv_mixer(h, hc, not last, od_w_in[j], od_w_out[j], hy_conv_w[j], hy_conv_b[j],
                                     hy_ffn_w1[j], hy_ffn_b1[j], hy_ffn_w2[j], hy_ffn_b2[j], hy_ffn_w3[j],
                                     hy_sin_freq[j], hy_bias[j], rw_mu[j], rw_w0[j], rw_w2[j], rw_a0[j],
                                     rw_a2[j], rw_g2[j], rw_k_k[j], rw_k_a[j], rw_r_k[j], rw_ln_g[j], rw_ln_b[j])
        xl = layer_norm(DN_ALPHA * xl + g1 * y, ln1_g[l], ln1_b[l])
        moe_p = (router_w[l], router_bias[l], exp_w13[l], exp_w2[l], sh_w13[l], sh_w2[l])
        u_l = xl * (1.0 + sc2) + sh2
        if last:
            mo_l = moe(u_l.reshape(B * L, D), *moe_p).reshape(B, L, D)
        else:
            xc = layer_norm(DN_ALPHA * xc + g1c * yc, ln1_g[l], ln1_b[l])
            u_c = xc * (1.0 + sc2c) + sh2c
            mo = moe(jnp.concatenate([u_c.reshape(B * Lc, D), u_l.reshape(B * L, D)], 0), *moe_p)
            mo_l = mo[B * Lc:].reshape(B, L, D)
            xc = layer_norm(DN_ALPHA * xc + g2c * mo[:B * Lc].reshape(B, Lc, D), ln2_g[l], ln2_b[l])
        xl = layer_norm(DN_ALPHA * xl + g2 * mo_l, ln2_g[l], ln2_b[l])
    return xl
```

```cpp
#include <hip/hip_runtime.h>
#include <stdint.h>
#include <stdio.h>
#include <string.h>

typedef unsigned short bf16_t;
typedef short bf16x8 __attribute__((ext_vector_type(8)));
typedef float f32x4 __attribute__((ext_vector_type(4)));
typedef unsigned u32x4 __attribute__((ext_vector_type(4)));
typedef unsigned u32x2 __attribute__((ext_vector_type(2)));

#define NTHR 512
#define DM 1024
#define NB 8
#define SEQ 4096
#define CTXL 256
#define NCTX (NB * CTXL)
#define NLAT (NB * SEQ)
#define NT (NCTX + NLAT)
#define EVW 4128
#define ODW 3392
#define MAXSLOT 378880
#define DN_ALPHA 1.41421356237f
#define NPHASE 40

struct Params {
    const float *x, *c, *ctx, *c_ctx, *mod_w, *mod_b, *ln1_g, *ln1_b, *ln2_g, *ln2_b;
    const float *ev_w_in, *ev_w_out, *gla_gate_w2, *gla_gate_b, *gla_norm_g, *hg_lb_logits, *hg_norm_g;
    const float *od_w_in, *od_w_out, *hy_conv_w, *hy_conv_b, *hy_ffn_w1, *hy_ffn_b1, *hy_ffn_w2, *hy_ffn_b2, *hy_ffn_w3, *hy_sin_freq, *hy_bias;
    const float *rw_mu, *rw_w0, *rw_w2, *rw_a0, *rw_a2, *rw_g2, *rw_k_k, *rw_k_a, *rw_r_k, *rw_ln_g, *rw_ln_b;
    const float *router_w, *router_bias, *exp_w13, *exp_w2, *sh_w13, *sh_w2;
    float* out;
    float* MOD;
    float* G;
    float* P;
    float* LA;
    float* O;
    bf16_t* Y;
    float* PRE;
    float* X1;
    bf16_t* U;
    float* LOGITS;
    int* EIDX; float* GATE; int* POS; int* TOKSLOT;
    int* CNT;
    int* META;
    int* TILE_E;
    int* SLOT_TOK; float* SLOT_GATE;
    bf16_t* ACT;
    bf16_t* YS;
    float* X2;
    float* UH;
    float* Z1;
    float *RR, *KP, *VV, *KK, *BV, *GT;
    float* DEC;
    unsigned* BAR;
};

typedef float f32x2_t __attribute__((ext_vector_type(2)));
typedef __bf16 bf16x2_t __attribute__((ext_vector_type(2)));
__device__ __forceinline__ unsigned pk2(float lo, float hi) { const f32x2_t v = {lo, hi}; return __builtin_bit_cast(unsigned, __builtin_convertvector(v, bf16x2_t)); }
__device__ __forceinline__ bf16x8 pack8(f32x4 a, f32x4 b) { u32x4 w; w.x = pk2(a[0], a[1]); w.y = pk2(a[2], a[3]); w.z = pk2(b[0], b[1]); w.w = pk2(b[2], b[3]); return __builtin_bit_cast(bf16x8, w); }
__device__ __forceinline__ float bf2f(bf16_t h) { return __uint_as_float((unsigned)h << 16); }
__device__ __forceinline__ bf16_t f2bf(float f) { return (bf16_t)(pk2(f, 0.f) & 0xffffu); }
__device__ __forceinline__ float sigmoid_f(float x) { return 1.f / (1.f + expf(-x)); }
__device__ __forceinline__ float silu_f(float x) { return x / (1.f + expf(-x)); }
__device__ __forceinline__ float logsigmoid_f(float x) { return x >= 0.f ? -log1pf(expf(-x)) : x - log1pf(expf(x)); }
__device__ __forceinline__ float wave_sum(float v) {
#pragma unroll
    for (int m = 32; m >= 1; m >>= 1) v += __shfl_xor(v, m);
    return v;
}
__device__ __forceinline__ float wave_max(float v) {
#pragma unroll
    for (int m = 32; m >= 1; m >>= 1) v = fmaxf(v, __shfl_xor(v, m));
    return v;
}
__device__ __forceinline__ int row_of(int dir, int b, int s) {
    if (s < CTXL) { const int pos = dir ? (CTXL - 1 - s) : s; return b * CTXL + pos; }
    const int q = s - CTXL; const int pos = dir ? (SEQ - 1 - q) : q; return NCTX + b * SEQ + pos;
}
__device__ __forceinline__ int row_mod(int r) { return r < NCTX ? 8 : ((r - NCTX) >> 12); }
__device__ __forceinline__ const float* xin_row(const Params& p, int layer, int r) {
    if (layer == 0) return r < NCTX ? p.ctx + (size_t)r * DM : p.x + (size_t)(r - NCTX) * DM;
    return p.X2 + (size_t)r * DM;
}

#define LSTR 40
template <class AL, class BL, class EP>
__device__ __forceinline__ void gemm_tile(const AL& al, const BL& bl, const EP& ep, const int K, unsigned char* lds) {
    bf16_t* As = (bf16_t*)lds;
    bf16_t* Bs = As + 256 * LSTR;
    const int tid = threadIdx.x, lane = tid & 63, w = tid >> 6, wm = w & 3, wn = w >> 2;
    const int ar0 = tid >> 2, akg = tid & 3;
    const int bn = tid & 127, bkg = tid >> 7;
    const typename AL::Row r0 = al.row(ar0), r1 = al.row(ar0 + 128);
    const typename BL::Col c0 = bl.col(bn);
    f32x4 acc[4][4];
#pragma unroll
    for (int i = 0; i < 4; ++i)
#pragma unroll
        for (int j = 0; j < 4; ++j) acc[i][j] = (f32x4){0.f, 0.f, 0.f, 0.f};
    bf16x8 ra0 = al.load(r0, akg * 8), ra1 = al.load(r1, akg * 8), rb = bl.load(c0, bkg * 8);
    for (int k0 = 0; k0 < K; k0 += 32) {
        __syncthreads();
        *(bf16x8*)(As + ar0 * LSTR + akg * 8) = ra0;
        *(bf16x8*)(As + (ar0 + 128) * LSTR + akg * 8) = ra1;
        *(bf16x8*)(Bs + bn * LSTR + bkg * 8) = rb;
        __syncthreads();
        if (k0 + 32 < K) { ra0 = al.load(r0, k0 + 32 + akg * 8); ra1 = al.load(r1, k0 + 32 + akg * 8); rb = bl.load(c0, k0 + 32 + bkg * 8); }
        bf16x8 af[4], bfr[4];
#pragma unroll
        for (int i = 0; i < 4; ++i) af[i] = *(const bf16x8*)(As + (wm * 64 + i * 16 + (lane & 15)) * LSTR + (lane >> 4) * 8);
#pragma unroll
        for (int j = 0; j < 4; ++j) bfr[j] = *(const bf16x8*)(Bs + (wn * 64 + j * 16 + (lane & 15)) * LSTR + (lane >> 4) * 8);
#pragma unroll
        for (int i = 0; i < 4; ++i)
#pragma unroll
            for (int j = 0; j < 4; ++j) acc[i][j] = __builtin_amdgcn_mfma_f32_16x16x32_bf16(bfr[j], af[i], acc[i][j], 0, 0, 0);
    }
    ep(acc, wm, wn, lane);
}
#define EP_ROW(i) (wm * 64 + (i) * 16 + (lane & 15))
#define EP_COL(j) (wn * 64 + (j) * 16 + (lane >> 4) * 4)

struct AModRow { const float* x; const float* sh; };
struct ALoadMod {
    const Params* p; int layer; int row0; int sec;
    typedef AModRow Row;
    __device__ __forceinline__ Row row(int r) const { const int g = row0 + r; Row R; R.x = xin_row(*p, layer, g); R.sh = p->MOD + ((size_t)layer * 9 + row_mod(g)) * 6144 + sec * 1024; return R; }
    __device__ __forceinline__ bf16x8 load(const Row& R, int k) const {
        const f32x4 x0 = *(const f32x4*)(R.x + k), x1 = *(const f32x4*)(R.x + k + 4);
        const f32x4 h0 = *(const f32x4*)(R.sh + k), h1 = *(const f32x4*)(R.sh + k + 4);
        const f32x4 s0 = *(const f32x4*)(R.sh + 1024 + k), s1 = *(const f32x4*)(R.sh + 1024 + k + 4);
        return pack8(x0 * (s0 + 1.f) + h0, x1 * (s1 + 1.f) + h1);
    }
};
struct ALoadBf {
    const bf16_t* A; int lda; int row0;
    typedef const bf16_t* Row;
    __device__ __forceinline__ Row row(int r) const { return A + (size_t)(row0 + r) * lda; }
    __device__ __forceinline__ bf16x8 load(Row R, int k) const { return *(const bf16x8*)(R + k); }
};
struct ALoadGather {
    const bf16_t* A; int lda; const int* idx;
    typedef const bf16_t* Row;
    __device__ __forceinline__ Row row(int r) const { return A + (size_t)idx[r] * lda; }
    __device__ __forceinline__ bf16x8 load(Row R, int k) const { return *(const bf16x8*)(R + k); }
};
__device__ __forceinline__ bf16x8 bload8(const float* c, int k, int ldb) {
    const float* q = c + (size_t)k * ldb;
    f32x4 a, b;
    a[0] = q[0]; a[1] = q[ldb]; a[2] = q[2 * ldb]; a[3] = q[3 * ldb];
    b[0] = q[4 * (size_t)ldb]; b[1] = q[5 * (size_t)ldb]; b[2] = q[6 * (size_t)ldb]; b[3] = q[7 * (size_t)ldb];
    return pack8(a, b);
}
struct BLoadF32 {
    const float* B; int ldb; int n0; int nvalid;
    typedef const float* Col;
    __device__ __forceinline__ Col col(int n) const { const int g = n0 + n; return g < nvalid ? B + g : nullptr; }
    __device__ __forceinline__ bf16x8 load(Col c, int k) const { if (!c) return (bf16x8){0, 0, 0, 0, 0, 0, 0, 0}; return bload8(c, k, ldb); }
};
struct BLoadW13 {
    const float* B; int nt;
    typedef const float* Col;
    __device__ __forceinline__ Col col(int n) const { const int wn = n >> 6, j = (n >> 4) & 3, c16 = n & 15; return B + (j >> 1) * 256 + nt * 64 + wn * 32 + (j & 1) * 16 + c16; }
    __device__ __forceinline__ bf16x8 load(Col c, int k) const { return bload8(c, k, 512); }
};

__device__ void phase_mod(const Params& p, unsigned char* lds) {
    float* sv = (float*)lds;
    float* red = sv + 9 * 1024;
    const int tid = threadIdx.x;
    for (int e = tid; e < 9 * 1024; e += NTHR) { const int j = e >> 10, k = e & 1023; const float v = j < 8 ? p.c[j * 1024 + k] : p.c_ctx[k]; sv[e] = silu_f(v); }
    __syncthreads();
    const int kg = tid >> 6, nl = tid & 63;
    for (int u = blockIdx.x; u < 192; u += gridDim.x) {
        const int l = u / 96, n0 = (u % 96) * 64;
        const float* W = p.mod_w + (size_t)l * 1024 * 6144 + n0 + nl;
        float acc[9];
#pragma unroll
        for (int j = 0; j < 9; ++j) acc[j] = 0.f;
        for (int k = kg; k < 1024; k += 8) {
            const float wv = W[(size_t)k * 6144];
#pragma unroll
            for (int j = 0; j < 9; ++j) acc[j] += sv[j * 1024 + k] * wv;
        }
#pragma unroll
        for (int j = 0; j < 9; ++j) red[(kg * 9 + j) * 64 + nl] = acc[j];
        __syncthreads();
        for (int e = tid; e < 576; e += NTHR) {
            const int j = e >> 6, n = e & 63; float s = 0.f;
#pragma unroll
            for (int g = 0; g < 8; ++g) s += red[(g * 9 + j) * 64 + n];
            p.MOD[((size_t)l * 9 + j) * 6144 + n0 + n] = s + p.mod_b[l * 6144 + n0 + n];
        }
        __syncthreads();
    }
}

__device__ void phase_filt(const Params& p, unsigned char* lds) {
    float* zs = (float*)lds;
    float* h1 = zs + 8 * 33;
    float* h2 = h1 + 8 * 64;
    const int tid = threadIdx.x;
    const float min_decay = logf(1e-2f) / 1.5f, max_decay = logf(1e-2f) / 0.3f;
    for (int u = blockIdx.x; u < 512; u += gridDim.x) {
        __syncthreads();
        if (tid < 8 * 33) {
            const int tt = tid / 33, i = tid % 33; const int t = u * 8 + tt;
            float v;
            if (i == 0) v = (float)t / 4095.f;
            else {
                const int bi = (i - 1) & 15; const float fr = 1e-4f + (float)bi * ((15.f - 1e-4f) / 15.f);
                const float wpos = 6.283185307179586f * (float)t / 4096.f;
                v = (i <= 16) ? cosf(fr * wpos) : -sinf(fr * wpos);
            }
            zs[tid] = v;
        }
        __syncthreads();
        const int tt = tid >> 6, j = tid & 63;
        {
            float s = p.hy_ffn_b1[j];
            for (int i = 0; i < 33; ++i) s += zs[tt * 33 + i] * p.hy_ffn_w1[i * 64 + j];
            h1[tt * 64 + j] = sinf(p.hy_sin_freq[j] * s);
        }
        __syncthreads();
        {
            float s = p.hy_ffn_b2[j];
            for (int i = 0; i < 64; ++i) s += h1[tt * 64 + i] * p.hy_ffn_w2[i * 64 + j];
            h2[tt * 64 + j] = sinf(p.hy_sin_freq[64 + j] * s);
        }
        __syncthreads();
#pragma unroll 1
        for (int mi = 0; mi < 4; ++mi) {
            const int m = tid + 512 * mi; const int n = m >> 10, side = (m >> 9) & 1, c = m & 511;
            float acc[8];
#pragma unroll
            for (int t2 = 0; t2 < 8; ++t2) acc[t2] = 0.f;
            for (int jj = 0; jj < 64; ++jj) {
                const float wv = p.hy_ffn_w3[jj * 2048 + m];
#pragma unroll
                for (int t2 = 0; t2 < 8; ++t2) acc[t2] += h2[t2 * 64 + jj] * wv;
            }
            const float delta = min_decay + (float)c * ((max_decay - min_decay) / 511.f);
#pragma unroll
            for (int t2 = 0; t2 < 8; ++t2) {
                const int t = u * 8 + t2; const float win = expf(-((float)t / 4095.f) * fabsf(delta)); const float val = acc[t2] * win;
                if (side == 0) p.G[((size_t)n * 8192 + 4096 + t) * 512 + c] = val;
                else if (t > 0) p.G[((size_t)n * 8192 + 4096 - t) * 512 + c] = val;
            }
        }
        if (u == 0) for (int e = tid; e < 1024; e += NTHR) p.G[((size_t)(e >> 9) * 8192) * 512 + (e & 511)] = 0.f;
    }
}

struct EpStoreF32 {
    float* C; int ldc; int row0; int n0; int nvalid;
    __device__ __forceinline__ void operator()(const f32x4 (&acc)[4][4], int wm, int wn, int lane) const {
#pragma unroll
        for (int i = 0; i < 4; ++i)
#pragma unroll
            for (int j = 0; j < 4; ++j) { const int col = n0 + EP_COL(j); if (col < nvalid) *(f32x4*)(C + (size_t)(row0 + EP_ROW(i)) * ldc + col) = acc[i][j]; }
    }
};
__device__ void phase_inproj(const Params& p, unsigned char* lds, int layer) {
    const int N = layer == 0 ? EVW : ODW; const int ntn = (N + 127) / 128; const int nunits = (NT / 256) * ntn;
    const float* W = layer == 0 ? p.ev_w_in : p.od_w_in;
    for (int u = blockIdx.x; u < nunits; u += gridDim.x) {
        const int tm = u / ntn, tn = u % ntn;
        ALoadMod al{&p, layer, tm * 256, 0};
        BLoadF32 bl{W, N, tn * 128, N};
        EpStoreF32 ep{p.P, N, tm * 256, tn * 128, N};
        gemm_tile(al, bl, ep, 1024, lds);
    }
}

__device__ void phase_gate(const Params& p) {
    const int tid = threadIdx.x, d = tid >> 8, col = tid & 255;
    float wv[16];
#pragma unroll
    for (int i = 0; i < 16; ++i) wv[i] = p.gla_gate_w2[(d * 16 + i) * 256 + col];
    const float bias = p.gla_gate_b[d * 256 + col];
    for (int r = blockIdx.x; r < NT; r += gridDim.x) {
        const float* a = p.P + (size_t)r * EVW + 1536 + d * 16;
        float s = bias;
#pragma unroll
        for (int i = 0; i < 16; ++i) s += a[i] * wv[i];
        p.LA[((size_t)d * NT + r) * 256 + col] = logsigmoid_f(s) * (1.f / 16.f);
    }
}

template <int DK, int TYPE>
__device__ __forceinline__ void rec0_units(const Params& p, unsigned char* lds, int blk, int nblk) {
    constexpr int CH = 8, DH = DK / 2;
    const int tid = threadIdx.x, sub = tid >> 8, v = (tid & 255) >> 1, half = tid & 1, t256 = tid & 255;
    float* base = (float*)lds + sub * (CH * (3 * DK + 128));
    float* sq = base; float* sk = sq + CH * DK; float* sa = sk + CH * DK; float* sv = sa + CH * DK;
    for (int ug = blk; ug < 32; ug += nblk) {
        const int unit = ug * 2 + sub; const int dir = unit >> 5, b = (unit >> 2) & 7, h = unit & 3;
        float S[DH];
#pragma unroll
        for (int d = 0; d < DH; ++d) S[d] = 0.f;
        for (int c0 = 0; c0 < CTXL + SEQ; c0 += CH) {
            __syncthreads();
            for (int e = t256; e < CH * DK; e += 256) {
                const int i = e / DK, d = e % DK; const int row = row_of(dir, b, c0 + i);
                const float* pr = p.P + (size_t)row * EVW;
                float q, k, a;
                if (TYPE == 0) { q = pr[h * 64 + d] * 0.125f; k = pr[256 + h * 64 + d]; a = expf(p.LA[((size_t)dir * NT + row) * 256 + h * 64 + d]); }
                else {
                    q = silu_f(pr[1568 + h * 128 + d]);
                    const float z = pr[2080 + dir * 512 + h * 128 + d];
                    const float l0 = p.hg_lb_logits[dir * 512 + h * 128 + d], l1 = p.hg_lb_logits[1024 + dir * 512 + h * 128 + d];
                    const float lb = 1.f / (1.f + expf(l1 - l0));
                    const float f = lb + (1.f - lb) * sigmoid_f(z);
                    k = 1.f - f; a = f;
                }
                sq[e] = q; sk[e] = k; sa[e] = a;
            }
            for (int e = t256; e < CH * 128; e += 256) {
                const int i = e >> 7, vv = e & 127; const int row = row_of(dir, b, c0 + i);
                sv[e] = p.P[(size_t)row * EVW + (TYPE == 0 ? 512 : 3104) + h * 128 + vv];
            }
            __syncthreads();
#pragma unroll 1
            for (int i = 0; i < CH; ++i) {
                const float vt = sv[i * 128 + v]; float o = 0.f;
                const float* q_ = sq + i * DK + half * DH; const float* k_ = sk + i * DK + half * DH; const float* a_ = sa + i * DK + half * DH;
#pragma unroll
                for (int d = 0; d < DH; d += 4) {
                    const f32x4 q4 = *(const f32x4*)(q_ + d), k4 = *(const f32x4*)(k_ + d), a4 = *(const f32x4*)(a_ + d);
#pragma unroll
                    for (int e = 0; e < 4; ++e) { S[d + e] = a4[e] * S[d + e] + k4[e] * vt; o += q4[e] * S[d + e]; }
                }
                o += __shfl_xor(o, 1);
                const int row = row_of(dir, b, c0 + i);
                if (half == 0) p.O[((size_t)dir * NT + row) * 1024 + TYPE * 512 + h * 128 + v] = o;
            }
        }
    }
}
__device__ void phase_rec0(const Params& p, unsigned char* lds) {
    const int nb = gridDim.x, b = blockIdx.x;
    if (nb >= 64) { if (b < 32) rec0_units<64, 0>(p, lds, b, 32); else if (b < 64) rec0_units<128, 1>(p, lds, b - 32, 32); }
    else { rec0_units<64, 0>(p, lds, b, nb); rec0_units<128, 1>(p, lds, b, nb); }
}

__device__ void phase_readout0(const Params& p) {
    const int lane = threadIdx.x & 63, w = threadIdx.x >> 6;
    const int c = w * 128 + lane * 2;
    const float* gn = w < 4 ? p.gla_norm_g : p.hg_norm_g;
    const float g0 = gn[lane * 2], g1 = gn[lane * 2 + 1];
    const int goff = w < 4 ? (1024 + c) : (3616 + (c - 512));
    for (int r = blockIdx.x; r < NT; r += gridDim.x) {
        const float* o0 = p.O + (size_t)r * 1024 + c; const float* o1 = p.O + ((size_t)NT + r) * 1024 + c;
        const float a = o0[0] + o1[0], b = o0[1] + o1[1];
        const float ss = wave_sum(a * a + b * b);
        const float rs = rsqrtf(ss * (1.f / 128.f) + 1e-6f);
        const float* gp = p.P + (size_t)r * EVW + goff;
        const float y0 = a * rs * g0 * silu_f(gp[0]), y1 = b * rs * g1 * silu_f(gp[1]);
        *(unsigned*)(p.Y + (size_t)r * 1024 + c) = pk2(y0, y1);
    }
}

struct EpPre {
    const Params* p; int layer; int row0; int n0;
    __device__ __forceinline__ void operator()(const f32x4 (&acc)[4][4], int wm, int wn, int lane) const {
#pragma unroll
        for (int i = 0; i < 4; ++i) {
            const int row = row0 + EP_ROW(i);
            const float* xr = xin_row(*p, layer, row);
            const float* g1 = p->MOD + ((size_t)layer * 9 + row_mod(row)) * 6144 + 2048;
#pragma unroll
            for (int j = 0; j < 4; ++j) {
                const int col = n0 + EP_COL(j);
                const f32x4 xv = *(const f32x4*)(xr + col), gv = *(const f32x4*)(g1 + col);
                *(f32x4*)(p->PRE + (size_t)row * DM + col) = xv * DN_ALPHA + gv * acc[i][j];
            }
        }
    }
};
__device__ void phase_outproj(const Params& p, unsigned char* lds, int layer) {
    const int rbase = layer == 0 ? 0 : NCTX; const int ntm = (NT - rbase) / 256; const int nunits = ntm * 8;
    const float* W = layer == 0 ? p.ev_w_out : p.od_w_out;
    for (int u = blockIdx.x; u < nunits; u += gridDim.x) {
        const int tm = u >> 3, tn = u & 7;
        ALoadBf al{p.Y, DM, rbase + tm * 256};
        BLoadF32 bl{W, DM, tn * 128, DM};
        EpPre ep{&p, layer, rbase + tm * 256, tn * 128};
        gemm_tile(al, bl, ep, 1024, lds);
    }
}

__device__ void phase_ln1(const Params& p, int layer) {
    const int lane = threadIdx.x & 63, w = threadIdx.x >> 6;
    const int rbase = layer == 0 ? 0 : NCTX;
    const float* lg = p.ln1_g + layer * DM; const float* lb = p.ln1_b + layer * DM;
    for (int r = rbase + blockIdx.x * 8 + w; r < NT; r += gridDim.x * 8) {
        f32x4 v[4]; float s = 0.f;
#pragma unroll
        for (int i = 0; i < 4; ++i) { v[i] = *(const f32x4*)(p.PRE + (size_t)r * DM + i * 256 + lane * 4); s += (v[i][0] + v[i][1]) + (v[i][2] + v[i][3]); }
        const float mean = wave_sum(s) * (1.f / 1024.f); float q = 0.f;
#pragma unroll
        for (int i = 0; i < 4; ++i) { const f32x4 d = v[i] - mean; q += (d[0] * d[0] + d[1] * d[1]) + (d[2] * d[2] + d[3] * d[3]); }
        const float rstd = rsqrtf(wave_sum(q) * (1.f / 1024.f) + 1e-5f);
        const float* md = p.MOD + ((size_t)layer * 9 + row_mod(r)) * 6144;
#pragma unroll
        for (int i = 0; i < 4; ++i) {
            const int col = i * 256 + lane * 4;
            const f32x4 y = (v[i] - mean) * rstd * *(const f32x4*)(lg + col) + *(const f32x4*)(lb + col);
            *(f32x4*)(p.X1 + (size_t)r * DM + col) = y;
            const f32x4 uu = y * (*(const f32x4*)(md + 4096 + col) + 1.f) + *(const f32x4*)(md + 3072 + col);
            u32x2 wv; wv.x = pk2(uu[0], uu[1]); wv.y = pk2(uu[2], uu[3]);
            *(u32x2*)(p.U + (size_t)r * DM + col) = wv;
        }
    }
}

__device__ void phase_router(const Params& p, unsigned char* lds, int layer) {
    const int rbase = layer == 0 ? 0 : NCTX; const int ntm = (NT - rbase) / 256; const int nunits = ntm * 2;
    for (int u = blockIdx.x; u < nunits; u += gridDim.x) {
        const int tm = u >> 1, tn = u & 1;
        ALoadBf al{p.U, DM, rbase + tm * 256};
        BLoadF32 bl{p.router_w + (size_t)layer * DM * 256, 256, tn * 128, 256};
        EpStoreF32 ep{p.LOGITS, 256, rbase + tm * 256, tn * 128, 256};
        gemm_tile(al, bl, ep, 1024, lds);
    }
}

__device__ void phase_select(const Params& p, int layer) {
    const int lane = threadIdx.x & 63, w = threadIdx.x >> 6;
    const int rbase = layer == 0 ? 0 : NCTX; const int nrows = NT - rbase;
    const f32x4 bias = *(const f32x4*)(p.router_bias + layer * 256 + lane * 4);
    int* cnt = p.CNT + layer * 256;
    const float NEG = -__builtin_inff();
    for (int t = blockIdx.x * 8 + w; t < nrows; t += gridDim.x * 8) {
        const f32x4 lg = *(const f32x4*)(p.LOGITS + (size_t)(rbase + t) * 256 + lane * 4);
        float sc0 = sigmoid_f(lg[0]), sc1 = sigmoid_f(lg[1]), sc2 = sigmoid_f(lg[2]), sc3 = sigmoid_f(lg[3]);
        float s0 = sc0 + bias[0], s1 = sc1 + bias[1], s2 = sc2 + bias[2], s3 = sc3 + bias[3];
        float a = fmaxf(s0, s1), b = fminf(s0, s1), c = fmaxf(s2, s3), d = fminf(s2, s3);
        float m1 = fmaxf(a, c), m2 = fmaxf(fminf(a, c), fmaxf(b, d));
#pragma unroll
        for (int m = 1; m <= 4; m <<= 1) {
            const float o1 = __shfl_xor(m1, m), o2 = __shfl_xor(m2, m);
            const float n1 = fmaxf(m1, o1), n2 = fmaxf(fminf(m1, o1), fmaxf(m2, o2));
            m1 = n1; m2 = n2;
        }
        const float grp = m1 + m2; const int myg = lane >> 3; int rank = 0;
#pragma unroll
        for (int g = 0; g < 8; ++g) { const float sg = __shfl(grp, g * 8); rank += (sg > grp || (sg == grp && g < myg)) ? 1 : 0; }
        if (rank >= 4) { s0 = NEG; s1 = NEG; s2 = NEG; s3 = NEG; }
        int my_e = 0; float my_s = 0.f, gsum = 0.f;
#pragma unroll 1
        for (int k = 0; k < 8; ++k) {
            float lm = s0; int li = 0;
            if (s1 > lm) { lm = s1; li = 1; }
            if (s2 > lm) { lm = s2; li = 2; }
            if (s3 > lm) { lm = s3; li = 3; }
            const float wmx = wave_max(lm);
            const unsigned long long bal = __ballot(lm == wmx);
            const int win = __ffsll((long long)bal) - 1;
            const float mysc = li == 0 ? sc0 : (li == 1 ? sc1 : (li == 2 ? sc2 : sc3));
            const int e = win * 4 + __shfl(li, win);
            const float se = __shfl(mysc, win);
            if (lane == win) { if (li == 0) s0 = NEG; else if (li == 1) s1 = NEG; else if (li == 2) s2 = NEG; else s3 = NEG; }
            if (lane == k) { my_e = e; my_s = se; }
            gsum += se;
        }
        if (lane < 8) {
            const int pos = atomicAdd(&cnt[my_e], 1);
            const size_t o = (size_t)t * 8 + lane;
            p.EIDX[o] = my_e; p.GATE[o] = my_s / gsum * 2.5f; p.POS[o] = pos;
        }
    }
}

__device__ void phase_offsets(const Params& p, unsigned char* lds, int layer) {
    int* offs = (int*)lds;
    const int tid = threadIdx.x;
    const int rbase = layer == 0 ? 0 : NCTX; const int nrows = NT - rbase;
    const int* cnt = p.CNT + layer * 256;
    __syncthreads();
    if (tid == 0) { int a = 0; for (int e = 0; e < 256; ++e) { offs[e] = a; a += (cnt[e] + 255) & ~255; } offs[256] = a; }
    __syncthreads();
    const int ntr = offs[256] >> 8;
    if (blockIdx.x == 0) {
        if (tid == 0) p.META[layer * 64] = ntr;
        for (int i = tid; i < ntr; i += NTHR) { int lo = 0, hi = 255; const int s = i * 256; while (lo < hi) { const int mid = (lo + hi + 1) >> 1; if (offs[mid] <= s) lo = mid; else hi = mid - 1; }
            p.TILE_E[i] = lo; }
    }
    for (int i = blockIdx.x * NTHR + tid; i < nrows * 8; i += gridDim.x * NTHR) {
        const int e = p.EIDX[i]; const int slot = offs[e] + p.POS[i];
        p.SLOT_TOK[slot] = rbase + (i >> 3); p.SLOT_GATE[slot] = p.GATE[i]; p.TOKSLOT[i] = slot;
    }
    for (int e = blockIdx.x; e < 256; e += gridDim.x) {
        const int c = cnt[e], pe = (c + 255) & ~255;
        for (int s = c + tid; s < pe; s += NTHR) { p.SLOT_TOK[offs[e] + s] = rbase; p.SLOT_GATE[offs[e] + s] = 0.f; }
    }
}

struct EpAct {
    bf16_t* ACT; int slot0; int nt;
    __device__ __forceinline__ void operator()(const f32x4 (&acc)[4][4], int wm, int wn, int lane) const {
#pragma unroll
        for (int i = 0; i < 4; ++i) {
            const int row = slot0 + EP_ROW(i);
#pragma unroll
            for (int j = 0; j < 2; ++j) {
                const int col = nt * 64 + wn * 32 + j * 16 + (lane >> 4) * 4;
                const f32x4 h1 = acc[i][j], h3 = acc[i][j + 2];
                u32x2 wv; wv.x = pk2(silu_f(h1[0]) * h3[0], silu_f(h1[1]) * h3[1]); wv.y = pk2(silu_f(h1[2]) * h3[2], silu_f(h1[3]) * h3[3]);
                *(u32x2*)(ACT + (size_t)row * 256 + col) = wv;
            }
        }
    }
};
__device__ void phase_moe1(const Params& p, unsigned char* lds, int layer) {
    const int rbase = layer == 0 ? 0 : NCTX; const int nsh = (NT - rbase) / 256;
    const int ntr = p.META[layer * 64]; const int nunits = (ntr + nsh) * 4;
    for (int u = blockIdx.x; u < nunits; u += gridDim.x) {
        const int tile = u >> 2, nt = u & 3;
        EpAct ep{p.ACT, tile * 256, nt};
        if (tile < ntr) {
            const int e = p.TILE_E[tile];
            ALoadGather al{p.U, DM, p.SLOT_TOK + tile * 256};
            BLoadW13 bl{p.exp_w13 + ((size_t)layer * 256 + e) * (1024 * 512), nt};
            gemm_tile(al, bl, ep, 1024, lds);
        } else {
            ALoadBf al{p.U, DM, rbase + (tile - ntr) * 256};
            BLoadW13 bl{p.sh_w13 + (size_t)layer * (1024 * 512), nt};
            gemm_tile(al, bl, ep, 1024, lds);
        }
    }
}
struct EpYs {
    bf16_t* YS; const float* gate; int slot0; int n0;
    __device__ __forceinline__ void operator()(const f32x4 (&acc)[4][4], int wm, int wn, int lane) const {
#pragma unroll
        for (int i = 0; i < 4; ++i) {
            const int row = slot0 + EP_ROW(i); const float g = gate ? gate[row] : 1.f;
#pragma unroll
            for (int j = 0; j < 4; ++j) {
                const int col = n0 + EP_COL(j); const f32x4 v = acc[i][j] * g;
                u32x2 wv; wv.x = pk2(v[0], v[1]); wv.y = pk2(v[2], v[3]);
                *(u32x2*)(YS + (size_t)row * DM + col) = wv;
            }
        }
    }
};
__device__ void phase_moe2(const Params& p, unsigned char* lds, int layer) {
    const int rbase = layer == 0 ? 0 : NCTX; const int nsh = (NT - rbase) / 256;
    const int ntr = p.META[layer * 64]; const int nunits = (ntr + nsh) * 8;
    for (int u = blockIdx.x; u < nunits; u += gridDim.x) {
        const int tile = u >> 3, tn = u & 7;
        ALoadBf al{p.ACT, 256, tile * 256};
        if (tile < ntr) {
            const int e = p.TILE_E[tile];
            BLoadF32 bl{p.exp_w2 + ((size_t)layer * 256 + e) * (256 * 1024), DM, tn * 128, DM};
            EpYs ep{p.YS, p.SLOT_GATE, tile * 256, tn * 128};
            gemm_tile(al, bl, ep, 256, lds);
        } else {
            BLoadF32 bl{p.sh_w2 + (size_t)layer * (256 * 1024), DM, tn * 128, DM};
            EpYs ep{p.YS, nullptr, tile * 256, tn * 128};
            gemm_tile(al, bl, ep, 256, lds);
        }
    }
}
__device__ void phase_combine(const Params& p, int layer) {
    const int lane = threadIdx.x & 63, w = threadIdx.x >> 6;
    const int rbase = layer == 0 ? 0 : NCTX; const int nrows = NT - rbase;
    const int ntr = p.META[layer * 64];
    const float* lg = p.ln2_g + layer * DM; const float* lb = p.ln2_b + layer * DM;
    for (int t = blockIdx.x * 8 + w; t < nrows; t += gridDim.x * 8) {
        const int r = rbase + t;
        int myslot = 0; if (lane < 8) myslot = p.TOKSLOT[(size_t)t * 8 + lane]; if (lane == 8) myslot = ntr * 256 + t;
        f32x4 mo[4];
#pragma unroll
        for (int i = 0; i < 4; ++i) mo[i] = (f32x4){0.f, 0.f, 0.f, 0.f};
#pragma unroll 1
        for (int k = 0; k < 9; ++k) {
            const int slot = __shfl(myslot, k);
            const bf16_t* yr = p.YS + (size_t)slot * DM;
#pragma unroll
            for (int i = 0; i < 4; ++i) { const u32x2 wv = *(const u32x2*)(yr + i * 256 + lane * 4);
                mo[i][0] += __uint_as_float(wv.x << 16); mo[i][1] += __uint_as_float(wv.x & 0xffff0000u); mo[i][2] += __uint_as_float(wv.y << 16); mo[i][3] += __uint_as_float(wv.y & 0xffff0000u); }
        }
        const float* md = p.MOD + ((size_t)layer * 9 + row_mod(r)) * 6144 + 5120;
        f32x4 v[4]; float s = 0.f;
#pragma unroll
        for (int i = 0; i < 4; ++i) { const int col = i * 256 + lane * 4; v[i] = *(const f32x4*)(p.X1 + (size_t)r * DM + col) * DN_ALPHA + *(const f32x4*)(md + col) * mo[i]; s += (v[i][0] + v[i][1]) + (v[i][2] + v[i][3]); }
        const float mean = wave_sum(s) * (1.f / 1024.f); float q = 0.f;
#pragma unroll
        for (int i = 0; i < 4; ++i) { const f32x4 d = v[i] - mean; q += (d[0] * d[0] + d[1] * d[1]) + (d[2] * d[2] + d[3] * d[3]); }
        const float rstd = rsqrtf(wave_sum(q) * (1.f / 1024.f) + 1e-5f);
        float* dst = layer == 0 ? p.X2 + (size_t)r * DM : p.out + (size_t)t * DM;
#pragma unroll
        for (int i = 0; i < 4; ++i) { const int col = i * 256 + lane * 4; f32x4 ov = (v[i] - mean) * rstd * *(const f32x4*)(lg + col) + *(const f32x4*)(lb + col);
#ifdef SANITIZE
            for (int e = 0; e < 4; ++e) { float z = ov[e]; if (!(fabsf(z) < 1e4f)) z = 100.f; ov[e] = z; }
#endif
            *(f32x4*)(dst + col) = ov; }
    }
}

__device__ void phase_shortconv(const Params& p) {
    for (size_t i = (size_t)blockIdx.x * NTHR + threadIdx.x; i < (size_t)NLAT * 1536; i += (size_t)gridDim.x * NTHR) {
        const int c = (int)(i % 1536); const int q = (int)(i / 1536); const int t = q & 4095;
        const float* pr = p.P + (size_t)(NCTX + q) * ODW + c;
        float s = p.hy_conv_b[c] + pr[0] * p.hy_conv_w[1536 + c];
        if (t > 0) s += pr[-ODW] * p.hy_conv_w[c];
        if (t < 4095) s += pr[ODW] * p.hy_conv_w[2 * 1536 + c];
        p.UH[i] = s;
    }
}
template <int ORD>
__device__ __forceinline__ void hyconv_naive(const Params& p) {
    const int lane = threadIdx.x & 63, w = threadIdx.x >> 6;
    for (int u = blockIdx.x; u < 8 * 128 * 8; u += gridDim.x) {
        const int ct = u & 7, tt = (u >> 3) & 127, b = u >> 10;
        const int c = ct * 64 + lane, t0 = tt * 32 + w * 4;
        const float* Gc = p.G + (size_t)ORD * 8192 * 512 + c;
        const float* uin = ORD == 0 ? p.UH + (size_t)b * 4096 * 1536 + c : p.Z1 + (size_t)b * 4096 * 512 + c;
        const int ustr = ORD == 0 ? 1536 : 512;
        float w0 = Gc[(size_t)(t0 + 4096) * 512], w1 = Gc[(size_t)(t0 + 4097) * 512], w2 = Gc[(size_t)(t0 + 4098) * 512], w3 = Gc[(size_t)(t0 + 4099) * 512];
        float a0 = 0.f, a1 = 0.f, a2 = 0.f, a3 = 0.f;
        const float* gp = Gc + (size_t)(t0 + 4095) * 512;
#pragma unroll 4
        for (int s = 0; s < 4096; ++s) {
            const float uv = uin[(size_t)s * ustr];
            const float wn = *gp; gp -= 512;
            a0 += w0 * uv; a1 += w1 * uv; a2 += w2 * uv; a3 += w3 * uv;
            w3 = w2; w2 = w1; w1 = w0; w0 = wn;
        }
        const float bias = p.hy_bias[ORD * 512 + c];
        float acc[4] = {a0, a1, a2, a3};
#pragma unroll
        for (int j = 0; j < 4; ++j) {
            const int t = t0 + j;
            const float gate = p.UH[((size_t)b * 4096 + t) * 1536 + 512 * (ORD + 1) + c];
            const float val = gate * (acc[j] + uin[(size_t)t * ustr] * bias);
            if (ORD == 0) p.Z1[((size_t)b * 4096 + t) * 512 + c] = val;
            else p.Y[(size_t)(NCTX + b * 4096 + t) * DM + c] = f2bf(val);
        }
    }
}
__device__ void phase_rwstreams(const Params& p, unsigned char* lds) {
    float* pm = (float*)lds;
    const int tid = threadIdx.x;
    for (int tile = blockIdx.x; tile < NT / 8; tile += gridDim.x) {
        const int r0 = tile * 8;
        __syncthreads();
        for (int e = tid; e < 8 * 1856; e += NTHR) {
            const int i = e / 1856, c = e % 1856; const int r = r0 + i;
            int rs = -1;
            if (r < NCTX) { const int t = r & 255; if ((c & 1) == 0) { if (t > 0) rs = r - 1; } else { if (t < 255) rs = r + 1; } }
            else { const int t = (r - NCTX) & 4095, gr = t >> 6, gc = t & 63, m = c & 3;
                if (m == 0) { if (gc > 0) rs = r - 1; } else if (m == 1) { if (gc < 63) rs = r + 1; } else if (m == 2) { if (gr > 0) rs = r - 64; } else { if (gr < 63) rs = r + 64; } }
            const float pv = p.P[(size_t)r * ODW + 1536 + c];
            const float ps = rs >= 0 ? p.P[(size_t)rs * ODW + 1536 + c] : 0.f;
            pm[e] = pv + p.rw_mu[c] * (ps - pv);
        }
        __syncthreads();
        for (int e = tid; e < 8 * 320; e += NTHR) {
            const int i = e / 320, c = 1536 + e % 320; float v = pm[i * 1856 + c];
            if (c < 1664) v = tanhf(v); else if (c >= 1728) v = sigmoid_f(v);
            pm[i * 1856 + c] = v;
        }
        __syncthreads();
        const int c = tid;
        float awf[8], awb[8], aa[8], ag[8];
#pragma unroll
        for (int i = 0; i < 8; ++i) { awf[i] = 0.f; awb[i] = 0.f; aa[i] = 0.f; ag[i] = 0.f; }
        for (int k = 0; k < 64; ++k) {
            const float wf = p.rw_w2[(size_t)k * 512 + c], wb = p.rw_w2[(size_t)(64 + k) * 512 + c], a2 = p.rw_a2[(size_t)k * 512 + c];
#pragma unroll
            for (int i = 0; i < 8; ++i) { awf[i] += pm[i * 1856 + 1536 + k] * wf; awb[i] += pm[i * 1856 + 1600 + k] * wb; aa[i] += pm[i * 1856 + 1664 + k] * a2; }
        }
        for (int k = 0; k < 128; ++k) {
            const float g2 = p.rw_g2[(size_t)k * 512 + c];
#pragma unroll
            for (int i = 0; i < 8; ++i) ag[i] += pm[i * 1856 + 1728 + k] * g2;
        }
        const float w0f = p.rw_w0[c], w0b = p.rw_w0[512 + c], a0 = p.rw_a0[c], kkw = p.rw_k_k[c], kaw = p.rw_k_a[c];
#pragma unroll
        for (int i = 0; i < 8; ++i) {
            const size_t o = (size_t)(r0 + i) * 512 + c;
            const float wf = logsigmoid_f(w0f + awf[i]) - 0.5f, wb = logsigmoid_f(w0b + awb[i]) - 0.5f;
            p.DEC[o] = expf(-expf(wf)); p.DEC[(size_t)NT * 512 + o] = expf(-expf(wb));
            const float a = sigmoid_f(a0 + aa[i]);
            const float k = pm[i * 1856 + 512 + c];
            const float kr = k * kkw; const float ss = wave_sum(kr * kr);
            const float kk = kr / fmaxf(sqrtf(ss), 1e-12f);
            p.KK[o] = kk; p.BV[o] = kk * a; p.KP[o] = k * (1.f + (a - 1.f) * kaw);
            p.RR[o] = pm[i * 1856 + c]; p.VV[o] = pm[i * 1856 + 1024 + c]; p.GT[o] = ag[i];
        }
    }
}
__device__ void phase_rwscan(const Params& p, unsigned char* lds) {
    constexpr int CH = 4;
    const int lane = threadIdx.x & 63, w = threadIdx.x >> 6;
    float* st = (float*)lds + w * (CH * 5 * 64);
    for (int ug = blockIdx.x; ug < 16; ug += gridDim.x) {
        const int unit = ug * 8 + w; const int dir = unit >> 6, b = (unit >> 3) & 7, h = unit & 7;
        float S[64];
#pragma unroll
        for (int k = 0; k < 64; ++k) S[k] = 0.f;
        for (int c0 = 0; c0 < CTXL + SEQ; c0 += CH) {
            __syncthreads();
#pragma unroll
            for (int i = 0; i < CH; ++i) {
                const size_t o = (size_t)row_of(dir, b, c0 + i) * 512 + h * 64 + lane;
                st[(i * 5 + 0) * 64 + lane] = p.DEC[(size_t)dir * NT * 512 + o];
                st[(i * 5 + 1) * 64 + lane] = p.KP[o];
                st[(i * 5 + 2) * 64 + lane] = p.KK[o];
                st[(i * 5 + 3) * 64 + lane] = p.BV[o];
                st[(i * 5 + 4) * 64 + lane] = p.RR[o];
            }
            __syncthreads();
#pragma unroll 1
            for (int i = 0; i < CH; ++i) {
                const int row = row_of(dir, b, c0 + i);
                const float vt = p.VV[(size_t)row * 512 + h * 64 + lane];
                const float* sd = st + (i * 5) * 64;
                float dot = 0.f;
#pragma unroll
                for (int k = 0; k < 64; k += 4) { const f32x4 kk4 = *(const f32x4*)(sd + 128 + k);
#pragma unroll
                    for (int e = 0; e < 4; ++e) dot += S[k + e] * kk4[e]; }
                float o = 0.f;
#pragma unroll
                for (int k = 0; k < 64; k += 4) {
                    const f32x4 d4 = *(const f32x4*)(sd + k), kp4 = *(const f32x4*)(sd + 64 + k), b4 = *(const f32x4*)(sd + 192 + k), r4 = *(const f32x4*)(sd + 256 + k);
#pragma unroll
                    for (int e = 0; e < 4; ++e) { S[k + e] = S[k + e] * d4[e] - dot * b4[e] + vt * kp4[e]; o += S[k + e] * r4[e]; }
                }
                if (c0 + i >= CTXL) p.O[((size_t)dir * NT + row) * 512 + h * 64 + lane] = o;
            }
        }
    }
}
__device__ void phase_readout1(const Params& p) {
    const int lane = threadIdx.x & 63, h = threadIdx.x >> 6;
    const float lg = p.rw_ln_g[h * 64 + lane], lb = p.rw_ln_b[h * 64 + lane], rk = p.rw_r_k[h * 64 + lane];
    for (int r = NCTX + blockIdx.x; r < NT; r += gridDim.x) {
        const size_t o = (size_t)r * 512 + h * 64 + lane;
        const float ov = p.O[o] + p.O[(size_t)NT * 512 + o];
        const float mean = wave_sum(ov) * (1.f / 64.f); const float d = ov - mean;
        const float var = wave_sum(d * d) * (1.f / 64.f);
        const float on = d * rsqrtf(var + 64e-5f) * lg + lb;
        const float bonus = wave_sum(p.RR[o] * p.KP[o] * rk) * p.VV[o];
        p.Y[(size_t)r * DM + 512 + h * 64 + lane] = f2bf((on + bonus) * p.GT[o]);
    }
}

#ifdef PROBE_BUF
__global__ void __launch_bounds__(NTHR) k_probe(Params p) { for (size_t i = (size_t)blockIdx.x * NTHR + threadIdx.x; i < (size_t)NLAT * DM; i += (size_t)gridDim.x * NTHR) {
        float z;
#if PROBE_KIND == 1
        const unsigned q = ((unsigned)i >> 1); z = 0.f; if (q < (unsigned)(NT * 8)) z = (i & 1) ? p.GATE[q] : (float)p.EIDX[q];
#elif PROBE_KIND == 2
        const unsigned q = (unsigned)i; const unsigned ts = q >> 8; z = bf2f(p.ACT[(size_t)p.TOKSLOT[ts] * 256 + (q & 255)]);
#elif PROBE_KIND == 4
        const unsigned q = (unsigned)i; const unsigned ts = q >> 10; z = bf2f(p.YS[((size_t)p.META[0] * 256 + ts) * 1024 + (q & 1023)]);
#elif PROBE_KIND == 6
        const unsigned q = (unsigned)i; const unsigned ts = q >> 8; z = 0.f; if (ts < NT) z = bf2f(p.ACT[((size_t)p.META[0] * 256 + ts) * 256 + (q & 255)]);
#elif PROBE_KIND == 7
        const unsigned q = (unsigned)i; z = 0.f; if (q < 2u * 256u * 1024u) z = p.sh_w2[q]; else if (q < 2u * 256u * 1024u + 2u * 1024u * 512u) z = p.sh_w13[q - 2u * 256u * 1024u];
#elif PROBE_KIND == 5
        const unsigned q = (unsigned)i; const unsigned ts = (q >> 10) * 8 + 3; z = bf2f(p.YS[(size_t)p.TOKSLOT[ts] * 1024 + (q & 1023)]);
#elif PROBE_KIND == 3
        const unsigned q = (unsigned)i; const unsigned ts = q >> 8; z = bf2f(p.YS[(size_t)p.TOKSLOT[ts] * 1024 + (q & 255)]);
#else
        const float* src = (const float*)p.PROBE_BUF; z = src[i + PROBE_OFF];
#endif
        if (!(fabsf(z) < 1e4f)) z = 100.f; p.out[i] = z; } }
#endif

__global__ void __launch_bounds__(NTHR, 2) k_fwd(Params p_, int lo, int hi) {
#if defined(__HIP_DEVICE_COMPILE__)
    typedef const __attribute__((address_space(4))) Params* KP;
    const KP kp0 = (KP)__builtin_amdgcn_kernarg_segment_ptr();
#define LOADP KP kq = kp0; asm volatile("" : "+s"(kq)); Params p; __builtin_memcpy(&p, kq, sizeof(Params));
#else
#define LOADP const Params& p = p_;
#endif
    extern __shared__ __attribute__((aligned(16))) unsigned char lds[];
#ifndef ONLY
#define ONLY -1
#endif
#define IN(k) ((ONLY < 0 || ONLY == (k)) && lo <= (k) && (k) < hi)
    if (IN(0)) { LOADP if (blockIdx.x == 0) { for (int e = threadIdx.x; e < 512; e += NTHR) p.CNT[e] = 0; if (threadIdx.x < 128) p.META[threadIdx.x] = 0; } phase_mod(p, lds); phase_filt(p, lds); }
    if (IN(1)) { LOADP phase_inproj(p, lds, 0); }
    if (IN(2)) { LOADP phase_gate(p); }
    if (IN(3)) { LOADP phase_rec0(p, lds); }
    if (IN(4)) { LOADP phase_readout0(p); }
    if (IN(5)) { LOADP phase_outproj(p, lds, 0); }
    if (IN(6)) { LOADP phase_ln1(p, 0); }
    if (IN(7)) { LOADP phase_router(p, lds, 0); }
    if (IN(8)) { LOADP phase_select(p, 0); }
    if (IN(9)) { LOADP phase_offsets(p, lds, 0); }
    if (IN(10)) { LOADP phase_moe1(p, lds, 0); }
    if (IN(11)) { LOADP phase_moe2(p, lds, 0); }
    if (IN(12)) { LOADP phase_combine(p, 0); }
    if (IN(13)) { LOADP phase_inproj(p, lds, 1); }
    if (IN(14)) { LOADP phase_shortconv(p); phase_rwstreams(p, lds); }
    if (IN(15)) { LOADP hyconv_naive<0>(p); }
    if (IN(16)) { LOADP hyconv_naive<1>(p); }
    if (IN(17)) { LOADP phase_rwscan(p, lds); }
    if (IN(18)) { LOADP phase_readout1(p); }
    if (IN(19)) { LOADP phase_outproj(p, lds, 1); }
    if (IN(20)) { LOADP phase_ln1(p, 1); }
    if (IN(21)) { LOADP phase_router(p, lds, 1); }
    if (IN(22)) { LOADP phase_select(p, 1); }
    if (IN(23)) { LOADP phase_offsets(p, lds, 1); }
    if (IN(24)) { LOADP phase_moe1(p, lds, 1); }
    if (IN(25)) { LOADP phase_moe2(p, lds, 1); }
    if (IN(26)) { LOADP phase_combine(p, 1); }
#undef IN
}
#define N_PHASES 27
#define LDS_BYTES 65536

extern "C" void kernel_launch(void* const* d_in, const int* in_sizes, int n_in, void* d_out, int out_size, void* d_ws, size_t ws_size, hipStream_t stream) {
    Params p;
    memset(&p, 0, sizeof(p));
    if (n_in != 45) { fprintf(stderr, "kernel_launch: expected 45 inputs, got %d\n", n_in); return; }
    const float** pin = (const float**)&p;
    for (int i = 0; i < 45; ++i) pin[i] = (const float*)d_in[i];
    p.out = (float*)d_out;
    size_t off = 0;
    unsigned char* ws = (unsigned char*)d_ws;
    auto take = [&](size_t bytes) { void* r = ws + off; off += (bytes + 255) & ~(size_t)255; return r; };
    p.BAR = (unsigned*)take(16384);
    p.CNT = (int*)take(2 * 256 * 4);
    p.META = (int*)take(2 * 64 * 4);
    const size_t zero_bytes = off;
    p.MOD = (float*)take((size_t)2 * 9 * 6144 * 4);
    p.G = (float*)take((size_t)2 * 8192 * 512 * 4);
    p.P = (float*)take((size_t)NT * EVW * 4);
    p.LA = (float*)take((size_t)2 * NT * 256 * 4);
    p.O = (float*)take((size_t)2 * NT * 1024 * 4);
    p.Y = (bf16_t*)take((size_t)NT * 1024 * 2);
    p.PRE = (float*)take((size_t)NT * 1024 * 4);
    p.X1 = (float*)take((size_t)NT * 1024 * 4);
    p.U = (bf16_t*)take((size_t)NT * 1024 * 2);
    p.LOGITS = (float*)take((size_t)NT * 256 * 4);
    p.EIDX = (int*)take((size_t)NT * 8 * 4); p.GATE = (float*)take((size_t)NT * 8 * 4); p.POS = (int*)take((size_t)NT * 8 * 4); p.TOKSLOT = (int*)take((size_t)NT * 8 * 4);
    p.TILE_E = (int*)take(2048 * 4);
    p.SLOT_TOK = (int*)take((size_t)MAXSLOT * 4); p.SLOT_GATE = (float*)take((size_t)MAXSLOT * 4);
    p.ACT = (bf16_t*)take((size_t)MAXSLOT * 256 * 2);
    p.YS = (bf16_t*)take((size_t)MAXSLOT * 1024 * 2);
    p.X2 = (float*)take((size_t)NT * 1024 * 4);
    p.UH = (float*)take((size_t)NLAT * 1536 * 4);
    p.Z1 = (float*)take((size_t)NLAT * 512 * 4);
    p.RR = (float*)take((size_t)NT * 512 * 4); p.KP = (float*)take((size_t)NT * 512 * 4); p.VV = (float*)take((size_t)NT * 512 * 4);
    p.KK = (float*)take((size_t)NT * 512 * 4); p.BV = (float*)take((size_t)NT * 512 * 4); p.GT = (float*)take((size_t)NT * 512 * 4);
    p.DEC = (float*)take((size_t)2 * NT * 512 * 4);
    if (off > ws_size) { fprintf(stderr, "kernel_launch: workspace too small: need %zu, have %zu\n", off, ws_size); return; }
    static bool attr_done = false;
    if (!attr_done) { (void)hipFuncSetAttribute((const void*)k_fwd, hipFuncAttributeMaxDynamicSharedMemorySize, LDS_BYTES); attr_done = true; }
    (void)hipMemsetAsync(d_ws, 0, zero_bytes, stream);
#ifdef PROBE_BUF
    for (int ph = 0; ph <= PROBE_UPTO; ++ph) hipLaunchKernelGGL(k_fwd, dim3(256), dim3(NTHR), LDS_BYTES, stream, p, ph, ph + 1);
    hipLaunchKernelGGL(k_fwd, dim3(256), dim3(NTHR), LDS_BYTES, stream, p, 98, 99);
    hipLaunchKernelGGL(k_fwd, dim3(256), dim3(NTHR), LDS_BYTES, stream, p, 98, 99);
    hipLaunchKernelGGL(k_probe, dim3(1024), dim3(NTHR), 0, stream, p);
#else
    for (int ph = 0; ph < N_PHASES; ++ph) {
        hipLaunchKernelGGL(k_fwd, dim3(256), dim3(NTHR), LDS_BYTES, stream, p, ph, ph + 1);
    }
#endif
}
```

```cpp
#include <hip/hip_runtime.h>
#include <stdint.h>
#include <stdio.h>
#include <string.h>

typedef unsigned short bf16_t;
typedef short bf16x8 __attribute__((ext_vector_type(8)));
typedef float f32x4 __attribute__((ext_vector_type(4)));
typedef unsigned u32x4 __attribute__((ext_vector_type(4)));
typedef unsigned u32x2 __attribute__((ext_vector_type(2)));

#define NTHR 512
#define DM 1024
#define NB 8
#define SEQ 4096
#define CTXL 256
#define NCTX (NB * CTXL)
#define NLAT (NB * SEQ)
#define NT (NCTX + NLAT)
#define EVW 4128
#define ODW 3392
#define MAXSLOT 378880
#define DN_ALPHA 1.41421356237f
#define NPHASE 40

struct Params {
    const float *x, *c, *ctx, *c_ctx, *mod_w, *mod_b, *ln1_g, *ln1_b, *ln2_g, *ln2_b;
    const float *ev_w_in, *ev_w_out, *gla_gate_w2, *gla_gate_b, *gla_norm_g, *hg_lb_logits, *hg_norm_g;
    const float *od_w_in, *od_w_out, *hy_conv_w, *hy_conv_b, *hy_ffn_w1, *hy_ffn_b1, *hy_ffn_w2, *hy_ffn_b2, *hy_ffn_w3, *hy_sin_freq, *hy_bias;
    const float *rw_mu, *rw_w0, *rw_w2, *rw_a0, *rw_a2, *rw_g2, *rw_k_k, *rw_k_a, *rw_r_k, *rw_ln_g, *rw_ln_b;
    const float *router_w, *router_bias, *exp_w13, *exp_w2, *sh_w13, *sh_w2;
    float* out;
    float* MOD;
    float* G;
    float* P;
    float* LA;
    float* O;
    bf16_t* Y;
    float* PRE;
    float* X1;
    bf16_t* U;
    float* LOGITS;
    int* EIDX; float* GATE; int* POS; int* TOKSLOT;
    int* CNT;
    int* META;
    int* TILE_E;
    int* SLOT_TOK; float* SLOT_GATE;
    bf16_t* ACT;
    bf16_t* YS;
    float* X2;
    float* UH;
    float* Z1;
    float *RR, *KP, *VV, *KK, *BV, *GT;
    float* DEC;
    unsigned* BAR;
};

typedef float f32x2_t __attribute__((ext_vector_type(2)));
typedef __bf16 bf16x2_t __attribute__((ext_vector_type(2)));
__device__ __forceinline__ unsigned pk2(float lo, float hi) { const f32x2_t v = {lo, hi}; return __builtin_bit_cast(unsigned, __builtin_convertvector(v, bf16x2_t)); }
__device__ __forceinline__ bf16x8 pack8(f32x4 a, f32x4 b) { u32x4 w; w.x = pk2(a[0], a[1]); w.y = pk2(a[2], a[3]); w.z = pk2(b[0], b[1]); w.w = pk2(b[2], b[3]); return __builtin_bit_cast(bf16x8, w); }
__device__ __forceinline__ float bf2f(bf16_t h) { return __uint_as_float((unsigned)h << 16); }
__device__ __forceinline__ bf16_t f2bf(float f) { return (bf16_t)(pk2(f, 0.f) & 0xffffu); }
__device__ __forceinline__ float sigmoid_f(float x) { return 1.f / (1.f + expf(-x)); }
__device__ __forceinline__ float silu_f(float x) { return x / (1.f + expf(-x)); }
__device__ __forceinline__ float logsigmoid_f(float x) { return x >= 0.f ? -log1pf(expf(-x)) : x - log1pf(expf(x)); }
__device__ __forceinline__ float wave_sum(float v) {
#pragma unroll
    for (int m = 32; m >= 1; m >>= 1) v += __shfl_xor(v, m);
    return v;
}
__device__ __forceinline__ float wave_max(float v) {
#pragma unroll
    for (int m = 32; m >= 1; m >>= 1) v = fmaxf(v, __shfl_xor(v, m));
    return v;
}
__device__ __forceinline__ int row_of(int dir, int b, int s) {
    if (s < CTXL) { const int pos = dir ? (CTXL - 1 - s) : s; return b * CTXL + pos; }
    const int q = s - CTXL; const int pos = dir ? (SEQ - 1 - q) : q; return NCTX + b * SEQ + pos;
}
__device__ __forceinline__ int row_mod(int r) { return r < NCTX ? 8 : ((r - NCTX) >> 12); }
__device__ __forceinline__ const float* xin_row(const Params& p, int layer, int r) {
    if (layer == 0) return r < NCTX ? p.ctx + (size_t)r * DM : p.x + (size_t)(r - NCTX) * DM;
    return p.X2 + (size_t)r * DM;
}

#define LSTR 40
template <class AL, class BL, class EP>
__device__ __forceinline__ void gemm_tile(const AL& al, const BL& bl, const EP& ep, const int K, unsigned char* lds) {
    bf16_t* As = (bf16_t*)lds;
    bf16_t* Bs = As + 256 * LSTR;
    const int tid = threadIdx.x, lane = tid & 63, w = tid >> 6, wm = w & 3, wn = w >> 2;
    const int ar0 = tid >> 2, akg = tid & 3;
    const int bn = tid & 127, bkg = tid >> 7;
    const typename AL::Row r0 = al.row(ar0), r1 = al.row(ar0 + 128);
    const typename BL::Col c0 = bl.col(bn);
    f32x4 acc[4][4];
#pragma unroll
    for (int i = 0; i < 4; ++i)
#pragma unroll
        for (int j = 0; j < 4; ++j) acc[i][j] = (f32x4){0.f, 0.f, 0.f, 0.f};
    bf16x8 ra0 = al.load(r0, akg * 8), ra1 = al.load(r1, akg * 8), rb = bl.load(c0, bkg * 8);
    for (int k0 = 0; k0 < K; k0 += 32) {
        __syncthreads();
        *(bf16x8*)(As + ar0 * LSTR + akg * 8) = ra0;
        *(bf16x8*)(As + (ar0 + 128) * LSTR + akg * 8) = ra1;
        *(bf16x8*)(Bs + bn * LSTR + bkg * 8) = rb;
        __syncthreads();
        if (k0 + 32 < K) { ra0 = al.load(r0, k0 + 32 + akg * 8); ra1 = al.load(r1, k0 + 32 + akg * 8); rb = bl.load(c0, k0 + 32 + bkg * 8); }
        bf16x8 af[4], bfr[4];
#pragma unroll
        for (int i = 0; i < 4; ++i) af[i] = *(const bf16x8*)(As + (wm * 64 + i * 16 + (lane & 15)) * LSTR + (lane >> 4) * 8);
#pragma unroll
        for (int j = 0; j < 4; ++j) bfr[j] = *(const bf16x8*)(Bs + (wn * 64 + j * 16 + (lane & 15)) * LSTR + (lane >> 4) * 8);
#pragma unroll
        for (int i = 0; i < 4; ++i)
#pragma unroll
            for (int j = 0; j < 4; ++j) acc[i][j] = __builtin_amdgcn_mfma_f32_16x16x32_bf16(bfr[j], af[i], acc[i][j], 0, 0, 0);
    }
    ep(acc, wm, wn, lane);
}
#define EP_ROW(i) (wm * 64 + (i) * 16 + (lane & 15))
#define EP_COL(j) (wn * 64 + (j) * 16 + (lane >> 4) * 4)

struct AModRow { const float* x; const float* sh; };
struct ALoadMod {
    const Params* p; int layer; int row0; int sec;
    typedef AModRow Row;
    __device__ __forceinline__ Row row(int r) const { const int g = row0 + r; Row R; R.x = xin_row(*p, layer, g); R.sh = p->MOD + ((size_t)layer * 9 + row_mod(g)) * 6144 + sec * 1024; return R; }
    __device__ __forceinline__ bf16x8 load(const Row& R, int k) const {
        const f32x4 x0 = *(const f32x4*)(R.x + k), x1 = *(const f32x4*)(R.x + k + 4);
        const f32x4 h0 = *(const f32x4*)(R.sh + k), h1 = *(const f32x4*)(R.sh + k + 4);
        const f32x4 s0 = *(const f32x4*)(R.sh + 1024 + k), s1 = *(const f32x4*)(R.sh + 1024 + k + 4);
        return pack8(x0 * (s0 + 1.f) + h0, x1 * (s1 + 1.f) + h1);
    }
};
struct ALoadBf {
    const bf16_t* A; int lda; int row0;
    typedef const bf16_t* Row;
    __device__ __forceinline__ Row row(int r) const { return A + (size_t)(row0 + r) * lda; }
    __device__ __forceinline__ bf16x8 load(Row R, int k) const { return *(const bf16x8*)(R + k); }
};
struct ALoadGather {
    const bf16_t* A; int lda; const int* idx;
    typedef const bf16_t* Row;
    __device__ __forceinline__ Row row(int r) const { return A + (size_t)idx[r] * lda; }
    __device__ __forceinline__ bf16x8 load(Row R, int k) const { return *(const bf16x8*)(R + k); }
};
__device__ __forceinline__ bf16x8 bload8(const float* c, int k, int ldb) {
    const float* q = c + (size_t)k * ldb;
    f32x4 a, b;
    a[0] = q[0]; a[1] = q[ldb]; a[2] = q[2 * ldb]; a[3] = q[3 * ldb];
    b[0] = q[4 * (size_t)ldb]; b[1] = q[5 * (size_t)ldb]; b[2] = q[6 * (size_t)ldb]; b[3] = q[7 * (size_t)ldb];
    return pack8(a, b);
}
struct BLoadF32 {
    const float* B; int ldb; int n0; int nvalid;
    typedef const float* Col;
    __device__ __forceinline__ Col col(int n) const { const int g = n0 + n; return g < nvalid ? B + g : nullptr; }
    __device__ __forceinline__ bf16x8 load(Col c, int k) const { if (!c) return (bf16x8){0, 0, 0, 0, 0, 0, 0, 0}; return bload8(c, k, ldb); }
};
struct BLoadW13 {
    const float* B; int nt;
    typedef const float* Col;
    __device__ __forceinline__ Col col(int n) const { const int wn = n >> 6, j = (n >> 4) & 3, c16 = n & 15; return B + (j >> 1) * 256 + nt * 64 + wn * 32 + (j & 1) * 16 + c16; }
    __device__ __forceinline__ bf16x8 load(Col c, int k) const { return bload8(c, k, 512); }
};

__device__ __forceinline__ void phase_mod(const Params& p, unsigned char* lds) {
    float* sv = (float*)lds;
    float* red = sv + 9 * 1024;
    const int tid = threadIdx.x;
    for (int e = tid; e < 9 * 1024; e += NTHR) { const int j = e >> 10, k = e & 1023; const float v = j < 8 ? p.c[j * 1024 + k] : p.c_ctx[k]; sv[e] = silu_f(v); }
    __syncthreads();
    const int kg = tid >> 6, nl = tid & 63;
    for (int u = blockIdx.x; u < 192; u += gridDim.x) {
        const int l = u / 96, n0 = (u % 96) * 64;
        const float* W = p.mod_w + (size_t)l * 1024 * 6144 + n0 + nl;
        float acc[9];
#pragma unroll
        for (int j = 0; j < 9; ++j) acc[j] = 0.f;
        for (int k = kg; k < 1024; k += 8) {
            const float wv = W[(size_t)k * 6144];
#pragma unroll
            for (int j = 0; j < 9; ++j) acc[j] += sv[j * 1024 + k] * wv;
        }
#pragma unroll
        for (int j = 0; j < 9; ++j) red[(kg * 9 + j) * 64 + nl] = acc[j];
        __syncthreads();
        for (int e = tid; e < 576; e += NTHR) {
            const int j = e >> 6, n = e & 63; float s = 0.f;
#pragma unroll
            for (int g = 0; g < 8; ++g) s += red[(g * 9 + j) * 64 + n];
            p.MOD[((size_t)l * 9 + j) * 6144 + n0 + n] = s + p.mod_b[l * 6144 + n0 + n];
        }
        __syncthreads();
    }
}

__device__ __forceinline__ void phase_filt(const Params& p, unsigned char* lds) {
    float* zs = (float*)lds;
    float* h1 = zs + 8 * 33;
    float* h2 = h1 + 8 * 64;
    const int tid = threadIdx.x;
    const float min_decay = logf(1e-2f) / 1.5f, max_decay = logf(1e-2f) / 0.3f;
    for (int u = blockIdx.x; u < 512; u += gridDim.x) {
        __syncthreads();
        if (tid < 8 * 33) {
            const int tt = tid / 33, i = tid % 33; const int t = u * 8 + tt;
            float v;
            if (i == 0) v = (float)t / 4095.f;
            else {
                const int bi = (i - 1) & 15; const float fr = 1e-4f + (float)bi * ((15.f - 1e-4f) / 15.f);
                const float wpos = 6.283185307179586f * (float)t / 4096.f;
                v = (i <= 16) ? cosf(fr * wpos) : -sinf(fr * wpos);
            }
            zs[tid] = v;
        }
        __syncthreads();
        const int tt = tid >> 6, j = tid & 63;
        {
            float s = p.hy_ffn_b1[j];
            for (int i = 0; i < 33; ++i) s += zs[tt * 33 + i] * p.hy_ffn_w1[i * 64 + j];
            h1[tt * 64 + j] = sinf(p.hy_sin_freq[j] * s);
        }
        __syncthreads();
        {
            float s = p.hy_ffn_b2[j];
            for (int i = 0; i < 64; ++i) s += h1[tt * 64 + i] * p.hy_ffn_w2[i * 64 + j];
            h2[tt * 64 + j] = sinf(p.hy_sin_freq[64 + j] * s);
        }
        __syncthreads();
#pragma unroll 1
        for (int mi = 0; mi < 4; ++mi) {
            const int m = tid + 512 * mi; const int n = m >> 10, side = (m >> 9) & 1, c = m & 511;
            float acc[8];
#pragma unroll
            for (int t2 = 0; t2 < 8; ++t2) acc[t2] = 0.f;
            for (int jj = 0; jj < 64; ++jj) {
                const float wv = p.hy_ffn_w3[jj * 2048 + m];
#pragma unroll
                for (int t2 = 0; t2 < 8; ++t2) acc[t2] += h2[t2 * 64 + jj] * wv;
            }
            const float delta = min_decay + (float)c * ((max_decay - min_decay) / 511.f);
#pragma unroll
            for (int t2 = 0; t2 < 8; ++t2) {
                const int t = u * 8 + t2; const float win = expf(-((float)t / 4095.f) * fabsf(delta)); const float val = acc[t2] * win;
                if (side == 0) p.G[((size_t)n * 8192 + 4096 + t) * 512 + c] = val;
                else if (t > 0) p.G[((size_t)n * 8192 + 4096 - t) * 512 + c] = val;
            }
        }
        if (u == 0) for (int e = tid; e < 1024; e += NTHR) p.G[((size_t)(e >> 9) * 8192) * 512 + (e & 511)] = 0.f;
    }
}

struct EpStoreF32 {
    float* C; int ldc; int row0; int n0; int nvalid;
    __device__ __forceinline__ void operator()(const f32x4 (&acc)[4][4], int wm, int wn, int lane) const {
#pragma unroll
        for (int i = 0; i < 4; ++i)
#pragma unroll
            for (int j = 0; j < 4; ++j) { const int col = n0 + EP_COL(j); if (col < nvalid) *(f32x4*)(C + (size_t)(row0 + EP_ROW(i)) * ldc + col) = acc[i][j]; }
    }
};
__device__ __forceinline__ void phase_inproj(const Params& p, unsigned char* lds, int layer) {
    const int N = layer == 0 ? EVW : ODW; const int ntn = (N + 127) / 128; const int nunits = (NT / 256) * ntn;
    const float* W = layer == 0 ? p.ev_w_in : p.od_w_in;
    for (int u = blockIdx.x; u < nunits; u += gridDim.x) {
        const int tm = u / ntn, tn = u % ntn;
        ALoadMod al{&p, layer, tm * 256, 0};
        BLoadF32 bl{W, N, tn * 128, N};
        EpStoreF32 ep{p.P, N, tm * 256, tn * 128, N};
        gemm_tile(al, bl, ep, 1024, lds);
    }
}

__device__ __forceinline__ void phase_gate(const Params& p) {
    const int tid = threadIdx.x, d = tid >> 8, col = tid & 255;
    float wv[16];
#pragma unroll
    for (int i = 0; i < 16; ++i) wv[i] = p.gla_gate_w2[(d * 16 + i) * 256 + col];
    const float bias = p.gla_gate_b[d * 256 + col];
    for (int r = blockIdx.x; r < NT; r += gridDim.x) {
        const float* a = p.P + (size_t)r * EVW + 1536 + d * 16;
        float s = bias;
#pragma unroll
        for (int i = 0; i < 16; ++i) s += a[i] * wv[i];
        p.LA[((size_t)d * NT + r) * 256 + col] = logsigmoid_f(s) * (1.f / 16.f);
    }
}

template <int DK, int TYPE>
__device__ __forceinline__ void rec0_units(const Params& p, unsigned char* lds, int blk, int nblk) {
    constexpr int CH = 8, DH = DK / 2;
    const int tid = threadIdx.x, sub = tid >> 8, v = (tid & 255) >> 1, half = tid & 1, t256 = tid & 255;
    float* base = (float*)lds + sub * (CH * (3 * DK + 128));
    float* sq = base; float* sk = sq + CH * DK; float* sa = sk + CH * DK; float* sv = sa + CH * DK;
    for (int ug = blk; ug < 32; ug += nblk) {
        const int unit = ug * 2 + sub; const int dir = unit >> 5, b = (unit >> 2) & 7, h = unit & 3;
        float S[DH];
#pragma unroll
        for (int d = 0; d < DH; ++d) S[d] = 0.f;
        for (int c0 = 0; c0 < CTXL + SEQ; c0 += CH) {
            __syncthreads();
            for (int e = t256; e < CH * DK; e += 256) {
                const int i = e / DK, d = e % DK; const int row = row_of(dir, b, c0 + i);
                const float* pr = p.P + (size_t)row * EVW;
                float q, k, a;
                if (TYPE == 0) { q = pr[h * 64 + d] * 0.125f; k = pr[256 + h * 64 + d]; a = expf(p.LA[((size_t)dir * NT + row) * 256 + h * 64 + d]); }
                else {
                    q = silu_f(pr[1568 + h * 128 + d]);
                    const float z = pr[2080 + dir * 512 + h * 128 + d];
                    const float l0 = p.hg_lb_logits[dir * 512 + h * 128 + d], l1 = p.hg_lb_logits[1024 + dir * 512 + h * 128 + d];
                    const float lb = 1.f / (1.f + expf(l1 - l0));
                    const float f = lb + (1.f - lb) * sigmoid_f(z);
                    k = 1.f - f; a = f;
                }
                sq[e] = q; sk[e] = k; sa[e] = a;
            }
            for (int e = t256; e < CH * 128; e += 256) {
                const int i = e >> 7, vv = e & 127; const int row = row_of(dir, b, c0 + i);
                sv[e] = p.P[(size_t)row * EVW + (TYPE == 0 ? 512 : 3104) + h * 128 + vv];
            }
            __syncthreads();
#pragma unroll 1
            for (int i = 0; i < CH; ++i) {
                const float vt = sv[i * 128 + v]; float o = 0.f;
                const float* q_ = sq + i * DK + half * DH; const float* k_ = sk + i * DK + half * DH; const float* a_ = sa + i * DK + half * DH;
#pragma unroll
                for (int d = 0; d < DH; d += 4) {
                    const f32x4 q4 = *(const f32x4*)(q_ + d), k4 = *(const f32x4*)(k_ + d), a4 = *(const f32x4*)(a_ + d);
#pragma unroll
                    for (int e = 0; e < 4; ++e) { S[d + e] = a4[e] * S[d + e] + k4[e] * vt; o += q4[e] * S[d + e]; }
                }
                o += __shfl_xor(o, 1);
                const int row = row_of(dir, b, c0 + i);
                if (half == 0) p.O[((size_t)dir * NT + row) * 1024 + TYPE * 512 + h * 128 + v] = o;
            }
        }
    }
}
__device__ __forceinline__ void phase_rec0(const Params& p, unsigned char* lds) {
    const int nb = gridDim.x, b = blockIdx.x;
    if (nb >= 64) { if (b < 32) rec0_units<64, 0>(p, lds, b, 32); else if (b < 64) rec0_units<128, 1>(p, lds, b - 32, 32); }
    else { rec0_units<64, 0>(p, lds, b, nb); rec0_units<128, 1>(p, lds, b, nb); }
}

__device__ __forceinline__ void phase_readout0(const Params& p) {
    const int lane = threadIdx.x & 63, w = threadIdx.x >> 6;
    const int c = w * 128 + lane * 2;
    const float* gn = w < 4 ? p.gla_norm_g : p.hg_norm_g;
    const float g0 = gn[lane * 2], g1 = gn[lane * 2 + 1];
    const int goff = w < 4 ? (1024 + c) : (3616 + (c - 512));
    for (int r = blockIdx.x; r < NT; r += gridDim.x) {
        const float* o0 = p.O + (size_t)r * 1024 + c; const float* o1 = p.O + ((size_t)NT + r) * 1024 + c;
        const float a = o0[0] + o1[0], b = o0[1] + o1[1];
        const float ss = wave_sum(a * a + b * b);
        const float rs = rsqrtf(ss * (1.f / 128.f) + 1e-6f);
        const float* gp = p.P + (size_t)r * EVW + goff;
        const float y0 = a * rs * g0 * silu_f(gp[0]), y1 = b * rs * g1 * silu_f(gp[1]);
        *(unsigned*)(p.Y + (size_t)r * 1024 + c) = pk2(y0, y1);
    }
}

struct EpPre {
    const Params* p; int layer; int row0; int n0;
    __device__ __forceinline__ void operator()(const f32x4 (&acc)[4][4], int wm, int wn, int lane) const {
#pragma unroll
        for (int i = 0; i < 4; ++i) {
            const int row = row0 + EP_ROW(i);
            const float* xr = xin_row(*p, layer, row);
            const float* g1 = p->MOD + ((size_t)layer * 9 + row_mod(row)) * 6144 + 2048;
#pragma unroll
            for (int j = 0; j < 4; ++j) {
                const int col = n0 + EP_COL(j);
                const f32x4 xv = *(const f32x4*)(xr + col), gv = *(const f32x4*)(g1 + col);
                *(f32x4*)(p->PRE + (size_t)row * DM + col) = xv * DN_ALPHA + gv * acc[i][j];
            }
        }
    }
};
__device__ __forceinline__ void phase_outproj(const Params& p, unsigned char* lds, int layer) {
    const int rbase = layer == 0 ? 0 : NCTX; const int ntm = (NT - rbase) / 256; const int nunits = ntm * 8;
    const float* W = layer == 0 ? p.ev_w_out : p.od_w_out;
    for (int u = blockIdx.x; u < nunits; u += gridDim.x) {
        const int tm = u >> 3, tn = u & 7;
        ALoadBf al{p.Y, DM, rbase + tm * 256};
        BLoadF32 bl{W, DM, tn * 128, DM};
        EpPre ep{&p, layer, rbase + tm * 256, tn * 128};
        gemm_tile(al, bl, ep, 1024, lds);
    }
}

__device__ __forceinline__ void phase_ln1(const Params& p, int layer) {
    const int lane = threadIdx.x & 63, w = threadIdx.x >> 6;
    const int rbase = layer == 0 ? 0 : NCTX;
    const float* lg = p.ln1_g + layer * DM; const float* lb = p.ln1_b + layer * DM;
    for (int r = rbase + blockIdx.x * 8 + w; r < NT; r += gridDim.x * 8) {
        f32x4 v[4]; float s = 0.f;
#pragma unroll
        for (int i = 0; i < 4; ++i) { v[i] = *(const f32x4*)(p.PRE + (size_t)r * DM + i * 256 + lane * 4); s += (v[i][0] + v[i][1]) + (v[i][2] + v[i][3]); }
        const float mean = wave_sum(s) * (1.f / 1024.f); float q = 0.f;
#pragma unroll
        for (int i = 0; i < 4; ++i) { const f32x4 d = v[i] - mean; q += (d[0] * d[0] + d[1] * d[1]) + (d[2] * d[2] + d[3] * d[3]); }
        const float rstd = rsqrtf(wave_sum(q) * (1.f / 1024.f) + 1e-5f);
        const float* md = p.MOD + ((size_t)layer * 9 + row_mod(r)) * 6144;
#pragma unroll
        for (int i = 0; i < 4; ++i) {
            const int col = i * 256 + lane * 4;
            const f32x4 y = (v[i] - mean) * rstd * *(const f32x4*)(lg + col) + *(const f32x4*)(lb + col);
            *(f32x4*)(p.X1 + (size_t)r * DM + col) = y;
            const f32x4 uu = y * (*(const f32x4*)(md + 4096 + col) + 1.f) + *(const f32x4*)(md + 3072 + col);
            u32x2 wv; wv.x = pk2(uu[0], uu[1]); wv.y = pk2(uu[2], uu[3]);
            *(u32x2*)(p.U + (size_t)r * DM + col) = wv;
        }
    }
}

__device__ __forceinline__ void phase_router(const Params& p, unsigned char* lds, int layer) {
    const int rbase = layer == 0 ? 0 : NCTX; const int ntm = (NT - rbase) / 256; const int nunits = ntm * 2;
    for (int u = blockIdx.x; u < nunits; u += gridDim.x) {
        const int tm = u >> 1, tn = u & 1;
        ALoadBf al{p.U, DM, rbase + tm * 256};
        BLoadF32 bl{p.router_w + (size_t)layer * DM * 256, 256, tn * 128, 256};
        EpStoreF32 ep{p.LOGITS, 256, rbase + tm * 256, tn * 128, 256};
        gemm_tile(al, bl, ep, 1024, lds);
    }
}

__device__ __forceinline__ void phase_select(const Params& p, int layer) {
    const int lane = threadIdx.x & 63, w = threadIdx.x >> 6;
    const int rbase = layer == 0 ? 0 : NCTX; const int nrows = NT - rbase;
    const f32x4 bias = *(const f32x4*)(p.router_bias + layer * 256 + lane * 4);
    int* cnt = p.CNT + layer * 256;
    const float NEG = -__builtin_inff();
    for (int t = blockIdx.x * 8 + w; t < nrows; t += gridDim.x * 8) {
        const f32x4 lg = *(const f32x4*)(p.LOGITS + (size_t)(rbase + t) * 256 + lane * 4);
        float sc0 = sigmoid_f(lg[0]), sc1 = sigmoid_f(lg[1]), sc2 = sigmoid_f(lg[2]), sc3 = sigmoid_f(lg[3]);
        float s0 = sc0 + bias[0], s1 = sc1 + bias[1], s2 = sc2 + bias[2], s3 = sc3 + bias[3];
        float a = fmaxf(s0, s1), b = fminf(s0, s1), c = fmaxf(s2, s3), d = fminf(s2, s3);
        float m1 = fmaxf(a, c), m2 = fmaxf(fminf(a, c), fmaxf(b, d));
#pragma unroll
        for (int m = 1; m <= 4; m <<= 1) {
            const float o1 = __shfl_xor(m1, m), o2 = __shfl_xor(m2, m);
            const float n1 = fmaxf(m1, o1), n2 = fmaxf(fminf(m1, o1), fmaxf(m2, o2));
            m1 = n1; m2 = n2;
        }
        const float grp = m1 + m2; const int myg = lane >> 3; int rank = 0;
#pragma unroll
        for (int g = 0; g < 8; ++g) { const float sg = __shfl(grp, g * 8); rank += (sg > grp || (sg == grp && g < myg)) ? 1 : 0; }
        if (rank >= 4) { s0 = NEG; s1 = NEG; s2 = NEG; s3 = NEG; }
        int my_e = 0; float my_s = 0.f, gsum = 0.f;
#pragma unroll 1
        for (int k = 0; k < 8; ++k) {
            float lm = s0; int li = 0;
            if (s1 > lm) { lm = s1; li = 1; }
            if (s2 > lm) { lm = s2; li = 2; }
            if (s3 > lm) { lm = s3; li = 3; }
            const float wmx = wave_max(lm);
            const unsigned long long bal = __ballot(lm == wmx);
            const int win = __ffsll((long long)bal) - 1;
            const float mysc = li == 0 ? sc0 : (li == 1 ? sc1 : (li == 2 ? sc2 : sc3));
            const int e = win * 4 + __shfl(li, win);
            const float se = __shfl(mysc, win);
            if (lane == win) { if (li == 0) s0 = NEG; else if (li == 1) s1 = NEG; else if (li == 2) s2 = NEG; else s3 = NEG; }
            if (lane == k) { my_e = e; my_s = se; }
            gsum += se;
        }
        if (lane < 8) {
            const int pos = atomicAdd(&cnt[my_e], 1);
            const size_t o = (size_t)t * 8 + lane;
            p.EIDX[o] = my_e; p.GATE[o] = my_s / gsum * 2.5f; p.POS[o] = pos;
        }
    }
}

__device__ __forceinline__ void phase_offsets(const Params& p, unsigned char* lds, int layer) {
    int* offs = (int*)lds;
    const int tid = threadIdx.x;
    const int rbase = layer == 0 ? 0 : NCTX; const int nrows = NT - rbase;
    const int* cnt = p.CNT + layer * 256;
    __syncthreads();
    if (tid == 0) { int a = 0; for (int e = 0; e < 256; ++e) { offs[e] = a; a += (cnt[e] + 255) & ~255; } offs[256] = a; }
    __syncthreads();
    const int ntr = offs[256] >> 8;
    if (blockIdx.x == 0) {
        if (tid == 0) p.META[layer * 64] = ntr;
        for (int i = tid; i < ntr; i += NTHR) { int lo = 0, hi = 255; const int s = i * 256; while (lo < hi) { const int mid = (lo + hi + 1) >> 1; if (offs[mid] <= s) lo = mid; else hi = mid - 1; }
            p.TILE_E[i] = lo; }
    }
    for (int i = blockIdx.x * NTHR + tid; i < nrows * 8; i += gridDim.x * NTHR) {
        const int e = p.EIDX[i]; const int slot = offs[e] + p.POS[i];
        p.SLOT_TOK[slot] = rbase + (i >> 3); p.SLOT_GATE[slot] = p.GATE[i]; p.TOKSLOT[i] = slot;
    }
    for (int e = blockIdx.x; e < 256; e += gridDim.x) {
        const int c = cnt[e], pe = (c + 255) & ~255;
        for (int s = c + tid; s < pe; s += NTHR) { p.SLOT_TOK[offs[e] + s] = rbase; p.SLOT_GATE[offs[e] + s] = 0.f; }
    }
}

struct EpAct {
    bf16_t* ACT; int slot0; int nt;
    __device__ __forceinline__ void operator()(const f32x4 (&acc)[4][4], int wm, int wn, int lane) const {
#pragma unroll
        for (int i = 0; i < 4; ++i) {
            const int row = slot0 + EP_ROW(i);
#pragma unroll
            for (int j = 0; j < 2; ++j) {
                const int col = nt * 64 + wn * 32 + j * 16 + (lane >> 4) * 4;
                const f32x4 h1 = acc[i][j], h3 = acc[i][j + 2];
                u32x2 wv; wv.x = pk2(silu_f(h1[0]) * h3[0], silu_f(h1[1]) * h3[1]); wv.y = pk2(silu_f(h1[2]) * h3[2], silu_f(h1[3]) * h3[3]);
                *(u32x2*)(ACT + (size_t)row * 256 + col) = wv;
            }
        }
    }
};
__device__ __forceinline__ void phase_moe1(const Params& p, unsigned char* lds, int layer) {
    const int rbase = layer == 0 ? 0 : NCTX; const int nsh = (NT - rbase) / 256;
    const int ntr = p.META[layer * 64]; const int nunits = (ntr + nsh) * 4;
    for (int u = blockIdx.x; u < nunits; u += gridDim.x) {
        const int tile = u >> 2, nt = u & 3;
        EpAct ep{p.ACT, tile * 256, nt};
        if (tile < ntr) {
            const int e = p.TILE_E[tile];
            ALoadGather al{p.U, DM, p.SLOT_TOK + tile * 256};
            BLoadW13 bl{p.exp_w13 + ((size_t)layer * 256 + e) * (1024 * 512), nt};
            gemm_tile(al, bl, ep, 1024, lds);
        } else {
            ALoadBf al{p.U, DM, rbase + (tile - ntr) * 256};
            BLoadW13 bl{p.sh_w13 + (size_t)layer * (1024 * 512), nt};
            gemm_tile(al, bl, ep, 1024, lds);
        }
    }
}
struct EpYs {
    bf16_t* YS; const float* gate; int slot0; int n0;
    __device__ __forceinline__ void operator()(const f32x4 (&acc)[4][4], int wm, int wn, int lane) const {
#pragma unroll
        for (int i = 0; i < 4; ++i) {
            const int row = slot0 + EP_ROW(i); const float g = gate ? gate[row] : 1.f;
#pragma unroll
            for (int j = 0; j < 4; ++j) {
                const int col = n0 + EP_COL(j); const f32x4 v = acc[i][j] * g;
                u32x2 wv; wv.x = pk2(v[0], v[1]); wv.y = pk2(v[2], v[3]);
                *(u32x2*)(YS + (size_t)row * DM + col) = wv;
            }
        }
    }
};
__device__ __forceinline__ void phase_moe2(const Params& p, unsigned char* lds, int layer) {
    const int rbase = layer == 0 ? 0 : NCTX; const int nsh = (NT - rbase) / 256;
    const int ntr = p.META[layer * 64]; const int nunits = (ntr + nsh) * 8;
    for (int u = blockIdx.x; u < nunits; u += gridDim.x) {
        const int tile = u >> 3, tn = u & 7;
        ALoadBf al{p.ACT, 256, tile * 256};
        if (tile < ntr) {
            const int e = p.TILE_E[tile];
            BLoadF32 bl{p.exp_w2 + ((size_t)layer * 256 + e) * (256 * 1024), DM, tn * 128, DM};
            EpYs ep{p.YS, p.SLOT_GATE, tile * 256, tn * 128};
            gemm_tile(al, bl, ep, 256, lds);
        } else {
            BLoadF32 bl{p.sh_w2 + (size_t)layer * (256 * 1024), DM, tn * 128, DM};
            EpYs ep{p.YS, nullptr, tile * 256, tn * 128};
            gemm_tile(al, bl, ep, 256, lds);
        }
    }
}
__device__ __forceinline__ void phase_combine(const Params& p, int layer) {
    const int lane = threadIdx.x & 63, w = threadIdx.x >> 6;
    const int rbase = layer == 0 ? 0 : NCTX; const int nrows = NT - rbase;
    const int ntr = p.META[layer * 64];
    const float* lg = p.ln2_g + layer * DM; const float* lb = p.ln2_b + layer * DM;
    for (int t = blockIdx.x * 8 + w; t < nrows; t += gridDim.x * 8) {
        const int r = rbase + t;
        int myslot = 0; if (lane < 8) myslot = p.TOKSLOT[(size_t)t * 8 + lane]; if (lane == 8) myslot = ntr * 256 + t;
        f32x4 mo[4];
#pragma unroll
        for (int i = 0; i < 4; ++i) mo[i] = (f32x4){0.f, 0.f, 0.f, 0.f};
#pragma unroll 1
        for (int k = 0; k < 9; ++k) {
            const int slot = __shfl(myslot, k);
            const bf16_t* yr = p.YS + (size_t)slot * DM;
#pragma unroll
            for (int i = 0; i < 4; ++i) { const u32x2 wv = *(const u32x2*)(yr + i * 256 + lane * 4);
                mo[i][0] += __uint_as_float(wv.x << 16); mo[i][1] += __uint_as_float(wv.x & 0xffff0000u); mo[i][2] += __uint_as_float(wv.y << 16); mo[i][3] += __uint_as_float(wv.y & 0xffff0000u); }
        }
        const float* md = p.MOD + ((size_t)layer * 9 + row_mod(r)) * 6144 + 5120;
        f32x4 v[4]; float s = 0.f;
#pragma unroll
        for (int i = 0; i < 4; ++i) { const int col = i * 256 + lane * 4; v[i] = *(const f32x4*)(p.X1 + (size_t)r * DM + col) * DN_ALPHA + *(const f32x4*)(md + col) * mo[i]; s += (v[i][0] + v[i][1]) + (v[i][2] + v[i][3]); }
        const float mean = wave_sum(s) * (1.f / 1024.f); float q = 0.f;
#pragma unroll
        for (int i = 0; i < 4; ++i) { const f32x4 d = v[i] - mean; q += (d[0] * d[0] + d[1] * d[1]) + (d[2] * d[2] + d[3] * d[3]); }
        const float rstd = rsqrtf(wave_sum(q) * (1.f / 1024.f) + 1e-5f);
        float* dst = layer == 0 ? p.X2 + (size_t)r * DM : p.out + (size_t)t * DM;
#pragma unroll
        for (int i = 0; i < 4; ++i) { const int col = i * 256 + lane * 4; f32x4 ov = (v[i] - mean) * rstd * *(const f32x4*)(lg + col) + *(const f32x4*)(lb + col);
#ifdef SANITIZE
            for (int e = 0; e < 4; ++e) { float z = ov[e]; if (!(fabsf(z) < 1e4f)) z = 100.f; ov[e] = z; }
#endif
            *(f32x4*)(dst + col) = ov; }
    }
}

__device__ __forceinline__ void phase_shortconv(const Params& p) {
    for (size_t i = (size_t)blockIdx.x * NTHR + threadIdx.x; i < (size_t)NLAT * 1536; i += (size_t)gridDim.x * NTHR) {
        const int c = (int)(i % 1536); const int q = (int)(i / 1536); const int t = q & 4095;
        const float* pr = p.P + (size_t)(NCTX + q) * ODW + c;
        float s = p.hy_conv_b[c] + pr[0] * p.hy_conv_w[1536 + c];
        if (t > 0) s += pr[-ODW] * p.hy_conv_w[c];
        if (t < 4095) s += pr[ODW] * p.hy_conv_w[2 * 1536 + c];
        p.UH[i] = s;
    }
}
template <int ORD>
__device__ __forceinline__ void hyconv_naive(const Params& p) {
    const int lane = threadIdx.x & 63, w = threadIdx.x >> 6;
    for (int u = blockIdx.x; u < 8 * 128 * 8; u += gridDim.x) {
        const int ct = u & 7, tt = (u >> 3) & 127, b = u >> 10;
        const int c = ct * 64 + lane, t0 = tt * 32 + w * 4;
        const float* Gc = p.G + (size_t)ORD * 8192 * 512 + c;
        const float* uin = ORD == 0 ? p.UH + (size_t)b * 4096 * 1536 + c : p.Z1 + (size_t)b * 4096 * 512 + c;
        const int ustr = ORD == 0 ? 1536 : 512;
        float w0 = Gc[(size_t)(t0 + 4096) * 512], w1 = Gc[(size_t)(t0 + 4097) * 512], w2 = Gc[(size_t)(t0 + 4098) * 512], w3 = Gc[(size_t)(t0 + 4099) * 512];
        float a0 = 0.f, a1 = 0.f, a2 = 0.f, a3 = 0.f;
        const float* gp = Gc + (size_t)(t0 + 4095) * 512;
#pragma unroll 4
        for (int s = 0; s < 4096; ++s) {
            const float uv = uin[(size_t)s * ustr];
            const float wn = *gp; gp -= 512;
            a0 += w0 * uv; a1 += w1 * uv; a2 += w2 * uv; a3 += w3 * uv;
            w3 = w2; w2 = w1; w1 = w0; w0 = wn;
        }
        const float bias = p.hy_bias[ORD * 512 + c];
        float acc[4] = {a0, a1, a2, a3};
#pragma unroll
        for (int j = 0; j < 4; ++j) {
            const int t = t0 + j;
            const float gate = p.UH[((size_t)b * 4096 + t) * 1536 + 512 * (ORD + 1) + c];
            const float val = gate * (acc[j] + uin[(size_t)t * ustr] * bias);
            if (ORD == 0) p.Z1[((size_t)b * 4096 + t) * 512 + c] = val;
            else p.Y[(size_t)(NCTX + b * 4096 + t) * DM + c] = f2bf(val);
        }
    }
}
__device__ __forceinline__ void phase_rwstreams(const Params& p, unsigned char* lds) {
    float* pm = (float*)lds;
    const int tid = threadIdx.x;
    for (int tile = blockIdx.x; tile < NT / 8; tile += gridDim.x) {
        const int r0 = tile * 8;
        __syncthreads();
        for (int e = tid; e < 8 * 1856; e += NTHR) {
            const int i = e / 1856, c = e % 1856; const int r = r0 + i;
            int rs = -1;
            if (r < NCTX) { const int t = r & 255; if ((c & 1) == 0) { if (t > 0) rs = r - 1; } else { if (t < 255) rs = r + 1; } }
            else { const int t = (r - NCTX) & 4095, gr = t >> 6, gc = t & 63, m = c & 3;
                if (m == 0) { if (gc > 0) rs = r - 1; } else if (m == 1) { if (gc < 63) rs = r + 1; } else if (m == 2) { if (gr > 0) rs = r - 64; } else { if (gr < 63) rs = r + 64; } }
            const float pv = p.P[(size_t)r * ODW + 1536 + c];
            const float ps = rs >= 0 ? p.P[(size_t)rs * ODW + 1536 + c] : 0.f;
            pm[e] = pv + p.rw_mu[c] * (ps - pv);
        }
        __syncthreads();
        for (int e = tid; e < 8 * 320; e += NTHR) {
            const int i = e / 320, c = 1536 + e % 320; float v = pm[i * 1856 + c];
            if (c < 1664) v = tanhf(v); else if (c >= 1728) v = sigmoid_f(v);
            pm[i * 1856 + c] = v;
        }
        __syncthreads();
        const int c = tid;
        float awf[8], awb[8], aa[8], ag[8];
#pragma unroll
        for (int i = 0; i < 8; ++i) { awf[i] = 0.f; awb[i] = 0.f; aa[i] = 0.f; ag[i] = 0.f; }
        for (int k = 0; k < 64; ++k) {
            const float wf = p.rw_w2[(size_t)k * 512 + c], wb = p.rw_w2[(size_t)(64 + k) * 512 + c], a2 = p.rw_a2[(size_t)k * 512 + c];
#pragma unroll
            for (int i = 0; i < 8; ++i) { awf[i] += pm[i * 1856 + 1536 + k] * wf; awb[i] += pm[i * 1856 + 1600 + k] * wb; aa[i] += pm[i * 1856 + 1664 + k] * a2; }
        }
        for (int k = 0; k < 128; ++k) {
            const float g2 = p.rw_g2[(size_t)k * 512 + c];
#pragma unroll
            for (int i = 0; i < 8; ++i) ag[i] += pm[i * 1856 + 1728 + k] * g2;
        }
        const float w0f = p.rw_w0[c], w0b = p.rw_w0[512 + c], a0 = p.rw_a0[c], kkw = p.rw_k_k[c], kaw = p.rw_k_a[c];
#pragma unroll
        for (int i = 0; i < 8; ++i) {
            const size_t o = (size_t)(r0 + i) * 512 + c;
            const float wf = logsigmoid_f(w0f + awf[i]) - 0.5f, wb = logsigmoid_f(w0b + awb[i]) - 0.5f;
            p.DEC[o] = expf(-expf(wf)); p.DEC[(size_t)NT * 512 + o] = expf(-expf(wb));
            const float a = sigmoid_f(a0 + aa[i]);
            const float k = pm[i * 1856 + 512 + c];
            const float kr = k * kkw; const float ss = wave_sum(kr * kr);
            const float kk = kr / fmaxf(sqrtf(ss), 1e-12f);
            p.KK[o] = kk; p.BV[o] = kk * a; p.KP[o] = k * (1.f + (a - 1.f) * kaw);
            p.RR[o] = pm[i * 1856 + c]; p.VV[o] = pm[i * 1856 + 1024 + c]; p.GT[o] = ag[i];
        }
    }
}
__device__ __forceinline__ void phase_rwscan(const Params& p, unsigned char* lds) {
    constexpr int CH = 4;
    const int lane = threadIdx.x & 63, w = threadIdx.x >> 6;
    float* st = (float*)lds + w * (CH * 5 * 64);
    for (int ug = blockIdx.x; ug < 16; ug += gridDim.x) {
        const int unit = ug * 8 + w; const int dir = unit >> 6, b = (unit >> 3) & 7, h = unit & 7;
        float S[64];
#pragma unroll
        for (int k = 0; k < 64; ++k) S[k] = 0.f;
        for (int c0 = 0; c0 < CTXL + SEQ; c0 += CH) {
            __syncthreads();
#pragma unroll
            for (int i = 0; i < CH; ++i) {
                const size_t o = (size_t)row_of(dir, b, c0 + i) * 512 + h * 64 + lane;
                st[(i * 5 + 0) * 64 + lane] = p.DEC[(size_t)dir * NT * 512 + o];
                st[(i * 5 + 1) * 64 + lane] = p.KP[o];
                st[(i * 5 + 2) * 64 + lane] = p.KK[o];
                st[(i * 5 + 3) * 64 + lane] = p.BV[o];
                st[(i * 5 + 4) * 64 + lane] = p.RR[o];
            }
            __syncthreads();
#pragma unroll 1
            for (int i = 0; i < CH; ++i) {
                const int row = row_of(dir, b, c0 + i);
                const float vt = p.VV[(size_t)row * 512 + h * 64 + lane];
                const float* sd = st + (i * 5) * 64;
                float dot = 0.f;
#pragma unroll
                for (int k = 0; k < 64; k += 4) { const f32x4 kk4 = *(const f32x4*)(sd + 128 + k);
#pragma unroll
                    for (int e = 0; e < 4; ++e) dot += S[k + e] * kk4[e]; }
                float o = 0.f;
#pragma unroll
                for (int k = 0; k < 64; k += 4) {
                    const f32x4 d4 = *(const f32x4*)(sd + k), kp4 = *(const f32x4*)(sd + 64 + k), b4 = *(const f32x4*)(sd + 192 + k), r4 = *(const f32x4*)(sd + 256 + k);
#pragma unroll
                    for (int e = 0; e < 4; ++e) { S[k + e] = S[k + e] * d4[e] - dot * b4[e] + vt * kp4[e]; o += S[k + e] * r4[e]; }
                }
                if (c0 + i >= CTXL) p.O[((size_t)dir * NT + row) * 512 + h * 64 + lane] = o;
            }
        }
    }
}
__device__ __forceinline__ void phase_readout1(const Params& p) {
    const int lane = threadIdx.x & 63, h = threadIdx.x >> 6;
    const float lg = p.rw_ln_g[h * 64 + lane], lb = p.rw_ln_b[h * 64 + lane], rk = p.rw_r_k[h * 64 + lane];
    for (int r = NCTX + blockIdx.x; r < NT; r += gridDim.x) {
        const size_t o = (size_t)r * 512 + h * 64 + lane;
        const float ov = p.O[o] + p.O[(size_t)NT * 512 + o];
        const float mean = wave_sum(ov) * (1.f / 64.f); const float d = ov - mean;
        const float var = wave_sum(d * d) * (1.f / 64.f);
        const float on = d * rsqrtf(var + 64e-5f) * lg + lb;
        const float bonus = wave_sum(p.RR[o] * p.KP[o] * rk) * p.VV[o];
        p.Y[(size_t)r * DM + 512 + h * 64 + lane] = f2bf((on + bonus) * p.GT[o]);
    }
}

#ifdef PROBE_BUF
__global__ void __launch_bounds__(NTHR) k_probe(Params p) { for (size_t i = (size_t)blockIdx.x * NTHR + threadIdx.x; i < (size_t)NLAT * DM; i += (size_t)gridDim.x * NTHR) {
        float z;
#if PROBE_KIND == 1
        const unsigned q = ((unsigned)i >> 1); z = 0.f; if (q < (unsigned)(NT * 8)) z = (i & 1) ? p.GATE[q] : (float)p.EIDX[q];
#elif PROBE_KIND == 2
        const unsigned q = (unsigned)i; const unsigned ts = q >> 8; z = bf2f(p.ACT[(size_t)p.TOKSLOT[ts] * 256 + (q & 255)]);
#elif PROBE_KIND == 4
        const unsigned q = (unsigned)i; const unsigned ts = q >> 10; z = bf2f(p.YS[((size_t)p.META[0] * 256 + ts) * 1024 + (q & 1023)]);
#elif PROBE_KIND == 6
        const unsigned q = (unsigned)i; const unsigned ts = q >> 8; z = 0.f; if (ts < NT) z = bf2f(p.ACT[((size_t)p.META[0] * 256 + ts) * 256 + (q & 255)]);
#elif PROBE_KIND == 7
        const unsigned q = (unsigned)i; z = 0.f; if (q < 2u * 256u * 1024u) z = p.sh_w2[q]; else if (q < 2u * 256u * 1024u + 2u * 1024u * 512u) z = p.sh_w13[q - 2u * 256u * 1024u];
#elif PROBE_KIND == 5
        const unsigned q = (unsigned)i; const unsigned ts = (q >> 10) * 8 + 3; z = bf2f(p.YS[(size_t)p.TOKSLOT[ts] * 1024 + (q & 1023)]);
#elif PROBE_KIND == 3
        const unsigned q = (unsigned)i; const unsigned ts = q >> 8; z = bf2f(p.YS[(size_t)p.TOKSLOT[ts] * 1024 + (q & 255)]);
#else
        const float* src = (const float*)p.PROBE_BUF; z = src[i + PROBE_OFF];
#endif
        if (!(fabsf(z) < 1e4f)) z = 100.f; p.out[i] = z; } }
#endif

#define XB_TMO      128
#define XB_XCNT(j)  (256  + 64 * (j))
#define XB_XSUB(j)  (1280 + 64 * (j))
#define XB_XGEN(j)  (2304 + 64 * (j))
#define XB_TOP      3328
#define XB_TOPGEN   3392
#define XCD_BAR_WORDS 3456
#define XB_SPIN_CAP (1u << 18)
#define LAS __attribute__((address_space(3)))

__device__ __forceinline__ unsigned xb_ld(unsigned* p)              { return __hip_atomic_load(p, __ATOMIC_RELAXED, __HIP_MEMORY_SCOPE_AGENT); }
__device__ __forceinline__ unsigned xb_add(unsigned* p, unsigned v) { return __hip_atomic_fetch_add(p, v, __ATOMIC_RELAXED, __HIP_MEMORY_SCOPE_AGENT); }
__device__ __forceinline__ unsigned xb_xcc_id() { return (unsigned)__builtin_amdgcn_s_getreg((3 << 11) | 20) & 0xFu; }
#define XB_SPIN(cond, bar) do { unsigned _sp = 0; while (cond) { __builtin_amdgcn_s_sleep(1); \
    if ((++_sp & 255u) == 0u) { if (xb_ld(&(bar)[XB_TMO])) break; if (_sp > XB_SPIN_CAP) { atomicAdd(&(bar)[XB_TMO], 1u); break; } } } } while (0)

struct XcdBarrier {
    unsigned* bar; unsigned x;
    volatile LAS unsigned* st;
};

__device__ __forceinline__ XcdBarrier xcd_barrier_post(unsigned* bar, volatile LAS unsigned* st) {
    XcdBarrier b; b.bar = bar; b.x = xb_xcc_id(); b.st = st;
    if (threadIdx.x == 0) (void)xb_add(&bar[XB_XCNT(b.x)], 1u);
    return b;
}
__device__ __forceinline__ void xcd_barrier_complete(unsigned* bar, unsigned x, unsigned& nloc, unsigned& nx) {
    const unsigned G = gridDim.x * gridDim.y * gridDim.z;
    unsigned sum, cnt, mine, sp = 0u;
    for (;;) {
        sum = 0u; cnt = 0u; mine = 0u;
#pragma unroll
        for (unsigned j = 0; j < 16; ++j) { const unsigned c = xb_ld(&bar[XB_XCNT(j)]); sum += c; cnt += (c > 0u) ? 1u : 0u; mine = (j == x) ? c : mine; }
        if (sum == G) break;
        __builtin_amdgcn_s_sleep(1);
        if ((++sp & 255u) == 0u) { if (xb_ld(&bar[XB_TMO])) break; if (sp > XB_SPIN_CAP) { atomicAdd(&bar[XB_TMO], 1u); break; } }
    }
    nloc = mine > 0u ? mine : 1u; nx = cnt > 0u ? cnt : 1u;
}

__device__ __forceinline__ void xcd_barrier(const XcdBarrier& b) {
    asm volatile("s_waitcnt vmcnt(0)" ::: "memory");
    __syncthreads();
    if (threadIdx.x == 0) {
        unsigned* bar = b.bar;
        __builtin_amdgcn_s_waitcnt(0);
        unsigned nloc = b.st[0], nx = b.st[1];
        if (nloc == 0u) { xcd_barrier_complete(bar, b.x, nloc, nx); b.st[0] = nloc; b.st[1] = nx; }
        const unsigned old = xb_add(&bar[XB_XSUB(b.x)], 1u);
        const unsigned gen = old / nloc;
        if (old + 1u == (gen + 1u) * nloc) {
            __builtin_amdgcn_fence(__ATOMIC_RELEASE, "agent");
            asm volatile("s_waitcnt vmcnt(0)" ::: "memory");
            const unsigned og = xb_add(&bar[XB_TOP], 1u);
            const unsigned tg = og / nx;
            if (og + 1u == (tg + 1u) * nx) xb_add(&bar[XB_TOPGEN], 1u);
            else XB_SPIN(xb_ld(&bar[XB_TOPGEN]) == tg, bar);
            __builtin_amdgcn_fence(__ATOMIC_ACQUIRE, "agent");
            xb_add(&bar[XB_XGEN(b.x)], 1u);
            asm volatile("s_waitcnt vmcnt(0)" ::: "memory");
        } else {
            XB_SPIN(xb_ld(&bar[XB_XGEN(b.x)]) == gen, bar);
            __builtin_amdgcn_fence(__ATOMIC_ACQUIRE, "agent");
            asm volatile("s_waitcnt vmcnt(0)" ::: "memory");
        }
    }
    __syncthreads();
}


__global__ void __launch_bounds__(NTHR, 2) k_fwd(Params p_, int lo, int hi) {
#if defined(__HIP_DEVICE_COMPILE__)
    typedef const __attribute__((address_space(4))) Params* KP;
    const KP kp0 = (KP)__builtin_amdgcn_kernarg_segment_ptr();
#define LOADP KP kq = kp0; asm volatile("" : "+s"(kq)); Params p; __builtin_memcpy(&p, kq, sizeof(Params));
#else
#define LOADP const Params& p = p_;
#endif
    extern __shared__ __attribute__((aligned(16))) unsigned char lds[];
    __shared__ uint4 xb_words;
    if (threadIdx.x == 0) xb_words = make_uint4(0u, 0u, 0u, 0u);
    __syncthreads();
    XcdBarrier bar; bar.bar = nullptr; bar.x = 0; bar.st = nullptr;
#if defined(__HIP_DEVICE_COMPILE__)
    if (hi - lo > 1) bar = xcd_barrier_post((unsigned*)kp0->BAR, (volatile LAS unsigned*)&xb_words);
#endif
#define SEAM(k) if (lo <= (k) && (k) + 1 < hi) xcd_barrier(bar);
#ifndef ONLY
#define ONLY -1
#endif
#define IN(k) ((ONLY < 0 || ONLY == (k)) && lo <= (k) && (k) < hi)
    if (IN(0)) { LOADP if (blockIdx.x == 0) { for (int e = threadIdx.x; e < 512; e += NTHR) p.CNT[e] = 0; if (threadIdx.x < 128) p.META[threadIdx.x] = 0; } phase_mod(p, lds); phase_filt(p, lds); } SEAM(0)
    if (IN(1)) { LOADP phase_inproj(p, lds, 0); } SEAM(1)
    if (IN(2)) { LOADP phase_gate(p); } SEAM(2)
    if (IN(3)) { LOADP phase_rec0(p, lds); } SEAM(3)
    if (IN(4)) { LOADP phase_readout0(p); } SEAM(4)
    if (IN(5)) { LOADP phase_outproj(p, lds, 0); } SEAM(5)
    if (IN(6)) { LOADP phase_ln1(p, 0); } SEAM(6)
    if (IN(7)) { LOADP phase_router(p, lds, 0); } SEAM(7)
    if (IN(8)) { LOADP phase_select(p, 0); } SEAM(8)
    if (IN(9)) { LOADP phase_offsets(p, lds, 0); } SEAM(9)
    if (IN(10)) { LOADP phase_moe1(p, lds, 0); } SEAM(10)
    if (IN(11)) { LOADP phase_moe2(p, lds, 0); } SEAM(11)
    if (IN(12)) { LOADP phase_combine(p, 0); } SEAM(12)
    if (IN(13)) { LOADP phase_inproj(p, lds, 1); } SEAM(13)
    if (IN(14)) { LOADP phase_shortconv(p); phase_rwstreams(p, lds); } SEAM(14)
    if (IN(15)) { LOADP hyconv_naive<0>(p); } SEAM(15)
    if (IN(16)) { LOADP hyconv_naive<1>(p); } SEAM(16)
    if (IN(17)) { LOADP phase_rwscan(p, lds); } SEAM(17)
    if (IN(18)) { LOADP phase_readout1(p); } SEAM(18)
    if (IN(19)) { LOADP phase_outproj(p, lds, 1); } SEAM(19)
    if (IN(20)) { LOADP phase_ln1(p, 1); } SEAM(20)
    if (IN(21)) { LOADP phase_router(p, lds, 1); } SEAM(21)
    if (IN(22)) { LOADP phase_select(p, 1); } SEAM(22)
    if (IN(23)) { LOADP phase_offsets(p, lds, 1); } SEAM(23)
    if (IN(24)) { LOADP phase_moe1(p, lds, 1); } SEAM(24)
    if (IN(25)) { LOADP phase_moe2(p, lds, 1); } SEAM(25)
    if (IN(26)) { LOADP phase_combine(p, 1); } SEAM(26)
#undef IN
}
#define N_PHASES 27
#define LDS_BYTES 65536

extern "C" void kernel_launch(void* const* d_in, const int* in_sizes, int n_in, void* d_out, int out_size, void* d_ws, size_t ws_size, hipStream_t stream) {
    Params p;
    memset(&p, 0, sizeof(p));
    if (n_in != 45) { fprintf(stderr, "kernel_launch: expected 45 inputs, got %d\n", n_in); return; }
    const float** pin = (const float**)&p;
    for (int i = 0; i < 45; ++i) pin[i] = (const float*)d_in[i];
    p.out = (float*)d_out;
    size_t off = 0;
    unsigned char* ws = (unsigned char*)d_ws;
    auto take = [&](size_t bytes) { void* r = ws + off; off += (bytes + 255) & ~(size_t)255; return r; };
    p.BAR = (unsigned*)take(16384);
    p.CNT = (int*)take(2 * 256 * 4);
    p.META = (int*)take(2 * 64 * 4);
    const size_t zero_bytes = off;
    p.MOD = (float*)take((size_t)2 * 9 * 6144 * 4);
    p.G = (float*)take((size_t)2 * 8192 * 512 * 4);
    p.P = (float*)take((size_t)NT * EVW * 4);
    p.LA = (float*)take((size_t)2 * NT * 256 * 4);
    p.O = (float*)take((size_t)2 * NT * 1024 * 4);
    p.Y = (bf16_t*)take((size_t)NT * 1024 * 2);
    p.PRE = (float*)take((size_t)NT * 1024 * 4);
    p.X1 = (float*)take((size_t)NT * 1024 * 4);
    p.U = (bf16_t*)take((size_t)NT * 1024 * 2);
    p.LOGITS = (float*)take((size_t)NT * 256 * 4);
    p.EIDX = (int*)take((size_t)NT * 8 * 4); p.GATE = (float*)take((size_t)NT * 8 * 4); p.POS = (int*)take((size_t)NT * 8 * 4); p.TOKSLOT = (int*)take((size_t)NT * 8 * 4);
    p.TILE_E = (int*)take(2048 * 4);
    p.SLOT_TOK = (int*)take((size_t)MAXSLOT * 4); p.SLOT_GATE = (float*)take((size_t)MAXSLOT * 4);
    p.ACT = (bf16_t*)take((size_t)MAXSLOT * 256 * 2);
    p.YS = (bf16_t*)take((size_t)MAXSLOT * 1024 * 2);
    p.X2 = (float*)take((size_t)NT * 1024 * 4);
    p.UH = (float*)take((size_t)NLAT * 1536 * 4);
    p.Z1 = (float*)take((size_t)NLAT * 512 * 4);
    p.RR = (float*)take((size_t)NT * 512 * 4); p.KP = (float*)take((size_t)NT * 512 * 4); p.VV = (float*)take((size_t)NT * 512 * 4);
    p.KK = (float*)take((size_t)NT * 512 * 4); p.BV = (float*)take((size_t)NT * 512 * 4); p.GT = (float*)take((size_t)NT * 512 * 4);
    p.DEC = (float*)take((size_t)2 * NT * 512 * 4);
    if (off > ws_size) { fprintf(stderr, "kernel_launch: workspace too small: need %zu, have %zu\n", off, ws_size); return; }
    static bool attr_done = false;
    if (!attr_done) { (void)hipFuncSetAttribute((const void*)k_fwd, hipFuncAttributeMaxDynamicSharedMemorySize, LDS_BYTES); attr_done = true; }
    (void)hipMemsetAsync(d_ws, 0, zero_bytes, stream);
#ifdef PROBE_BUF
    for (int ph = 0; ph <= PROBE_UPTO; ++ph) hipLaunchKernelGGL(k_fwd, dim3(256), dim3(NTHR), LDS_BYTES, stream, p, ph, ph + 1);
    hipLaunchKernelGGL(k_fwd, dim3(256), dim3(NTHR), LDS_BYTES, stream, p, 98, 99);
    hipLaunchKernelGGL(k_fwd, dim3(256), dim3(NTHR), LDS_BYTES, stream, p, 98, 99);
    hipLaunchKernelGGL(k_probe, dim3(1024), dim3(NTHR), 0, stream, p);
#else
#ifdef MULTI_LAUNCH
    for (int ph = 0; ph < N_PHASES; ++ph) {
        hipLaunchKernelGGL(k_fwd, dim3(256), dim3(NTHR), LDS_BYTES, stream, p, ph, ph + 1);
    }
#else
    static int grid = 0;
    if (grid == 0) {
        int dev = 0, cus = 0, per_cu = 0;
        (void)hipGetDevice(&dev); (void)hipDeviceGetAttribute(&cus, hipDeviceAttributeMultiprocessorCount, dev);
        if (hipOccupancyMaxActiveBlocksPerMultiprocessor(&per_cu, (const void*)k_fwd, NTHR, LDS_BYTES) != hipSuccess || per_cu < 1) { fprintf(stderr, "kernel_launch: occupancy query says %d blocks per CU\n", per_cu); per_cu = 1; }
        (void)hipGetLastError();
        grid = cus > 0 ? cus : 256;
    }
    hipLaunchKernelGGL(k_fwd, dim3(grid), dim3(NTHR), LDS_BYTES, stream, p, 0, N_PHASES);
#endif
#endif
}
```

```cpp
#include <hip/hip_runtime.h>
#include <stdint.h>
#include <stdio.h>
#include <string.h>

typedef unsigned short bf16_t;
typedef short bf16x8 __attribute__((ext_vector_type(8)));
typedef float f32x4 __attribute__((ext_vector_type(4)));
typedef unsigned u32x4 __attribute__((ext_vector_type(4)));
typedef unsigned u32x2 __attribute__((ext_vector_type(2)));

#define NTHR 512
#define DM 1024
#define NB 8
#define SEQ 4096
#define CTXL 256
#define NCTX (NB * CTXL)
#define NLAT (NB * SEQ)
#define NT (NCTX + NLAT)
#define EVW 4128
#define ODW 3392
#define MAXSLOT 378880
#define DN_ALPHA 1.41421356237f
#define NPHASE 40

typedef float __attribute__((ext_vector_type(2)))* f32x2_p;
struct Params {
    const float *x, *c, *ctx, *c_ctx, *mod_w, *mod_b, *ln1_g, *ln1_b, *ln2_g, *ln2_b;
    const float *ev_w_in, *ev_w_out, *gla_gate_w2, *gla_gate_b, *gla_norm_g, *hg_lb_logits, *hg_norm_g;
    const float *od_w_in, *od_w_out, *hy_conv_w, *hy_conv_b, *hy_ffn_w1, *hy_ffn_b1, *hy_ffn_w2, *hy_ffn_b2, *hy_ffn_w3, *hy_sin_freq, *hy_bias;
    const float *rw_mu, *rw_w0, *rw_w2, *rw_a0, *rw_a2, *rw_g2, *rw_k_k, *rw_k_a, *rw_r_k, *rw_ln_g, *rw_ln_b;
    const float *router_w, *router_bias, *exp_w13, *exp_w2, *sh_w13, *sh_w2;
    float* out;
    float* MOD;
    float* G;
    bf16_t* P;
    float* LA;
    float* O;
    bf16_t* Y;
    float* PRE;
    float* X1;
    bf16_t* U;
    float* LOGITS;
    int* EIDX; float* GATE; int* POS; int* TOKSLOT;
    int* CNT;
    int* META;
    int* TILE_E;
    int* SLOT_TOK; float* SLOT_GATE;
    bf16_t* ACT;
    bf16_t* YS;
    float* X2;
    f32x2_p FF;
    float* UH;
    float* Z1;
    bf16_t *RR, *KP, *VV, *KK, *BV, *GT;
    float* DEC;
    bf16_t *GMT, *QMT, *HMB, *OMB;
    bf16_t* HIN;
    bf16_t *WT_RWF, *WT_RWB, *WT_RWA, *WT_RWG;
    bf16_t *WT_EVIN, *WT_EVOUT, *WT_ODIN, *WT_ODOUT, *WT_ROUT, *WT_SH13, *WT_SH2, *WT_W13, *WT_W2;
    unsigned* BAR;
};

typedef float f32x2_t __attribute__((ext_vector_type(2)));
typedef __bf16 bf16x2_t __attribute__((ext_vector_type(2)));
__device__ __forceinline__ unsigned pk2(float lo, float hi) { const f32x2_t v = {lo, hi}; return __builtin_bit_cast(unsigned, __builtin_convertvector(v, bf16x2_t)); }
__device__ __forceinline__ bf16x8 pack8(f32x4 a, f32x4 b) { u32x4 w; w.x = pk2(a[0], a[1]); w.y = pk2(a[2], a[3]); w.z = pk2(b[0], b[1]); w.w = pk2(b[2], b[3]); return __builtin_bit_cast(bf16x8, w); }
__device__ __forceinline__ float bf2f(bf16_t h) { return __uint_as_float((unsigned)h << 16); }
__device__ __forceinline__ f32x4 bf4_to_f32(u32x2 w) { return (f32x4){__uint_as_float(w.x << 16), __uint_as_float(w.x & 0xffff0000u), __uint_as_float(w.y << 16), __uint_as_float(w.y & 0xffff0000u)}; }
__device__ __forceinline__ u32x2 f32_to_bf4(f32x4 v) { u32x2 w; w.x = pk2(v[0], v[1]); w.y = pk2(v[2], v[3]); return w; }
__device__ __forceinline__ bf16_t f2bf(float f) { return (bf16_t)(pk2(f, 0.f) & 0xffffu); }
__device__ __forceinline__ float sigmoid_f(float x) { return 1.f / (1.f + expf(-x)); }
__device__ __forceinline__ float silu_f(float x) { return x / (1.f + expf(-x)); }
__device__ __forceinline__ float logsigmoid_f(float x) { return x >= 0.f ? -log1pf(expf(-x)) : x - log1pf(expf(x)); }
__device__ __forceinline__ float wave_sum(float v) {
#pragma unroll
    for (int m = 32; m >= 1; m >>= 1) v += __shfl_xor(v, m);
    return v;
}
__device__ __forceinline__ float wave_max(float v) {
#pragma unroll
    for (int m = 32; m >= 1; m >>= 1) v = fmaxf(v, __shfl_xor(v, m));
    return v;
}
__device__ __forceinline__ int row_of(int dir, int b, int s) {
    if (s < CTXL) { const int pos = dir ? (CTXL - 1 - s) : s; return b * CTXL + pos; }
    const int q = s - CTXL; const int pos = dir ? (SEQ - 1 - q) : q; return NCTX + b * SEQ + pos;
}
__device__ __forceinline__ int row_mod(int r) { return r < NCTX ? 8 : ((r - NCTX) >> 12); }
__device__ __forceinline__ const float* xin_row(const Params& p, int layer, int r) {
    if (layer == 0) return r < NCTX ? p.ctx + (size_t)r * DM : p.x + (size_t)(r - NCTX) * DM;
    return p.X2 + (size_t)r * DM;
}

#define LSTR 72
#define GEMM_LDS_BYTES (2 * (256 + 128) * LSTR * 2)
template <class AL, class BL, class EP>
__device__ __forceinline__ void gemm_tile(const AL& al, const BL& bl, const EP& ep, const int K, unsigned char* lds) {
    bf16_t* As0 = (bf16_t*)lds;
    bf16_t* Bs0 = As0 + 2 * 256 * LSTR;
    const int tid = threadIdx.x, lane = tid & 63, w = tid >> 6, wm = w & 3, wn = w >> 2;
    const int ar = tid >> 1, ah = tid & 1;
    const int bn = tid & 127, bkg = tid >> 7;
    const typename AL::Row r0 = al.row(ar);
    const typename BL::Col c0 = bl.col(bn);
    f32x4 acc[4][4];
#pragma unroll
    for (int i = 0; i < 4; ++i)
#pragma unroll
        for (int j = 0; j < 4; ++j) acc[i][j] = (f32x4){0.f, 0.f, 0.f, 0.f};
    bf16x8 ra[4], rb[2];
#define G2_LOAD(k0) do { _Pragma("unroll") for (int _g = 0; _g < 4; ++_g) ra[_g] = al.load(r0, (k0) + ah * 32 + _g * 8); rb[0] = bl.load(c0, (k0) + bkg * 16); rb[1] = bl.load(c0, (k0) + bkg * 16 + 8); } while (0)
#define G2_STORE(buf) do { bf16_t* _a = As0 + (buf) * 256 * LSTR + ar * LSTR + ah * 32; _Pragma("unroll") for (int _g = 0; _g < 4; ++_g) *(bf16x8*)(_a + _g * 8) = ra[_g]; \
        bf16_t* _b = Bs0 + (buf) * 128 * LSTR + bn * LSTR + bkg * 16; *(bf16x8*)_b = rb[0]; *(bf16x8*)(_b + 8) = rb[1]; } while (0)
    const int nk = K / 64;
    __syncthreads();
    G2_LOAD(0); G2_STORE(0);
    if (nk > 1) G2_LOAD(64);
    __syncthreads();
    for (int it = 0; it < nk; ++it) {
        const bf16_t* As = As0 + (it & 1) * 256 * LSTR; const bf16_t* Bs = Bs0 + (it & 1) * 128 * LSTR;
#pragma unroll
        for (int ks = 0; ks < 2; ++ks) {
            bf16x8 af[4], bfr[4];
#pragma unroll
            for (int i = 0; i < 4; ++i) af[i] = *(const bf16x8*)(As + (wm * 64 + i * 16 + (lane & 15)) * LSTR + ks * 32 + (lane >> 4) * 8);
#pragma unroll
            for (int j = 0; j < 4; ++j) bfr[j] = *(const bf16x8*)(Bs + (wn * 64 + j * 16 + (lane & 15)) * LSTR + ks * 32 + (lane >> 4) * 8);
#pragma unroll
            for (int i = 0; i < 4; ++i)
#pragma unroll
                for (int j = 0; j < 4; ++j) acc[i][j] = __builtin_amdgcn_mfma_f32_16x16x32_bf16(bfr[j], af[i], acc[i][j], 0, 0, 0);
        }
        if (it + 1 < nk) { G2_STORE((it + 1) & 1); if (it + 2 < nk) G2_LOAD((it + 2) * 64); }
        __syncthreads();
    }
#undef G2_LOAD
#undef G2_STORE
    ep(acc, wm, wn, lane);
}
#define EP_ROW(i) (wm * 64 + (i) * 16 + (lane & 15))
#define EP_COL(j) (wn * 64 + (j) * 16 + (lane >> 4) * 4)


namespace mg8 {
#define MG_LAS __attribute__((address_space(3)))
constexpr int BM = 256, BK = 64, HALF = 128, HTB = HALF * BK * 2, STAGE_BYTES = 8 * HTB, NXCD = 8, WGM = 8;
__host__ __device__ __forceinline__ int lds_byte(int r, int c) { const int st = (r >> 4) * 2 + (c >> 5), rr = r & 15, cc = c & 31, ob = rr * 64 + cc * 2; return st * 1024 + (ob ^ (((ob >> 9) & 1) << 5)); }
__host__ __device__ __forceinline__ void stage_rc(int b, int& R, int& C) { const int st = b / 1024, sb = b % 1024, swz = sb ^ (((sb >> 9) & 1) << 5); R = (st >> 1) * 16 + swz / 64; C = (st & 1) * 32 + (swz % 64) / 2; }
__host__ __device__ __forceinline__ int perm32(int rho) { const int n = rho >> 4, i = rho & 15; return 8 * (i >> 2) + 4 * n + (i & 3); }
struct Unit { int pm, pn; const char* A; const char* B; const int* gidx; };
__device__ __forceinline__ int xcd_remap(int wgid, int nwg) { const int q = nwg / NXCD, r = nwg % NXCD, xcd = wgid % NXCD, off = wgid / NXCD; return (xcd < r ? xcd * (q + 1) : r * (q + 1) + (xcd - r) * q) + off; }
struct DenseOrder {
    int nM, nN, nwg, G, c; const char* A; const char* Bt; size_t tstep;
    __device__ void init(const bf16_t* A_, const bf16_t* Bt_, int M, int N, int K, int G_, int c_) { nM = M / BM; nN = N / BM; nwg = nM * nN; G = G_; c = c_; A = (const char*)A_; Bt = (const char*)Bt_; tstep = (size_t)BM * K * 2; }
    __device__ bool next(int i, Unit& u) const {
        const long L = (long)i * G + c; if (L >= nwg) return false;
        const int wgid = xcd_remap((int)L, nwg);
        const int nig = WGM * nN, gid = wgid / nig, fm = gid * WGM, gsz = (nM - fm) < WGM ? (nM - fm) : WGM;
        u.pm = fm + ((wgid % nig) % gsz); u.pn = (wgid % nig) / gsz; u.A = A + (size_t)u.pm * tstep; u.B = Bt + (size_t)u.pn * tstep; u.gidx = nullptr; return true;
    }
};
struct MoeOrder {
    int ntr, npn, nwg, G, c, K, rbase; bool gather; const char* A; const char* Wexp; size_t wstride; const char* Wsh; const int* tile_e; const int* slot_tok;
    __device__ bool next(int i, Unit& u) const {
        const long L = (long)i * G + c; if (L >= nwg) return false;
        const int wv = xcd_remap((int)L, nwg); const int tile = wv / npn, pn = wv % npn; const size_t tstep = (size_t)BM * K * 2;
        u.pm = tile; u.pn = pn; u.gidx = nullptr;
        if (tile < ntr) { const int e = tile_e[tile]; u.B = Wexp + (size_t)e * wstride + (size_t)pn * tstep; if (gather) { u.A = A; u.gidx = slot_tok + tile * 256; } else u.A = A + (size_t)tile * tstep; }
        else { u.B = Wsh + (size_t)pn * tstep; u.A = gather ? A + (size_t)(rbase + (tile - ntr) * 256) * K * 2 : A + (size_t)tile * tstep; }
        return true;
    }
};
template <class Epi, class Sched, bool GATHER>
__device__ __forceinline__ void gemm_phase(MG_LAS unsigned char* lds, const int K, const Sched& S, const Epi& E) {
    const int tid = threadIdx.x, wid = __builtin_amdgcn_readfirstlane(tid >> 6), lane = tid & 63, wr = wid >> 2, wc = wid & 3, fr = lane & 15, fq = lane >> 4;
    const int nt = K / BK;
    int RR[2], CC[2]; unsigned voffB[2], vA[2][2], vN[2][2];
#pragma unroll
    for (int i = 0; i < 2; ++i) { int R, C; stage_rc(tid * 16 + i * 8192, R, C); RR[i] = R; CC[i] = C; const int Rb = Epi::PERM ? ((R & ~31) + perm32(R & 31)) : R; voffB[i] = (unsigned)(Rb * K + C) * 2u; }
#define MG_MKV(v, u) do { _Pragma("unroll") for (int _h = 0; _h < 2; ++_h) _Pragma("unroll") for (int _i = 0; _i < 2; ++_i) { const int _row = _h * HALF + RR[_i]; \
        const int _src = (GATHER && (u).gidx) ? (u).gidx[_row] : _row; v[_h][_i] = (unsigned)(_src * K + CC[_i]) * 2u; } } while (0)
    const size_t kstep = (size_t)(BK * 2);
    const size_t hstep = (size_t)HALF * K * 2;
    const unsigned ldsw = (unsigned)wid * 1024u;
    const int aoff = lds_byte(wr * 64 + fr, fq * 8), boff = lds_byte(wc * 32 + fr, fq * 8);
#define MG_SA(b, h) (((b) * 2 + (h)) * HTB)
#define MG_SB(b, h) ((4 + (b) * 2 + (h)) * HTB)
#define MG_STAGE(bufoff, gbase, voff) do { _Pragma("unroll") for (int _i = 0; _i < 2; ++_i) \
        __builtin_amdgcn_global_load_lds((const unsigned*)((const char*)(gbase) + (voff)[_i]), (MG_LAS unsigned*)(lds + (bufoff) + ldsw + _i * 8192), 16, 0, 0); } while (0)
#define MG_LDA(dst, b, h) do { _Pragma("unroll") for (int m = 0; m < 4; ++m) _Pragma("unroll") for (int k = 0; k < 2; ++k) dst[m][k] = *(const MG_LAS bf16x8*)(lds + MG_SA(b, h) + aoff + m * 2048 + k * 1024); } while (0)
#define MG_LDB(dst, b, h) do { _Pragma("unroll") for (int n = 0; n < 2; ++n) _Pragma("unroll") for (int k = 0; k < 2; ++k) dst[n][k] = *(const MG_LAS bf16x8*)(lds + MG_SB(b, h) + boff + n * 2048 + k * 1024); } while (0)
#define MG_MMA(ai, bj, At, Bt) do { __builtin_amdgcn_s_setprio(1); _Pragma("unroll") for (int m = 0; m < 4; ++m) _Pragma("unroll") for (int n = 0; n < 2; ++n) _Pragma("unroll") for (int k = 0; k < 2; ++k) \
        acc[ai][bj][m][n] = __builtin_amdgcn_mfma_f32_16x16x32_bf16(Bt[n][k], At[m][k], acc[ai][bj][m][n], 0, 0, 0); __builtin_amdgcn_s_setprio(0); } while (0)
#define MG_WAIT_V(n) asm volatile("s_waitcnt vmcnt(" #n ")" ::: "memory")
#define MG_WAIT_L(n) asm volatile("s_waitcnt lgkmcnt(" #n ")" ::: "memory")
#define MG_BAR __builtin_amdgcn_s_barrier()
#define MG_SCHED __builtin_amdgcn_sched_barrier(0)
    Unit cur, nxt; int ui = 0;
    if (!S.next(0, cur)) return;
    f32x4 acc[2][2][4][2];
#pragma unroll
    for (int a = 0; a < 2; ++a)
#pragma unroll
        for (int b = 0; b < 2; ++b)
#pragma unroll
            for (int m = 0; m < 4; ++m)
#pragma unroll
                for (int n = 0; n < 2; ++n) acc[a][b][m][n] = (f32x4){0.f, 0.f, 0.f, 0.f};
    bf16x8 At[4][2], B0[2][2], B1[2][2];
    const char* cA = cur.A; const char* cB = cur.B;
    MG_MKV(vA, cur);
    MG_STAGE(MG_SB(0, 0), cB, voffB); MG_STAGE(MG_SB(0, 1), cB + hstep, voffB); MG_STAGE(MG_SA(0, 0), cA, vA[0]); MG_STAGE(MG_SA(0, 1), cA, vA[1]);
    if (wr == 1) MG_BAR;
    MG_WAIT_V(2); MG_BAR;
    MG_STAGE(MG_SB(1, 0), cB + kstep, voffB); MG_STAGE(MG_SA(1, 0), cA + kstep, vA[0]); MG_STAGE(MG_SB(1, 1), cB + hstep + kstep, voffB);
    MG_WAIT_V(6); MG_BAR;
    for (;;) {
        const bool has_next = S.next(ui + 1, nxt);
        const char* nA = has_next ? nxt.A : cA; const char* nB = has_next ? nxt.B : cB;
#pragma unroll 1
        for (int t = 0; t < nt; t += 2) {
            const bool last = (t == nt - 2);
            const char* a1 = cA + (size_t)(t + 1) * kstep;
            const char* a2 = last ? nA : cA + (size_t)(t + 2) * kstep; const char* b2 = last ? nB : cB + (size_t)(t + 2) * kstep;
            const char* a3 = a2 + kstep; const char* b3 = b2 + kstep;
            unsigned x0[2], x1[2];
            if constexpr (GATHER) {
                if (last) { if (has_next) { MG_MKV(vN, nxt); } else {
#pragma unroll
                    for (int h = 0; h < 2; ++h)
#pragma unroll
                        for (int i = 0; i < 2; ++i) vN[h][i] = vA[h][i]; } }
#pragma unroll
                for (int i = 0; i < 2; ++i) { x0[i] = last ? vN[0][i] : vA[0][i]; x1[i] = last ? vN[1][i] : vA[1][i]; }
            } else {
#pragma unroll
                for (int i = 0; i < 2; ++i) { x0[i] = vA[0][i]; x1[i] = vA[1][i]; }
            }
            MG_LDB(B0, 0, 0); MG_LDB(B1, 0, 1); MG_SCHED; MG_LDA(At, 0, 0); MG_STAGE(MG_SA(1, 1), a1, vA[1]);
            MG_WAIT_V(8); MG_WAIT_L(0); MG_BAR; MG_MMA(0, 0, At, B0); MG_MMA(0, 1, At, B1); MG_BAR; MG_SCHED;
            MG_LDA(At, 0, 1); MG_STAGE(MG_SB(0, 0), b2, voffB); MG_STAGE(MG_SB(0, 1), b2 + hstep, voffB); MG_STAGE(MG_SA(0, 0), a2, x0);
            MG_WAIT_V(8); MG_WAIT_L(0); MG_BAR; MG_MMA(1, 0, At, B0); MG_MMA(1, 1, At, B1); MG_BAR; MG_SCHED;
            MG_LDB(B0, 1, 0); MG_LDB(B1, 1, 1); MG_SCHED; MG_LDA(At, 1, 0); MG_STAGE(MG_SA(0, 1), a2, x1);
            MG_WAIT_V(8); MG_WAIT_L(0); MG_BAR; MG_MMA(0, 0, At, B0); MG_MMA(0, 1, At, B1); MG_BAR; MG_SCHED;
            MG_LDA(At, 1, 1); MG_STAGE(MG_SB(1, 0), b3, voffB); MG_STAGE(MG_SB(1, 1), b3 + hstep, voffB); MG_STAGE(MG_SA(1, 0), a3, x0);
            MG_WAIT_V(8); MG_WAIT_L(0); MG_BAR; MG_MMA(1, 0, At, B0); MG_MMA(1, 1, At, B1); MG_BAR; MG_SCHED;
        }
        if (wr == 0) MG_BAR;
        E(acc, cur, wr, wc, fr, fq);
        if (!has_next) break;
#pragma unroll
        for (int a = 0; a < 2; ++a)
#pragma unroll
            for (int b = 0; b < 2; ++b)
#pragma unroll
                for (int m = 0; m < 4; ++m)
#pragma unroll
                    for (int n = 0; n < 2; ++n) acc[a][b][m][n] = (f32x4){0.f, 0.f, 0.f, 0.f};
        cur = nxt; cA = nA; cB = nB; ++ui;
        if constexpr (GATHER) {
#pragma unroll
            for (int h = 0; h < 2; ++h)
#pragma unroll
                for (int i = 0; i < 2; ++i) vA[h][i] = vN[h][i];
        }
        if (wr == 1) MG_BAR;
    }
    MG_WAIT_V(0);
    MG_BAR;
#undef MG_MKV
#undef MG_SA
#undef MG_SB
#undef MG_STAGE
#undef MG_LDA
#undef MG_LDB
#undef MG_MMA
#undef MG_WAIT_V
#undef MG_WAIT_L
#undef MG_BAR
#undef MG_SCHED
}
struct EpiF32 {
    static constexpr bool PERM = false;
    float* C; int ldc; int row0; int nvalid;
    __device__ __forceinline__ void operator()(const f32x4 (&acc)[2][2][4][2], const Unit& u, int wr, int wc, int fr, int fq) const {
        const int rb = row0 + u.pm * BM + wr * 64 + fr, cb = u.pn * BM + wc * 32 + 4 * fq;
#pragma unroll
        for (int ai = 0; ai < 2; ++ai)
#pragma unroll
            for (int m = 0; m < 4; ++m) { float* rowp = C + (size_t)(rb + ai * HALF + m * 16) * ldc;
#pragma unroll
                for (int bj = 0; bj < 2; ++bj)
#pragma unroll
                    for (int n = 0; n < 2; ++n) { const int col = cb + bj * HALF + n * 16; if (col < nvalid) *(f32x4*)(rowp + col) = acc[ai][bj][m][n]; } }
    }
};
struct EpiBf16 {
    static constexpr bool PERM = true;
    bf16_t* C; int ldc; int row0; int nvalid;
    __device__ __forceinline__ void operator()(const f32x4 (&acc)[2][2][4][2], const Unit& u, int wr, int wc, int fr, int fq) const {
        const int rb = row0 + u.pm * BM + wr * 64 + fr, cb = u.pn * BM + wc * 32 + 8 * fq;
#pragma unroll
        for (int ai = 0; ai < 2; ++ai)
#pragma unroll
            for (int m = 0; m < 4; ++m) { bf16_t* rowp = C + (size_t)(rb + ai * HALF + m * 16) * ldc;
#pragma unroll
                for (int bj = 0; bj < 2; ++bj) { const int col = cb + bj * HALF; if (col < nvalid) *(bf16x8*)(rowp + col) = pack8(acc[ai][bj][m][0] + 0.f, acc[ai][bj][m][1] + 0.f); } }
    }
};
struct EpiPre {
    static constexpr bool PERM = false;
    const Params* p; int layer; int row0;
    __device__ __forceinline__ void operator()(const f32x4 (&acc)[2][2][4][2], const Unit& u, int wr, int wc, int fr, int fq) const {
        const int rb = row0 + u.pm * BM + wr * 64 + fr, cb = u.pn * BM + wc * 32 + 4 * fq;
#pragma unroll
        for (int ai = 0; ai < 2; ++ai)
#pragma unroll
            for (int m = 0; m < 4; ++m) { const int row = rb + ai * HALF + m * 16; const float* xr = xin_row(*p, layer, row); const float* g1 = p->MOD + ((size_t)layer * 9 + row_mod(row)) * 6144 + 2048;
#pragma unroll
                for (int bj = 0; bj < 2; ++bj)
#pragma unroll
                    for (int n = 0; n < 2; ++n) { const int col = cb + bj * HALF + n * 16;
                        *(f32x4*)(p->PRE + (size_t)row * DM + col) = *(const f32x4*)(xr + col) * DN_ALPHA + *(const f32x4*)(g1 + col) * acc[ai][bj][m][n]; } }
    }
};
struct EpiAct {
    static constexpr bool PERM = true;
    bf16_t* ACT;
    __device__ __forceinline__ void operator()(const f32x4 (&acc)[2][2][4][2], const Unit& u, int wr, int wc, int fr, int fq) const {
        const int rb = u.pm * BM + wr * 64 + fr, cb = u.pn * HALF + wc * 32 + 8 * fq;
#pragma unroll
        for (int ai = 0; ai < 2; ++ai)
#pragma unroll
            for (int m = 0; m < 4; ++m) {
                const f32x4 a0 = acc[ai][0][m][0], a1 = acc[ai][0][m][1], b0 = acc[ai][1][m][0], b1 = acc[ai][1][m][1];
                f32x4 o0, o1;
#pragma unroll
                for (int e = 0; e < 4; ++e) { o0[e] = a0[e] / (1.f + __expf(-a0[e])) * b0[e]; o1[e] = a1[e] / (1.f + __expf(-a1[e])) * b1[e]; }
                *(bf16x8*)(ACT + (size_t)(rb + ai * HALF + m * 16) * 256 + cb) = pack8(o0, o1);
            }
    }
};
struct EpiYs {
    static constexpr bool PERM = true;
    bf16_t* YS; const float* gate; int ntr;
    __device__ __forceinline__ void operator()(const f32x4 (&acc)[2][2][4][2], const Unit& u, int wr, int wc, int fr, int fq) const {
        const int rb = u.pm * BM + wr * 64 + fr, cb = u.pn * BM + wc * 32 + 8 * fq;
#pragma unroll
        for (int ai = 0; ai < 2; ++ai)
#pragma unroll
            for (int m = 0; m < 4; ++m) { const int row = rb + ai * HALF + m * 16; const float g = gate[row] * 64.f;
#pragma unroll
                for (int bj = 0; bj < 2; ++bj) { const f32x4 v0 = acc[ai][bj][m][0] * g, v1 = acc[ai][bj][m][1] * g; int w0 = 0, w1 = 0;
                    w0 = __builtin_amdgcn_cvt_pk_fp8_f32(v0[0], v0[1], w0, false); w0 = __builtin_amdgcn_cvt_pk_fp8_f32(v0[2], v0[3], w0, true);
                    w1 = __builtin_amdgcn_cvt_pk_fp8_f32(v1[0], v1[1], w1, false); w1 = __builtin_amdgcn_cvt_pk_fp8_f32(v1[2], v1[3], w1, true);
                    u32x2 wv; wv.x = (unsigned)w0; wv.y = (unsigned)w1; *(u32x2*)((unsigned char*)YS + (size_t)row * DM + cb + bj * HALF) = wv; } }
    }
};
}

struct AModRow { const float* x; const float* sh; };
struct ALoadMod {
    const Params* p; int layer; int row0; int sec;
    typedef AModRow Row;
    __device__ __forceinline__ Row row(int r) const { const int g = row0 + r; Row R; R.x = xin_row(*p, layer, g); R.sh = p->MOD + ((size_t)layer * 9 + row_mod(g)) * 6144 + sec * 1024; return R; }
    __device__ __forceinline__ bf16x8 load(const Row& R, int k) const {
        const f32x4 x0 = *(const f32x4*)(R.x + k), x1 = *(const f32x4*)(R.x + k + 4);
        const f32x4 h0 = *(const f32x4*)(R.sh + k), h1 = *(const f32x4*)(R.sh + k + 4);
        const f32x4 s0 = *(const f32x4*)(R.sh + 1024 + k), s1 = *(const f32x4*)(R.sh + 1024 + k + 4);
        return pack8(x0 * (s0 + 1.f) + h0, x1 * (s1 + 1.f) + h1);
    }
};
struct ALoadBf {
    const bf16_t* A; int lda; int row0;
    typedef const bf16_t* Row;
    __device__ __forceinline__ Row row(int r) const { return A + (size_t)(row0 + r) * lda; }
    __device__ __forceinline__ bf16x8 load(Row R, int k) const { return *(const bf16x8*)(R + k); }
};
struct ALoadGather {
    const bf16_t* A; int lda; const int* idx;
    typedef const bf16_t* Row;
    __device__ __forceinline__ Row row(int r) const { return A + (size_t)idx[r] * lda; }
    __device__ __forceinline__ bf16x8 load(Row R, int k) const { return *(const bf16x8*)(R + k); }
};
__device__ __forceinline__ bf16x8 bload8(const float* c, int k, int ldb) {
    const float* q = c + (size_t)k * ldb;
    f32x4 a, b;
    a[0] = q[0]; a[1] = q[ldb]; a[2] = q[2 * ldb]; a[3] = q[3 * ldb];
    b[0] = q[4 * (size_t)ldb]; b[1] = q[5 * (size_t)ldb]; b[2] = q[6 * (size_t)ldb]; b[3] = q[7 * (size_t)ldb];
    return pack8(a, b);
}
struct BLoadF32 {
    const float* B; int ldb; int n0; int nvalid;
    typedef const float* Col;
    __device__ __forceinline__ Col col(int n) const { const int g = n0 + n; return g < nvalid ? B + g : nullptr; }
    __device__ __forceinline__ bf16x8 load(Col c, int k) const { if (!c) return (bf16x8){0, 0, 0, 0, 0, 0, 0, 0}; return bload8(c, k, ldb); }
};
struct BLoadW13 {
    const float* B; int nt;
    typedef const float* Col;
    __device__ __forceinline__ Col col(int n) const { const int wn = n >> 6, j = (n >> 4) & 3, c16 = n & 15; return B + (j >> 1) * 256 + nt * 64 + wn * 32 + (j & 1) * 16 + c16; }
    __device__ __forceinline__ bf16x8 load(Col c, int k) const { return bload8(c, k, 512); }
};

__device__ __forceinline__ void phase_mod(const Params& p, unsigned char* lds) {
    float* sv = (float*)lds;
    float* red = sv + 9 * 1024;
    const int tid = threadIdx.x;
    for (int e = tid; e < 9 * 1024; e += NTHR) { const int j = e >> 10, k = e & 1023; const float v = j < 8 ? p.c[j * 1024 + k] : p.c_ctx[k]; sv[e] = silu_f(v); }
    __syncthreads();
    const int kg = tid >> 6, nl = tid & 63;
    for (int u = blockIdx.x; u < 192; u += gridDim.x) {
        const int l = u / 96, n0 = (u % 96) * 64;
        const float* W = p.mod_w + (size_t)l * 1024 * 6144 + n0 + nl;
        float acc[9];
#pragma unroll
        for (int j = 0; j < 9; ++j) acc[j] = 0.f;
        for (int k = kg; k < 1024; k += 8) {
            const float wv = W[(size_t)k * 6144];
#pragma unroll
            for (int j = 0; j < 9; ++j) acc[j] += sv[j * 1024 + k] * wv;
        }
#pragma unroll
        for (int j = 0; j < 9; ++j) red[(kg * 9 + j) * 64 + nl] = acc[j];
        __syncthreads();
        for (int e = tid; e < 576; e += NTHR) {
            const int j = e >> 6, n = e & 63; float s = 0.f;
#pragma unroll
            for (int g = 0; g < 8; ++g) s += red[(g * 9 + j) * 64 + n];
            p.MOD[((size_t)l * 9 + j) * 6144 + n0 + n] = s + p.mod_b[l * 6144 + n0 + n];
        }
        __syncthreads();
    }
}

__device__ __forceinline__ void phase_filt(const Params& p, unsigned char* lds) {
    float* zs = (float*)lds;
    float* h1 = zs + 8 * 33;
    float* h2 = h1 + 8 * 64;
    const int tid = threadIdx.x;
    const float min_decay = logf(1e-2f) / 1.5f, max_decay = logf(1e-2f) / 0.3f;
    for (int u = blockIdx.x; u < 512; u += gridDim.x) {
        __syncthreads();
        if (tid < 8 * 33) {
            const int tt = tid / 33, i = tid % 33; const int t = u * 8 + tt;
            float v;
            if (i == 0) v = (float)t / 4095.f;
            else {
                const int bi = (i - 1) & 15; const float fr = 1e-4f + (float)bi * ((15.f - 1e-4f) / 15.f);
                const float wpos = 6.283185307179586f * (float)t / 4096.f;
                v = (i <= 16) ? cosf(fr * wpos) : -sinf(fr * wpos);
            }
            zs[tid] = v;
        }
        __syncthreads();
        const int tt = tid >> 6, j = tid & 63;
        {
            float s = p.hy_ffn_b1[j];
            for (int i = 0; i < 33; ++i) s += zs[tt * 33 + i] * p.hy_ffn_w1[i * 64 + j];
            h1[tt * 64 + j] = sinf(p.hy_sin_freq[j] * s);
        }
        __syncthreads();
        {
            float s = p.hy_ffn_b2[j];
            for (int i = 0; i < 64; ++i) s += h1[tt * 64 + i] * p.hy_ffn_w2[i * 64 + j];
            h2[tt * 64 + j] = sinf(p.hy_sin_freq[64 + j] * s);
        }
        __syncthreads();
#pragma unroll 1
        for (int mi = 0; mi < 4; ++mi) {
            const int m = tid + 512 * mi; const int n = m >> 10, side = (m >> 9) & 1, c = m & 511;
            float acc[8];
#pragma unroll
            for (int t2 = 0; t2 < 8; ++t2) acc[t2] = 0.f;
            for (int jj = 0; jj < 64; ++jj) {
                const float wv = p.hy_ffn_w3[jj * 2048 + m];
#pragma unroll
                for (int t2 = 0; t2 < 8; ++t2) acc[t2] += h2[t2 * 64 + jj] * wv;
            }
            const float delta = min_decay + (float)c * ((max_decay - min_decay) / 511.f);
#pragma unroll
            for (int t2 = 0; t2 < 8; ++t2) {
                const int t = u * 8 + t2; const float win = expf(-((float)t / 4095.f) * fabsf(delta)); const float val = acc[t2] * win;
                if (side == 0) p.G[((size_t)n * 512 + c) * 8192 + 4096 + t] = val;
                else if (t > 0) p.G[((size_t)n * 512 + c) * 8192 + 4096 - t] = val;
            }
        }
        if (u == 0) for (int e = tid; e < 1024; e += NTHR) p.G[(size_t)e * 8192] = 0.f;
    }
}

__device__ __forceinline__ void conv_tile(const float* src, int ld, int ncols_valid, int col0, int k0, bf16_t* dst, int K, unsigned char* lds) {
    bf16_t* T = (bf16_t*)lds;
    const int tid = threadIdx.x, kk = tid >> 4, nq = tid & 15;
    const int col = col0 + nq * 4;
    f32x4 v0 = {0.f, 0.f, 0.f, 0.f}, v1 = v0;
    if (col < ncols_valid) { v0 = *(const f32x4*)(src + (size_t)(k0 + kk) * ld + col); v1 = *(const f32x4*)(src + (size_t)(k0 + kk + 32) * ld + col); }
    __syncthreads();
#pragma unroll
    for (int e = 0; e < 4; ++e) { T[(nq * 4 + e) * 66 + kk] = f2bf(v0[e]); T[(nq * 4 + e) * 66 + kk + 32] = f2bf(v1[e]); }
    __syncthreads();
    const int n = tid >> 3, seg = tid & 7;
    const unsigned* tp = (const unsigned*)(T + n * 66 + seg * 8);
    u32x4 o; o.x = tp[0]; o.y = tp[1]; o.z = tp[2]; o.w = tp[3];
    *(u32x4*)(dst + (size_t)n * K + k0 + seg * 8) = o;
}
__device__ __forceinline__ int w13_col(int nrow) { const int pn = nrow >> 8, within = nrow & 255; return (within >> 7) * 256 + pn * 128 + (within & 127); }
__device__ __forceinline__ void phase_convw(const Params& p, unsigned char* lds) {
    const int total = 3008 + 65536 + 32768 + 40;
    for (int g = blockIdx.x; g < total; g += gridDim.x) {
        if (g < 1088) { const int rt = g >> 4, kt = g & 15; conv_tile(p.ev_w_in, EVW, EVW, rt * 64, kt * 64, p.WT_EVIN + (size_t)rt * 64 * 1024, 1024, lds); }
        else if (g < 1344) { const int t = g - 1088, rt = t >> 4, kt = t & 15; conv_tile(p.ev_w_out, 1024, 1024, rt * 64, kt * 64, p.WT_EVOUT + (size_t)rt * 64 * 1024, 1024, lds); }
        else if (g < 2240) { const int t = g - 1344, rt = t >> 4, kt = t & 15; conv_tile(p.od_w_in, ODW, ODW, rt * 64, kt * 64, p.WT_ODIN + (size_t)rt * 64 * 1024, 1024, lds); }
        else if (g < 2496) { const int t = g - 2240, rt = t >> 4, kt = t & 15; conv_tile(p.od_w_out, 1024, 1024, rt * 64, kt * 64, p.WT_ODOUT + (size_t)rt * 64 * 1024, 1024, lds); }
        else if (g < 2624) { const int t = g - 2496, l = t >> 6, rt = (t >> 4) & 3, kt = t & 15; conv_tile(p.router_w + (size_t)l * 1024 * 256, 256, 256, rt * 64, kt * 64, p.WT_ROUT + ((size_t)l * 256 + rt * 64) * 1024, 1024, lds); }
        else if (g < 2880) { const int t = g - 2624, l = t >> 7, rt = (t >> 4) & 7, kt = t & 15; conv_tile(p.sh_w13 + (size_t)l * 1024 * 512, 512, 512, w13_col(rt * 64), kt * 64, p.WT_SH13 + ((size_t)l * 512 + rt * 64) * 1024, 1024, lds); }
        else if (g < 3008) { const int t = g - 2880, l = t >> 6, rt = (t >> 2) & 15, kt = t & 3; conv_tile(p.sh_w2 + (size_t)l * 256 * 1024, 1024, 1024, rt * 64, kt * 64, p.WT_SH2 + ((size_t)l * 1024 + rt * 64) * 256, 256, lds); }
        else if (g < 3008 + 65536) { const int t = g - 3008, le = t >> 7, rt = (t >> 4) & 7, kt = t & 15; conv_tile(p.exp_w13 + (size_t)le * 1024 * 512, 512, 512, w13_col(rt * 64), kt * 64, p.WT_W13 + ((size_t)le * 512 + rt * 64) * 1024, 1024, lds); }
        else if (g < 3008 + 65536 + 32768) { const int t = g - 3008 - 65536, le = t >> 6, rt = (t >> 2) & 15, kt = t & 3; conv_tile(p.exp_w2 + (size_t)le * 256 * 1024, 1024, 1024, rt * 64, kt * 64, p.WT_W2 + ((size_t)le * 1024 + rt * 64) * 256, 256, lds); }
        else { const int t = g - 3008 - 65536 - 32768;
            if (t < 8) conv_tile(p.rw_w2, 512, 512, t * 64, 0, p.WT_RWF + (size_t)t * 64 * 64, 64, lds);
            else if (t < 16) conv_tile(p.rw_w2 + 64 * 512, 512, 512, (t - 8) * 64, 0, p.WT_RWB + (size_t)(t - 8) * 64 * 64, 64, lds);
            else if (t < 24) conv_tile(p.rw_a2, 512, 512, (t - 16) * 64, 0, p.WT_RWA + (size_t)(t - 16) * 64 * 64, 64, lds);
            else { const int t2 = t - 24; conv_tile(p.rw_g2, 512, 512, (t2 >> 1) * 64, (t2 & 1) * 64, p.WT_RWG + (size_t)(t2 >> 1) * 64 * 128, 128, lds); } }
    }
}
__device__ __forceinline__ void phase_hin0(const Params& p) {
    for (int i = blockIdx.x * NTHR + threadIdx.x; i < NT * 128; i += gridDim.x * NTHR) {
        const int r = i >> 7, k = (i & 127) * 8;
        const float* xr = xin_row(p, 0, r) + k; const float* md = p.MOD + (size_t)row_mod(r) * 6144 + k;
        const f32x4 x0 = *(const f32x4*)xr, x1 = *(const f32x4*)(xr + 4), h0 = *(const f32x4*)md, h1 = *(const f32x4*)(md + 4), s0 = *(const f32x4*)(md + 1024), s1 = *(const f32x4*)(md + 1028);
        *(bf16x8*)(p.HIN + (size_t)r * 1024 + k) = pack8(x0 * (s0 + 1.f) + h0, x1 * (s1 + 1.f) + h1);
    }
}
struct EpStoreF32 {
    float* C; int ldc; int row0; int n0; int nvalid;
    __device__ __forceinline__ void operator()(const f32x4 (&acc)[4][4], int wm, int wn, int lane) const {
#pragma unroll
        for (int i = 0; i < 4; ++i)
#pragma unroll
            for (int j = 0; j < 4; ++j) { const int col = n0 + EP_COL(j); if (col < nvalid) *(f32x4*)(C + (size_t)(row0 + EP_ROW(i)) * ldc + col) = acc[i][j]; }
    }
};
__device__ __forceinline__ void phase_inproj(const Params& p, unsigned char* lds, int layer) {
    mg8::DenseOrder S; S.init(p.HIN, layer == 0 ? p.WT_EVIN : p.WT_ODIN, NT, layer == 0 ? 4352 : 3584, 1024, gridDim.x, blockIdx.x);
    const int N = layer == 0 ? EVW : ODW;
    mg8::EpiBf16 E{p.P, N, 0, N};
    mg8::gemm_phase<mg8::EpiBf16, mg8::DenseOrder, false>((MG_LAS unsigned char*)lds, 1024, S, E);
}

template <int DK, int TYPE>
__device__ __forceinline__ void rec0_chunked(const Params& p, unsigned char* lds, int blk, int nblk) {
    constexpr int DKP = DK + 8, TPT = DK / 8, NPART = 512 / DK, NT16 = DK / 16;
    bf16_t* Qs = (bf16_t*)lds;
    bf16_t* Ks = Qs + 64 * DKP;
    bf16_t* KsT = Ks + 64 * DKP;
    bf16_t* Vt = KsT + DK * 72;
    bf16_t* Ps = Vt + 64 * 72;
    float* ptot = (float*)(Ps + 64 * 72);
    float* lref = ptot + 8 * 128;
    float* decv = lref + 128; float* elv = decv + 128; float* erv = elv + 128;
    const int tid = threadIdx.x, lane = tid & 63, w = tid >> 6, cw = w & 3, mh = w >> 2, q4 = lane >> 4, l15 = lane & 15;
    const int d = tid % DK, part = tid / DK;
    for (int e = tid; e < 64 * 72; e += NTHR) Ps[e] = 0;
    for (int unit = blk; unit < 128; unit += nblk) {
        const int half = unit & 1, h = (unit >> 1) & 3, b = (unit >> 3) & 7, dir = unit >> 6;
        float wg[16]; float gbias = 0.f, lbv = 0.f;
        if (TYPE == 0) {
#pragma unroll
            for (int i = 0; i < 16; ++i) wg[i] = p.gla_gate_w2[(dir * 16 + i) * 256 + h * 64 + d];
            gbias = p.gla_gate_b[dir * 256 + h * 64 + d];
        } else {
            const float l0 = p.hg_lb_logits[dir * 512 + h * 128 + d], l1 = p.hg_lb_logits[1024 + dir * 512 + h * 128 + d];
            lbv = 1.f / (1.f + expf(l1 - l0));
        }
        f32x4 Sacc[NT16];
#pragma unroll
        for (int t = 0; t < NT16; ++t) Sacc[t] = (f32x4){0.f, 0.f, 0.f, 0.f};
        const int vcol0 = (TYPE == 0 ? 512 : 3104) + h * 128 + half * 64;
        float ra[TPT], rb[TPT], rv[8]; f32x4 rg = {0.f, 0.f, 0.f, 0.f};
        float* sga = erv + 128;
#define REC_LOAD(cc) do { _Pragma("unroll") for (int tt = 0; tt < TPT; ++tt) { const bf16_t* pr = p.P + (size_t)row_of(dir, b, (cc) * 64 + part * TPT + tt) * EVW; \
            if (TYPE == 0) { ra[tt] = bf2f(pr[h * 64 + d]); rb[tt] = bf2f(pr[256 + h * 64 + d]); } else { ra[tt] = bf2f(pr[1568 + h * 128 + d]); rb[tt] = bf2f(pr[2080 + dir * 512 + h * 128 + d]); } } \
        _Pragma("unroll") for (int e = 0; e < 8; ++e) rv[e] = bf2f(p.P[(size_t)row_of(dir, b, (cc) * 64 + (tid >> 6) * 8 + e) * EVW + vcol0 + (tid & 63)]); \
        if (TYPE == 0 && tid < 256) rg = bf4_to_f32(*(const u32x2*)(p.P + (size_t)row_of(dir, b, (cc) * 64 + (tid >> 2)) * EVW + 1536 + dir * 16 + (tid & 3) * 4)); } while (0)
        REC_LOAD(0);
        for (int c = 0; c < (CTXL + SEQ) / 64; ++c) {
            __syncthreads();
            if (TYPE == 0) { if (tid < 256) *(f32x4*)(sga + tid * 4) = rg; __syncthreads(); }
            float qv[TPT], kv[TPT], lcv[TPT]; float lc = 0.f;
#pragma unroll
            for (int tt = 0; tt < TPT; ++tt) {
                float la;
                if (TYPE == 0) {
                    qv[tt] = ra[tt] * 0.125f; kv[tt] = rb[tt];
                    const float* ap = sga + (part * TPT + tt) * 16; float sg = gbias;
#pragma unroll
                    for (int i = 0; i < 16; i += 4) { const f32x4 a4 = *(const f32x4*)(ap + i); sg += a4[0] * wg[i] + a4[1] * wg[i + 1] + a4[2] * wg[i + 2] + a4[3] * wg[i + 3]; }
                    const float ex = __expf(-fabsf(sg)); la = (fminf(sg, 0.f) - __logf(1.f + ex)) * (1.f / 16.f);
                } else {
                    qv[tt] = ra[tt] * __builtin_amdgcn_rcpf(1.f + __expf(-ra[tt]));
                    const float f = lbv + (1.f - lbv) * __builtin_amdgcn_rcpf(1.f + __expf(-rb[tt]));
                    kv[tt] = 1.f - f; la = __logf(f);
                }
                lc += la; lcv[tt] = lc;
            }
            ptot[part * 128 + d] = lc;
            if (part == 32 / TPT) lref[d] = lcv[32 % TPT];
            *(bf16x8*)(Vt + (tid & 63) * 72 + (tid >> 6) * 8) = pack8((f32x4){rv[0], rv[1], rv[2], rv[3]}, (f32x4){rv[4], rv[5], rv[6], rv[7]});
            __syncthreads();
            float off = 0.f, bref = lref[d], blast = 0.f;
#pragma unroll
            for (int pp = 0; pp < NPART; ++pp) { const float tv = ptot[pp * 128 + d]; if (pp < part) off += tv; if (pp < 32 / TPT) bref += tv; blast += tv; }
            if (part == 0) { decv[d] = __expf(blast); elv[d] = __expf(blast - bref); erv[d] = __expf(bref); }
            {
                float ksv[TPT];
#pragma unroll
                for (int tt = 0; tt < TPT; ++tt) {
                    const int j = part * TPT + tt; const float bj = lcv[tt] + off;
                    const float e1 = __expf(bj - bref), e2 = __expf(bref - bj);
                    Qs[j * DKP + d] = f2bf(qv[tt] * e1); ksv[tt] = kv[tt] * e2; Ks[j * DKP + d] = f2bf(ksv[tt]);
                }
#pragma unroll
                for (int g = 0; g < TPT / 8; ++g) {
                    f32x4 a0 = {ksv[g * 8], ksv[g * 8 + 1], ksv[g * 8 + 2], ksv[g * 8 + 3]}, a1 = {ksv[g * 8 + 4], ksv[g * 8 + 5], ksv[g * 8 + 6], ksv[g * 8 + 7]};
                    *(bf16x8*)(KsT + d * 72 + part * TPT + g * 8) = pack8(a0, a1);
                }
            }
            __syncthreads();
            if (c + 1 < (CTXL + SEQ) / 64) REC_LOAD(c + 1);
#pragma unroll
            for (int rep = 0; rep < 2; ++rep) {
                const int t = w + rep * 8;
                if (t < 10) {
                    const int it = t < 1 ? 0 : (t < 3 ? 1 : (t < 6 ? 2 : 3)); const int jt = t - (it * (it + 1)) / 2;
                    f32x4 acc = {0.f, 0.f, 0.f, 0.f};
#pragma unroll
                    for (int ks = 0; ks < DK / 32; ++ks) {
                        const bf16x8 ka = *(const bf16x8*)(Ks + (jt * 16 + l15) * DKP + ks * 32 + q4 * 8);
                        const bf16x8 qb = *(const bf16x8*)(Qs + (it * 16 + l15) * DKP + ks * 32 + q4 * 8);
                        acc = __builtin_amdgcn_mfma_f32_16x16x32_bf16(ka, qb, acc, 0, 0, 0);
                    }
                    const int i = it * 16 + l15, j0 = jt * 16 + q4 * 4;
                    u32x2 wv; wv.x = pk2(i >= j0 ? acc[0] : 0.f, i >= j0 + 1 ? acc[1] : 0.f); wv.y = pk2(i >= j0 + 2 ? acc[2] : 0.f, i >= j0 + 3 ? acc[3] : 0.f);
                    *(u32x2*)(Ps + i * 72 + j0) = wv;
                }
            }
            __syncthreads();
            bf16x8 vb[2];
#pragma unroll
            for (int ks = 0; ks < 2; ++ks) vb[ks] = *(const bf16x8*)(Vt + (cw * 16 + l15) * 72 + ks * 32 + q4 * 8);
            bf16x8 sb[DK / 32];
#pragma unroll
            for (int ks = 0; ks < DK / 32; ++ks) {
                const f32x4 e0 = *(const f32x4*)(erv + ks * 32 + q4 * 4), e1 = *(const f32x4*)(erv + ks * 32 + 16 + q4 * 4);
                sb[ks] = pack8(Sacc[2 * ks] * e0, Sacc[2 * ks + 1] * e1);
            }
#pragma unroll
            for (int r2 = 0; r2 < 2; ++r2) {
                const int it = mh * 2 + r2;
                f32x4 acc = {0.f, 0.f, 0.f, 0.f};
#pragma unroll
                for (int ks = 0; ks < 2; ++ks) {
                    if (ks == 0 || it >= 2) {
                        const bf16x8 pa = *(const bf16x8*)(Ps + (it * 16 + l15) * 72 + ks * 32 + q4 * 8);
                        acc = __builtin_amdgcn_mfma_f32_16x16x32_bf16(pa, vb[ks], acc, 0, 0, 0);
                    }
                }
#pragma unroll
                for (int ks = 0; ks < DK / 32; ++ks) {
                    const u32x2 lo2 = *(const u32x2*)(Qs + (it * 16 + l15) * DKP + ks * 32 + q4 * 4), hi2 = *(const u32x2*)(Qs + (it * 16 + l15) * DKP + ks * 32 + 16 + q4 * 4);
                    u32x4 qa4; qa4.x = lo2.x; qa4.y = lo2.y; qa4.z = hi2.x; qa4.w = hi2.y;
                    acc = __builtin_amdgcn_mfma_f32_16x16x32_bf16(__builtin_bit_cast(bf16x8, qa4), sb[ks], acc, 0, 0, 0);
                }
#pragma unroll
                for (int e = 0; e < 4; ++e) {
                    const int row = row_of(dir, b, c * 64 + it * 16 + q4 * 4 + e);
                    p.O[((size_t)dir * NT + row) * 1024 + TYPE * 512 + h * 128 + half * 64 + cw * 16 + l15] = acc[e];
                }
            }
#pragma unroll
            for (int t = 0; t < NT16; ++t) {
                f32x4 acc = {0.f, 0.f, 0.f, 0.f};
#pragma unroll
                for (int ks = 0; ks < 2; ++ks) {
                    const bf16x8 ka = *(const bf16x8*)(KsT + (t * 16 + l15) * 72 + ks * 32 + q4 * 8);
                    acc = __builtin_amdgcn_mfma_f32_16x16x32_bf16(ka, vb[ks], acc, 0, 0, 0);
                }
                const f32x4 dv = *(const f32x4*)(decv + t * 16 + q4 * 4), ev = *(const f32x4*)(elv + t * 16 + q4 * 4);
                Sacc[t] = Sacc[t] * dv + ev * acc;
            }
        }
#undef REC_LOAD
    }
}
__device__ __forceinline__ void phase_rec0(const Params& p, unsigned char* lds) {
    const int nb = gridDim.x, b = blockIdx.x;
    if (nb >= 256) { if (b < 128) rec0_chunked<128, 1>(p, lds, b, 128); else rec0_chunked<64, 0>(p, lds, b - 128, nb - 128); }
    else { rec0_chunked<128, 1>(p, lds, b, nb); rec0_chunked<64, 0>(p, lds, b, nb); }
}

__device__ __forceinline__ void phase_readout0(const Params& p) {
    const int lane = threadIdx.x & 63, w = threadIdx.x >> 6;
    const int c = w * 128 + lane * 2;
    const float* gn = w < 4 ? p.gla_norm_g : p.hg_norm_g;
    const float g0 = gn[lane * 2], g1 = gn[lane * 2 + 1];
    const int goff = w < 4 ? (1024 + c) : (3616 + (c - 512));
    for (int r = blockIdx.x; r < NT; r += gridDim.x) {
        const float* o0 = p.O + (size_t)r * 1024 + c; const float* o1 = p.O + ((size_t)NT + r) * 1024 + c;
        const float a = o0[0] + o1[0], b = o0[1] + o1[1];
        const float ss = wave_sum(a * a + b * b);
        const float rs = rsqrtf(ss * (1.f / 128.f) + 1e-6f);
        const unsigned gpw = *(const unsigned*)(p.P + (size_t)r * EVW + goff); const float gp[2] = {__uint_as_float(gpw << 16), __uint_as_float(gpw & 0xffff0000u)};
        const float y0 = a * rs * g0 * silu_f(gp[0]), y1 = b * rs * g1 * silu_f(gp[1]);
        *(unsigned*)(p.Y + (size_t)r * 1024 + c) = pk2(y0, y1);
    }
}

struct EpPre {
    const Params* p; int layer; int row0; int n0;
    __device__ __forceinline__ void operator()(const f32x4 (&acc)[4][4], int wm, int wn, int lane) const {
#pragma unroll
        for (int i = 0; i < 4; ++i) {
            const int row = row0 + EP_ROW(i);
            const float* xr = xin_row(*p, layer, row);
            const float* g1 = p->MOD + ((size_t)layer * 9 + row_mod(row)) * 6144 + 2048;
#pragma unroll
            for (int j = 0; j < 4; ++j) {
                const int col = n0 + EP_COL(j);
                const f32x4 xv = *(const f32x4*)(xr + col), gv = *(const f32x4*)(g1 + col);
                *(f32x4*)(p->PRE + (size_t)row * DM + col) = xv * DN_ALPHA + gv * acc[i][j];
            }
        }
    }
};
__device__ __forceinline__ void phase_outproj(const Params& p, unsigned char* lds, int layer) {
    const int rbase = layer == 0 ? 0 : NCTX;
    mg8::DenseOrder S; S.init(p.Y + (size_t)rbase * DM, layer == 0 ? p.WT_EVOUT : p.WT_ODOUT, NT - rbase, 1024, 1024, gridDim.x, blockIdx.x);
    mg8::EpiPre E{&p, layer, rbase};
    mg8::gemm_phase<mg8::EpiPre, mg8::DenseOrder, false>((MG_LAS unsigned char*)lds, 1024, S, E);
}

__device__ __forceinline__ void phase_ln1(const Params& p, int layer) {
    const int lane = threadIdx.x & 63, w = threadIdx.x >> 6;
    const int rbase = layer == 0 ? 0 : NCTX;
    const float* lg = p.ln1_g + layer * DM; const float* lb = p.ln1_b + layer * DM;
    for (int r = rbase + blockIdx.x * 8 + w; r < NT; r += gridDim.x * 8) {
        f32x4 v[4]; float s = 0.f;
#pragma unroll
        for (int i = 0; i < 4; ++i) { v[i] = *(const f32x4*)(p.PRE + (size_t)r * DM + i * 256 + lane * 4); s += (v[i][0] + v[i][1]) + (v[i][2] + v[i][3]); }
        const float mean = wave_sum(s) * (1.f / 1024.f); float q = 0.f;
#pragma unroll
        for (int i = 0; i < 4; ++i) { const f32x4 d = v[i] - mean; q += (d[0] * d[0] + d[1] * d[1]) + (d[2] * d[2] + d[3] * d[3]); }
        const float rstd = rsqrtf(wave_sum(q) * (1.f / 1024.f) + 1e-5f);
        const float* md = p.MOD + ((size_t)layer * 9 + row_mod(r)) * 6144;
#pragma unroll
        for (int i = 0; i < 4; ++i) {
            const int col = i * 256 + lane * 4;
            const f32x4 y = (v[i] - mean) * rstd * *(const f32x4*)(lg + col) + *(const f32x4*)(lb + col);
            *(f32x4*)(p.X1 + (size_t)r * DM + col) = y;
            const f32x4 uu = y * (*(const f32x4*)(md + 4096 + col) + 1.f) + *(const f32x4*)(md + 3072 + col);
            u32x2 wv; wv.x = pk2(uu[0], uu[1]); wv.y = pk2(uu[2], uu[3]);
            *(u32x2*)(p.U + (size_t)r * DM + col) = wv;
        }
    }
}

__device__ __forceinline__ void phase_router(const Params& p, unsigned char* lds, int layer) {
    const int rbase = layer == 0 ? 0 : NCTX;
    mg8::DenseOrder S; S.init(p.U + (size_t)rbase * DM, p.WT_ROUT + (size_t)layer * 256 * 1024, NT - rbase, 256, 1024, gridDim.x, blockIdx.x);
    mg8::EpiF32 E{p.LOGITS, 256, rbase, 256};
    mg8::gemm_phase<mg8::EpiF32, mg8::DenseOrder, false>((MG_LAS unsigned char*)lds, 1024, S, E);
}

__device__ __forceinline__ void phase_select(const Params& p, int layer) {
    const int lane = threadIdx.x & 63, w = threadIdx.x >> 6;
    const int rbase = layer == 0 ? 0 : NCTX; const int nrows = NT - rbase;
    const f32x4 bias = *(const f32x4*)(p.router_bias + layer * 256 + lane * 4);
    int* cnt = p.CNT + layer * 256;
    const float NEG = -__builtin_inff();
    for (int t = blockIdx.x * 8 + w; t < nrows; t += gridDim.x * 8) {
        const f32x4 lg = *(const f32x4*)(p.LOGITS + (size_t)(rbase + t) * 256 + lane * 4);
        float sc0 = sigmoid_f(lg[0]), sc1 = sigmoid_f(lg[1]), sc2 = sigmoid_f(lg[2]), sc3 = sigmoid_f(lg[3]);
        float s0 = sc0 + bias[0], s1 = sc1 + bias[1], s2 = sc2 + bias[2], s3 = sc3 + bias[3];
        float a = fmaxf(s0, s1), b = fminf(s0, s1), c = fmaxf(s2, s3), d = fminf(s2, s3);
        float m1 = fmaxf(a, c), m2 = fmaxf(fminf(a, c), fmaxf(b, d));
#pragma unroll
        for (int m = 1; m <= 4; m <<= 1) {
            const float o1 = __shfl_xor(m1, m), o2 = __shfl_xor(m2, m);
            const float n1 = fmaxf(m1, o1), n2 = fmaxf(fminf(m1, o1), fmaxf(m2, o2));
            m1 = n1; m2 = n2;
        }
        const float grp = m1 + m2; const int myg = lane >> 3; int rank = 0;
#pragma unroll
        for (int g = 0; g < 8; ++g) { const float sg = __shfl(grp, g * 8); rank += (sg > grp || (sg == grp && g < myg)) ? 1 : 0; }
        if (rank >= 4) { s0 = NEG; s1 = NEG; s2 = NEG; s3 = NEG; }
        int my_e = 0; float my_s = 0.f, gsum = 0.f;
#pragma unroll 1
        for (int k = 0; k < 8; ++k) {
            float lm = s0; int li = 0;
            if (s1 > lm) { lm = s1; li = 1; }
            if (s2 > lm) { lm = s2; li = 2; }
            if (s3 > lm) { lm = s3; li = 3; }
            const float wmx = wave_max(lm);
            const unsigned long long bal = __ballot(lm == wmx);
            const int win = __ffsll((long long)bal) - 1;
            const float mysc = li == 0 ? sc0 : (li == 1 ? sc1 : (li == 2 ? sc2 : sc3));
            const int e = win * 4 + __shfl(li, win);
            const float se = __shfl(mysc, win);
            if (lane == win) { if (li == 0) s0 = NEG; else if (li == 1) s1 = NEG; else if (li == 2) s2 = NEG; else s3 = NEG; }
            if (lane == k) { my_e = e; my_s = se; }
            gsum += se;
        }
        if (lane < 8) {
            const int pos = atomicAdd(&cnt[my_e], 1);
            const size_t o = (size_t)t * 8 + lane;
            p.EIDX[o] = my_e; p.GATE[o] = my_s / gsum * 2.5f; p.POS[o] = pos;
        }
    }
}

__device__ __forceinline__ void phase_offsets(const Params& p, unsigned char* lds, int layer) {
    int* offs = (int*)lds;
    const int tid = threadIdx.x;
    const int rbase = layer == 0 ? 0 : NCTX; const int nrows = NT - rbase;
    const int* cnt = p.CNT + layer * 256;
    __syncthreads();
    if (tid == 0) { int a = 0; for (int e = 0; e < 256; ++e) { offs[e] = a; a += (cnt[e] + 255) & ~255; } offs[256] = a; }
    __syncthreads();
    const int ntr = offs[256] >> 8;
    if (blockIdx.x == 0) {
        if (tid == 0) p.META[layer * 64] = ntr;
        for (int i = tid; i < ntr; i += NTHR) { int lo = 0, hi = 255; const int s = i * 256; while (lo < hi) { const int mid = (lo + hi + 1) >> 1; if (offs[mid] <= s) lo = mid; else hi = mid - 1; }
            p.TILE_E[i] = lo; }
    }
    for (int i = blockIdx.x * NTHR + tid; i < nrows * 8; i += gridDim.x * NTHR) {
        const int e = p.EIDX[i]; const int slot = offs[e] + p.POS[i];
        p.SLOT_TOK[slot] = rbase + (i >> 3); p.SLOT_GATE[slot] = p.GATE[i]; p.TOKSLOT[i] = slot;
    }
    for (int i = blockIdx.x * NTHR + tid; i < nrows; i += gridDim.x * NTHR) p.SLOT_GATE[ntr * 256 + i] = 1.f;
    for (int e = blockIdx.x; e < 256; e += gridDim.x) {
        const int c = cnt[e], pe = (c + 255) & ~255;
        for (int s = c + tid; s < pe; s += NTHR) { p.SLOT_TOK[offs[e] + s] = rbase; p.SLOT_GATE[offs[e] + s] = 0.f; }
    }
}

struct EpAct {
    bf16_t* ACT; int slot0; int nt;
    __device__ __forceinline__ void operator()(const f32x4 (&acc)[4][4], int wm, int wn, int lane) const {
#pragma unroll
        for (int i = 0; i < 4; ++i) {
            const int row = slot0 + EP_ROW(i);
#pragma unroll
            for (int j = 0; j < 2; ++j) {
                const int col = nt * 64 + wn * 32 + j * 16 + (lane >> 4) * 4;
                const f32x4 h1 = acc[i][j], h3 = acc[i][j + 2];
                u32x2 wv; wv.x = pk2(silu_f(h1[0]) * h3[0], silu_f(h1[1]) * h3[1]); wv.y = pk2(silu_f(h1[2]) * h3[2], silu_f(h1[3]) * h3[3]);
                *(u32x2*)(ACT + (size_t)row * 256 + col) = wv;
            }
        }
    }
};
__device__ __forceinline__ void phase_moe1(const Params& p, unsigned char* lds, int layer) {
    const int rbase = layer == 0 ? 0 : NCTX; const int nsh = (NT - rbase) / 256; const int ntr = p.META[layer * 64];
    mg8::MoeOrder S; S.ntr = ntr; S.npn = 2; S.nwg = (ntr + nsh) * 2; S.G = gridDim.x; S.c = blockIdx.x; S.K = 1024; S.rbase = rbase; S.gather = true;
    S.A = (const char*)p.U; S.Wexp = (const char*)(p.WT_W13 + (size_t)layer * 256 * 512 * 1024); S.wstride = (size_t)512 * 1024 * 2; S.Wsh = (const char*)(p.WT_SH13 + (size_t)layer * 512 * 1024);
    S.tile_e = p.TILE_E; S.slot_tok = p.SLOT_TOK;
    mg8::EpiAct E{p.ACT};
    mg8::gemm_phase<mg8::EpiAct, mg8::MoeOrder, true>((MG_LAS unsigned char*)lds, 1024, S, E);
}
struct EpYs {
    bf16_t* YS; const float* gate; int slot0; int n0;
    __device__ __forceinline__ void operator()(const f32x4 (&acc)[4][4], int wm, int wn, int lane) const {
#pragma unroll
        for (int i = 0; i < 4; ++i) {
            const int row = slot0 + EP_ROW(i); const float g = gate ? gate[row] : 1.f;
#pragma unroll
            for (int j = 0; j < 4; ++j) {
                const int col = n0 + EP_COL(j); const f32x4 v = acc[i][j] * g;
                u32x2 wv; wv.x = pk2(v[0], v[1]); wv.y = pk2(v[2], v[3]);
                *(u32x2*)(YS + (size_t)row * DM + col) = wv;
            }
        }
    }
};
__device__ __forceinline__ void phase_moe2(const Params& p, unsigned char* lds, int layer) {
    const int rbase = layer == 0 ? 0 : NCTX; const int nsh = (NT - rbase) / 256; const int ntr = p.META[layer * 64];
    mg8::MoeOrder S; S.ntr = ntr; S.npn = 4; S.nwg = (ntr + nsh) * 4; S.G = gridDim.x; S.c = blockIdx.x; S.K = 256; S.rbase = rbase; S.gather = false;
    S.A = (const char*)p.ACT; S.Wexp = (const char*)(p.WT_W2 + (size_t)layer * 256 * 1024 * 256); S.wstride = (size_t)1024 * 256 * 2; S.Wsh = (const char*)(p.WT_SH2 + (size_t)layer * 1024 * 256);
    S.tile_e = p.TILE_E; S.slot_tok = p.SLOT_TOK;
    mg8::EpiYs E{p.YS, p.SLOT_GATE, ntr};
    mg8::gemm_phase<mg8::EpiYs, mg8::MoeOrder, false>((MG_LAS unsigned char*)lds, 256, S, E);
}
__device__ __forceinline__ void phase_combine(const Params& p, int layer) {
    const int lane = threadIdx.x & 63, w = threadIdx.x >> 6;
    const int rbase = layer == 0 ? 0 : NCTX; const int nrows = NT - rbase;
    const int ntr = p.META[layer * 64];
    const float* lg = p.ln2_g + layer * DM; const float* lb = p.ln2_b + layer * DM;
    for (int t = blockIdx.x * 8 + w; t < nrows; t += gridDim.x * 8) {
        const int r = rbase + t;
        int myslot = 0; if (lane < 8) myslot = p.TOKSLOT[(size_t)t * 8 + lane]; if (lane == 8) myslot = ntr * 256 + t;
        f32x4 mo[4];
#pragma unroll
        for (int i = 0; i < 4; ++i) mo[i] = (f32x4){0.f, 0.f, 0.f, 0.f};
#pragma unroll 1
        for (int k = 0; k < 9; ++k) {
            const int slot = __shfl(myslot, k);
            const unsigned char* yr = (const unsigned char*)p.YS + (size_t)slot * DM;
#pragma unroll
            for (int i = 0; i < 4; ++i) { const int wv = *(const int*)(yr + i * 256 + lane * 4);
                const f32x2_t lo = __builtin_amdgcn_cvt_pk_f32_fp8(wv, false), hi = __builtin_amdgcn_cvt_pk_f32_fp8(wv, true);
                mo[i][0] += lo.x; mo[i][1] += lo.y; mo[i][2] += hi.x; mo[i][3] += hi.y; }
        }
        const float* md = p.MOD + ((size_t)layer * 9 + row_mod(r)) * 6144 + 5120;
        f32x4 v[4]; float s = 0.f;
#pragma unroll
        for (int i = 0; i < 4; ++i) { const int col = i * 256 + lane * 4; v[i] = *(const f32x4*)(p.X1 + (size_t)r * DM + col) * DN_ALPHA + *(const f32x4*)(md + col) * (mo[i] * (1.f / 64.f)); s += (v[i][0] + v[i][1]) + (v[i][2] + v[i][3]); }
        const float mean = wave_sum(s) * (1.f / 1024.f); float q = 0.f;
#pragma unroll
        for (int i = 0; i < 4; ++i) { const f32x4 d = v[i] - mean; q += (d[0] * d[0] + d[1] * d[1]) + (d[2] * d[2] + d[3] * d[3]); }
        const float rstd = rsqrtf(wave_sum(q) * (1.f / 1024.f) + 1e-5f);
        float* dst = layer == 0 ? p.X2 + (size_t)r * DM : p.out + (size_t)t * DM;
#pragma unroll
        for (int i = 0; i < 4; ++i) { const int col = i * 256 + lane * 4; f32x4 ov = (v[i] - mean) * rstd * *(const f32x4*)(lg + col) + *(const f32x4*)(lb + col);
#ifdef SANITIZE
            for (int e = 0; e < 4; ++e) { float z = ov[e]; if (!(fabsf(z) < 1e4f)) z = 100.f; ov[e] = z; }
#endif
            *(f32x4*)(dst + col) = ov;
            if (layer == 0) { const float* m1 = p.MOD + ((size_t)9 + row_mod(r)) * 6144; const f32x4 hv = ov * (*(const f32x4*)(m1 + 1024 + col) + 1.f) + *(const f32x4*)(m1 + col); u32x2 hw; hw.x = pk2(hv[0], hv[1]); hw.y = pk2(hv[2], hv[3]); *(u32x2*)(p.HIN + (size_t)r * DM + col) = hw; } }
    }
}

typedef float f32x2 __attribute__((ext_vector_type(2)));
__device__ __forceinline__ f32x2 cmul(f32x2 a, f32x2 b) { return (f32x2){a.x * b.x - a.y * b.y, a.x * b.y + a.y * b.x}; }
#define SQH 0.70710678118654752f
__device__ __forceinline__ void fft_dif8(f32x2* X, const int q) {
    __syncthreads();
#pragma unroll 1
    for (int o = threadIdx.x; o < 1024; o += NTHR) {
        const int pp = o & (q - 1), base = ((o - pp) << 3) + pp;
        f32x2 x[8];
#pragma unroll
        for (int m = 0; m < 8; ++m) x[m] = X[base + m * q];
        const float rev = -(float)pp / (float)(8 * q);
        const f32x2 w1 = {__builtin_amdgcn_cosf(rev), __builtin_amdgcn_sinf(rev)}; const f32x2 w2 = cmul(w1, w1), w4 = cmul(w2, w2);
        { f32x2 a = x[0], b = x[4]; x[0] = a + b; x[4] = cmul(a - b, w1); }
        { f32x2 a = x[1], b = x[5]; x[1] = a + b; x[5] = cmul(a - b, cmul(w1, (f32x2){SQH, -SQH})); }
        { f32x2 a = x[2], b = x[6]; x[2] = a + b; x[6] = cmul(a - b, (f32x2){w1.y, -w1.x}); }
        { f32x2 a = x[3], b = x[7]; x[3] = a + b; x[7] = cmul(a - b, cmul(w1, (f32x2){-SQH, -SQH})); }
#pragma unroll
        for (int blk = 0; blk < 8; blk += 4) {
            { f32x2 a = x[blk], b = x[blk + 2]; x[blk] = a + b; x[blk + 2] = cmul(a - b, w2); }
            { f32x2 a = x[blk + 1], b = x[blk + 3]; x[blk + 1] = a + b; x[blk + 3] = cmul(a - b, (f32x2){w2.y, -w2.x}); }
        }
#pragma unroll
        for (int m = 0; m < 8; m += 2) { f32x2 a = x[m], b = x[m + 1]; x[m] = a + b; x[m + 1] = cmul(a - b, w4); }
#pragma unroll
        for (int m = 0; m < 8; ++m) X[base + m * q] = x[m];
    }
}
__device__ __forceinline__ void fft_dit8(f32x2* X, const int q) {
    __syncthreads();
#pragma unroll 1
    for (int o = threadIdx.x; o < 1024; o += NTHR) {
        const int pp = o & (q - 1), base = ((o - pp) << 3) + pp;
        f32x2 x[8];
#pragma unroll
        for (int m = 0; m < 8; ++m) x[m] = X[base + m * q];
        const float rev = (float)pp / (float)(8 * q);
        const f32x2 w1 = {__builtin_amdgcn_cosf(rev), __builtin_amdgcn_sinf(rev)}; const f32x2 w2 = cmul(w1, w1), w4 = cmul(w2, w2);
#pragma unroll
        for (int m = 0; m < 8; m += 2) { f32x2 a = x[m], b = cmul(x[m + 1], w4); x[m] = a + b; x[m + 1] = a - b; }
#pragma unroll
        for (int blk = 0; blk < 8; blk += 4) {
            { f32x2 a = x[blk], b = cmul(x[blk + 2], w2); x[blk] = a + b; x[blk + 2] = a - b; }
            { f32x2 a = x[blk + 1], b = cmul(x[blk + 3], (f32x2){-w2.y, w2.x}); x[blk + 1] = a + b; x[blk + 3] = a - b; }
        }
        { f32x2 a = x[0], b = cmul(x[4], w1); x[0] = a + b; x[4] = a - b; }
        { f32x2 a = x[1], b = cmul(x[5], cmul(w1, (f32x2){SQH, SQH})); x[1] = a + b; x[5] = a - b; }
        { f32x2 a = x[2], b = cmul(x[6], (f32x2){-w1.y, w1.x}); x[2] = a + b; x[6] = a - b; }
        { f32x2 a = x[3], b = cmul(x[7], cmul(w1, (f32x2){-SQH, SQH})); x[3] = a + b; x[7] = a - b; }
#pragma unroll
        for (int m = 0; m < 8; ++m) X[base + m * q] = x[m];
    }
}
__device__ __forceinline__ void fft_r2(f32x2* X) {
    __syncthreads();
#pragma unroll 1
    for (int k = threadIdx.x; k < 4096; k += NTHR) { const f32x4 v = *(const f32x4*)(X + 2 * k); *(f32x4*)(X + 2 * k) = (f32x4){v[0] + v[2], v[1] + v[3], v[0] - v[2], v[1] - v[3]}; }
}
__device__ __forceinline__ void fft_fwd(f32x2* X) { fft_dif8(X, 1024); fft_dif8(X, 128); fft_dif8(X, 16); fft_dif8(X, 2); fft_r2(X); }
__device__ __forceinline__ void fft_inv(f32x2* X) { fft_r2(X); fft_dit8(X, 2); fft_dit8(X, 16); fft_dit8(X, 128); fft_dit8(X, 1024); }

__device__ __forceinline__ void phase_filtfft(const Params& p, unsigned char* lds) {
    f32x2* X = (f32x2*)lds;
    for (int u = blockIdx.x; u < 1024; u += gridDim.x) {
        const float* g = p.G + (size_t)u * 8192;
        __syncthreads();
        for (int tau = threadIdx.x; tau < 8192; tau += NTHR) X[tau] = (f32x2){g[(tau + 4096) & 8191], 0.f};
        fft_fwd(X);
        __syncthreads();
        f32x2* o = p.FF + (size_t)u * 8192;
        for (int r = threadIdx.x; r < 8192; r += NTHR) o[r] = X[r] * (1.f / 8192.f);
    }
}
__device__ __forceinline__ void phase_shortconv(const Params& p, unsigned char* lds) {
    float* T = (float*)lds;
    const int tid = threadIdx.x, lane = tid & 63, w = tid >> 6;
    float v[10];
#define SC_LOAD(uu) do { const int ct_ = (uu) % 24, tt_ = ((uu) / 24) & 63, b_ = (uu) / (24 * 64); const int t0_ = tt_ * 64 + w * 8; \
        const bf16_t* pr_ = p.P + (size_t)(NCTX + b_ * 4096 + t0_) * ODW + ct_ * 64 + lane; \
        _Pragma("unroll") for (int k = 0; k < 10; ++k) { const int t = t0_ + k - 1; v[k] = (t >= 0 && t < 4096) ? bf2f(pr_[(ptrdiff_t)(k - 1) * ODW]) : 0.f; } } while (0)
    if ((int)blockIdx.x < 8 * 64 * 24) SC_LOAD((int)blockIdx.x);
    for (int u = blockIdx.x; u < 8 * 64 * 24; u += gridDim.x) {
        const int ct = u % 24, tt = (u / 24) & 63, b = u / (24 * 64);
        const int c = ct * 64 + lane;
        const float w0 = p.hy_conv_w[c], w1 = p.hy_conv_w[1536 + c], w2 = p.hy_conv_w[3072 + c], cb = p.hy_conv_b[c];
        float o[8];
#pragma unroll
        for (int k = 0; k < 8; ++k) o[k] = cb + v[k] * w0 + v[k + 1] * w1 + v[k + 2] * w2;
        if (u + (int)gridDim.x < 8 * 64 * 24) SC_LOAD(u + (int)gridDim.x);
        __syncthreads();
#pragma unroll
        for (int k = 0; k < 8; ++k) T[lane * 65 + w * 8 + k] = o[k];
        __syncthreads();
        const int cc = tid >> 3, seg = tid & 7; const int cg = ct * 64 + cc; const int plane = cg >> 9, cl = cg & 511;
        float* dst = p.UH + (((size_t)plane * 8 + b) * 512 + cl) * 4096 + tt * 64 + seg * 8;
        f32x4 o0, o1;
#pragma unroll
        for (int e = 0; e < 4; ++e) { o0[e] = T[cc * 65 + seg * 8 + e]; o1[e] = T[cc * 65 + seg * 8 + 4 + e]; }
        *(f32x4*)dst = o0; *(f32x4*)(dst + 4) = o1;
    }
#undef SC_LOAD
}
__device__ __forceinline__ void phase_hyena(const Params& p, unsigned char* lds) {
    f32x2* X = (f32x2*)lds;
    const int tid = threadIdx.x;
    for (int u = blockIdx.x; u < 2048; u += gridDim.x) {
        const int c = u >> 2, b0 = (u & 3) * 2, b1 = b0 + 1;
        const float* v0p = p.UH + ((size_t)(0 * 8 + b0) * 512 + c) * 4096; const float* v1p = p.UH + ((size_t)(0 * 8 + b1) * 512 + c) * 4096;
        float zr[8], zi[8];
        __syncthreads();
#pragma unroll
        for (int k = 0; k < 8; ++k) { const int t = tid + NTHR * k; zr[k] = v0p[t]; zi[k] = v1p[t]; X[t] = (f32x2){zr[k], zi[k]}; X[t + 4096] = (f32x2){0.f, 0.f}; }
#pragma unroll 1
        for (int n = 0; n < 2; ++n) {
            fft_fwd(X);
            __syncthreads();
            const f32x2* ff = p.FF + ((size_t)n * 512 + c) * 8192;
            for (int r = tid; r < 8192; r += NTHR) X[r] = cmul(X[r], ff[r]);
            fft_inv(X);
            __syncthreads();
            const float bias = p.hy_bias[n * 512 + c];
            const float* g0p = p.UH + ((size_t)((n + 1) * 8 + b0) * 512 + c) * 4096; const float* g1p = p.UH + ((size_t)((n + 1) * 8 + b1) * 512 + c) * 4096;
#pragma unroll
            for (int k = 0; k < 8; ++k) {
                const int t = tid + NTHR * k; const f32x2 y = X[t];
                zr[k] = g0p[t] * (y.x + zr[k] * bias); zi[k] = g1p[t] * (y.y + zi[k] * bias);
                if (n == 0) { X[t] = (f32x2){zr[k], zi[k]}; X[t + 4096] = (f32x2){0.f, 0.f}; }
                else { p.Z1[((size_t)b0 * 512 + c) * 4096 + t] = zr[k]; p.Z1[((size_t)b1 * 512 + c) * 4096 + t] = zi[k]; }
            }
        }
    }
}
__device__ __forceinline__ void phase_zt2y(const Params& p, unsigned char* lds) {
    float* T = (float*)lds;
    const int tid = threadIdx.x;
    for (int u = blockIdx.x; u < 8 * 64 * 8; u += gridDim.x) {
        const int ct = u & 7, tt = (u >> 3) & 63, b = u >> 9;
        const int cc = tid >> 3, seg = tid & 7;
        const float* src = p.Z1 + ((size_t)b * 512 + ct * 64 + cc) * 4096 + tt * 64 + seg * 8;
        const f32x4 i0 = *(const f32x4*)src, i1 = *(const f32x4*)(src + 4);
        __syncthreads();
#pragma unroll
        for (int e = 0; e < 4; ++e) { T[cc * 65 + seg * 8 + e] = i0[e]; T[cc * 65 + seg * 8 + 4 + e] = i1[e]; }
        __syncthreads();
        const int t = tid >> 3, cs = tid & 7; f32x4 o0, o1;
#pragma unroll
        for (int e = 0; e < 4; ++e) { o0[e] = T[(cs * 8 + e) * 65 + t]; o1[e] = T[(cs * 8 + 4 + e) * 65 + t]; }
        *(bf16x8*)(p.Y + (size_t)(NCTX + b * 4096 + tt * 64 + t) * DM + ct * 64 + cs * 8) = pack8(o0, o1);
    }
}
struct RwRaw { f32x4 own, sh; };
__device__ __forceinline__ RwRaw rw_raw4(const Params& p, int r, int cc) {
    const bf16_t* pr = p.P + (size_t)r * ODW + 1536 + cc;
    const bool isctx = r < NCTX; const int t = isctx ? (r & 255) : ((r - NCTX) & 4095); const int gr = t >> 6, gc = t & 63;
    const bool v0 = isctx ? (t > 0) : (gc > 0), v1 = isctx ? (t < 255) : (gc < 63), v2 = isctx ? (t > 0) : (gr > 0), v3 = isctx ? (t < 255) : (gr < 63);
    const int o2 = isctx ? -ODW : -64 * ODW, o3 = isctx ? ODW : 64 * ODW;
    const bf16_t x0 = pr[v0 ? -ODW : 0], x1 = pr[(v1 ? ODW : 0) + 1], x2 = pr[(v2 ? o2 : 0) + 2], x3 = pr[(v3 ? o3 : 0) + 3];
    RwRaw R; R.own = bf4_to_f32(*(const u32x2*)pr);
    R.sh[0] = v0 ? bf2f(x0) : 0.f; R.sh[1] = v1 ? bf2f(x1) : 0.f; R.sh[2] = v2 ? bf2f(x2) : 0.f; R.sh[3] = v3 ? bf2f(x3) : 0.f;
    return R;
}
__device__ __forceinline__ f32x4 rw_mix(const RwRaw& R, const f32x4 mu4) { return R.own + mu4 * (R.sh - R.own); }
__device__ __forceinline__ f32x4 rw_mix4(const Params& p, int r, int cc) { const RwRaw R = rw_raw4(p, r, cc); return rw_mix(R, *(const f32x4*)(p.rw_mu + cc)); }
__device__ __forceinline__ float fsig(float x) { return __builtin_amdgcn_rcpf(1.f + __expf(-x)); }
__device__ __forceinline__ void phase_rwstreams(const Params& p, unsigned char* lds) {
    constexpr int XS = 328, KS = 520;
    bf16_t* X = (bf16_t*)lds;
    float* ss = (float*)(X + 64 * XS);
    bf16_t* KMX = (bf16_t*)(ss + 512);
    const int tid = threadIdx.x, lane = tid & 63, h = tid >> 6, q4 = lane >> 4, l15 = lane & 15;
    for (int ti = blockIdx.x; ti < NT / 64; ti += gridDim.x) {
        const int tile = mg8::xcd_remap(ti, NT / 64);
        const int r0 = tile * 64;
        __syncthreads();
#pragma unroll 5
        for (int it = tid; it < 64 * 80; it += NTHR) {
            const int row = it / 80, qd = it % 80, cc = qd * 4;
            f32x4 v = rw_mix4(p, r0 + row, 1536 + cc);
            if (cc < 128) {
#pragma unroll
                for (int e = 0; e < 4; ++e) v[e] = 1.f - 2.f * __builtin_amdgcn_rcpf(1.f + __expf(2.f * v[e]));
            } else if (cc >= 192) {
#pragma unroll
                for (int e = 0; e < 4; ++e) v[e] = fsig(v[e]);
            }
            u32x2 wv; wv.x = pk2(v[0], v[1]); wv.y = pk2(v[2], v[3]);
            *(u32x2*)(X + row * XS + cc) = wv;
        }
        {
            RwRaw cur[6], nxt[6];
#pragma unroll
            for (int j = 0; j < 6; ++j) { const int it = tid + j * NTHR; nxt[j] = rw_raw4(p, r0 + it / 384, (it % 384) * 4); }
#pragma unroll 1
            for (int bt = 0; bt < 8; ++bt) {
#pragma unroll
                for (int j = 0; j < 6; ++j) cur[j] = nxt[j];
                if (bt + 1 < 8) {
#pragma unroll
                    for (int j = 0; j < 6; ++j) { const int it = tid + ((bt + 1) * 6 + j) * NTHR; nxt[j] = rw_raw4(p, r0 + it / 384, (it % 384) * 4); }
                }
                asm volatile("" ::: "memory");
#pragma unroll
                for (int j = 0; j < 6; ++j) {
                    const int it = tid + (bt * 6 + j) * NTHR; const int row = it / 384, qd = it % 384; const int r = r0 + row;
                    const f32x4 v = rw_mix(cur[j], *(const f32x4*)(p.rw_mu + qd * 4));
                    if (qd < 128) *(u32x2*)(p.RR + (size_t)r * 512 + qd * 4) = f32_to_bf4(v);
                    else if (qd >= 256) *(u32x2*)(p.VV + (size_t)r * 512 + (qd - 256) * 4) = f32_to_bf4(v);
                    else {
                        const int kq = qd - 128;
                        const f32x4 kr = v * *(const f32x4*)(p.rw_k_k + kq * 4);
                        float sacc = (kr[0] * kr[0] + kr[1] * kr[1]) + (kr[2] * kr[2] + kr[3] * kr[3]);
                        sacc += __shfl_xor(sacc, 1); sacc += __shfl_xor(sacc, 2); sacc += __shfl_xor(sacc, 4); sacc += __shfl_xor(sacc, 8);
                        if ((lane & 15) == 0) ss[row * 8 + (kq >> 4)] = sacc;
                        *(u32x2*)(KMX + row * KS + kq * 4) = f32_to_bf4(v);
                    }
                }
                asm volatile("" ::: "memory");
            }
        }
        __syncthreads();
#pragma unroll 4
        for (int it = tid; it < 64 * 128; it += NTHR) {
            const int row = it >> 7, kq = it & 127;
            const u32x2 mk = *(const u32x2*)(KMX + row * KS + kq * 4);
            const f32x4 k4 = {__uint_as_float(mk.x << 16), __uint_as_float(mk.x & 0xffff0000u), __uint_as_float(mk.y << 16), __uint_as_float(mk.y & 0xffff0000u)};
            const float rn = __builtin_amdgcn_rsqf(fmaxf(ss[row * 8 + (kq >> 4)], 1e-24f));
            *(u32x2*)(p.KK + (size_t)(r0 + row) * 512 + kq * 4) = f32_to_bf4(k4 * *(const f32x4*)(p.rw_k_k + kq * 4) * rn);
        }
#pragma unroll 1
        for (int ct = 0; ct < 4; ++ct) {
            const int c0 = h * 64 + ct * 16 + q4 * 4;
            const int cw = h * 64 + ct * 16 + l15;
            bf16x8 wf[2], wb[2], wa[2], wg[4];
#pragma unroll
            for (int ks = 0; ks < 2; ++ks) { wf[ks] = *(const bf16x8*)(p.WT_RWF + (size_t)cw * 64 + ks * 32 + q4 * 8); wb[ks] = *(const bf16x8*)(p.WT_RWB + (size_t)cw * 64 + ks * 32 + q4 * 8); wa[ks] = *(const bf16x8*)(p.WT_RWA + (size_t)cw * 64 + ks * 32 + q4 * 8); }
#pragma unroll
            for (int ks = 0; ks < 4; ++ks) wg[ks] = *(const bf16x8*)(p.WT_RWG + (size_t)cw * 128 + ks * 32 + q4 * 8);
            const f32x4 w0f = *(const f32x4*)(p.rw_w0 + c0), w0b = *(const f32x4*)(p.rw_w0 + 512 + c0), a0 = *(const f32x4*)(p.rw_a0 + c0), kkw = *(const f32x4*)(p.rw_k_k + c0), kaw = *(const f32x4*)(p.rw_k_a + c0);
#pragma unroll 1
            for (int rt = 0; rt < 4; ++rt) {
                const int rloc = rt * 16 + l15; const int row = r0 + rloc;
                f32x4 aF = {0.f, 0.f, 0.f, 0.f}, aB = aF, aA = aF, aG = aF;
                const bf16_t* xr = X + rloc * XS + q4 * 8;
#pragma unroll
                for (int ks = 0; ks < 2; ++ks) {
                    aF = __builtin_amdgcn_mfma_f32_16x16x32_bf16(wf[ks], *(const bf16x8*)(xr + ks * 32), aF, 0, 0, 0);
                    aB = __builtin_amdgcn_mfma_f32_16x16x32_bf16(wb[ks], *(const bf16x8*)(xr + 64 + ks * 32), aB, 0, 0, 0);
                    aA = __builtin_amdgcn_mfma_f32_16x16x32_bf16(wa[ks], *(const bf16x8*)(xr + 128 + ks * 32), aA, 0, 0, 0);
                }
#pragma unroll
                for (int ks = 0; ks < 4; ++ks) aG = __builtin_amdgcn_mfma_f32_16x16x32_bf16(wg[ks], *(const bf16x8*)(xr + 192 + ks * 32), aG, 0, 0, 0);
                const u32x2 mk = *(const u32x2*)(KMX + rloc * KS + c0);
                const f32x4 k4 = {__uint_as_float(mk.x << 16), __uint_as_float(mk.x & 0xffff0000u), __uint_as_float(mk.y << 16), __uint_as_float(mk.y & 0xffff0000u)};
                const float rn = __builtin_amdgcn_rsqf(fmaxf(ss[rloc * 8 + h], 1e-24f));
                const size_t o = (size_t)row * 512 + c0;
                f32x4 ldf, ldb, bvv, kp;
#pragma unroll
                for (int e = 0; e < 4; ++e) {
                    ldf[e] = -0.60653065971f * fsig(w0f[e] + aF[e]); ldb[e] = -0.60653065971f * fsig(w0b[e] + aB[e]);
                    const float av = fsig(a0[e] + aA[e]);
                    bvv[e] = k4[e] * kkw[e] * rn * av; kp[e] = k4[e] * (1.f + (av - 1.f) * kaw[e]);
                }
                *(f32x4*)(p.DEC + o) = ldf; *(f32x4*)(p.DEC + (size_t)NT * 512 + o) = ldb;
                *(u32x2*)(p.BV + o) = f32_to_bf4(bvv); *(u32x2*)(p.KP + o) = f32_to_bf4(kp); *(u32x2*)(p.GT + o) = f32_to_bf4(aG + 0.f);
            }
        }
    }
}
#define RW_NUNIT 8704
__device__ __forceinline__ void phase_rwprep(const Params& p, unsigned char* lds) {
    constexpr int SL = 64 * 72;
    float* MT = (float*)lds;
    float* ptot = MT + 64 * 68;
    float* gcv = ptot + 512;
    bf16_t* L = (bf16_t*)(gcv + 64);
    bf16_t *sBp = L, *sKp = L + SL, *sKKm = L + 2 * SL, *sRg = L + 3 * SL, *sBpT = L + 4 * SL, *sKpT = L + 5 * SL, *sKKmT = L + 6 * SL, *sVT = L + 7 * SL, *sNT = L + 8 * SL, *sArT = L + 9 * SL, *sNrT = L + 10 * SL;
    bf16_t *sX2 = sBp, *sTmT = sKp, *sWn = sKKm, *sU2n = sNT;
    const int tid = threadIdx.x, lane = tid & 63, w = tid >> 6, q4 = lane >> 4, l15 = lane & 15;
    for (int u = blockIdx.x; u < RW_NUNIT; u += gridDim.x) {
        const int c = u % 68, h = (u / 68) & 7, b = (u / (68 * 8)) & 7, dir = u / (68 * 64);
        __syncthreads();
        {
            const int k = lane, part = w;
            float lcv[8], ldv[8], kkv[8], bvv[8], kpv[8], rv[8]; float lc = 0.f;
#pragma unroll
            for (int tt = 0; tt < 8; ++tt) {
                const size_t o = (size_t)row_of(dir, b, c * 64 + part * 8 + tt) * 512 + h * 64 + k;
                ldv[tt] = p.DEC[(size_t)dir * NT * 512 + o]; kkv[tt] = bf2f(p.KK[o]); bvv[tt] = bf2f(p.BV[o]); kpv[tt] = bf2f(p.KP[o]); rv[tt] = bf2f(p.RR[o]);
                lc += ldv[tt]; lcv[tt] = lc;
            }
            ptot[part * 64 + k] = lc;
            {
                f32x4 v0, v1;
#pragma unroll
                for (int e = 0; e < 8; ++e) { const float vv = bf2f(p.VV[(size_t)row_of(dir, b, c * 64 + w * 8 + e) * 512 + h * 64 + lane]); if (e < 4) v0[e] = vv; else v1[e - 4] = vv; }
                *(bf16x8*)(sVT + lane * 72 + w * 8) = pack8(v0, v1);
            }
            __syncthreads();
            float off = 0.f, tot = 0.f;
#pragma unroll
            for (int pp = 0; pp < 8; ++pp) { const float tv = ptot[pp * 64 + k]; if (pp < part) off += tv; tot += tv; }
            if (part == 0) gcv[k] = __expf(tot);
            float xa[8], xb[8], xc[8];
#pragma unroll
            for (int tt = 0; tt < 8; ++tt) {
                const int j = part * 8 + tt; const float lw = lcv[tt] + off;
                const float eg = __expf(lw), ig = __expf(-lw), egm = __expf(lw - ldv[tt]);
                xa[tt] = kkv[tt] * egm; xb[tt] = bvv[tt] * ig; xc[tt] = kpv[tt] * ig;
                sKKm[j * 72 + k] = f2bf(xa[tt]); sBp[j * 72 + k] = f2bf(xb[tt]); sKp[j * 72 + k] = f2bf(xc[tt]); sRg[j * 72 + k] = f2bf(rv[tt] * eg);
            }
            *(bf16x8*)(sKKmT + k * 72 + part * 8) = pack8((f32x4){xa[0], xa[1], xa[2], xa[3]}, (f32x4){xa[4], xa[5], xa[6], xa[7]});
            *(bf16x8*)(sBpT + k * 72 + part * 8) = pack8((f32x4){xb[0], xb[1], xb[2], xb[3]}, (f32x4){xb[4], xb[5], xb[6], xb[7]});
            *(bf16x8*)(sKpT + k * 72 + part * 8) = pack8((f32x4){xc[0], xc[1], xc[2], xc[3]}, (f32x4){xc[4], xc[5], xc[6], xc[7]});
        }
        __syncthreads();
#pragma unroll
        for (int rep = 0; rep < 2; ++rep) {
            const int pos = w + rep * 8, tt_ = pos >> 2, jt_ = pos & 3;
            f32x4 aM = {0.f, 0.f, 0.f, 0.f}, aN = aM, aA = aM, aR = aM;
#pragma unroll
            for (int ks = 0; ks < 2; ++ks) {
                const bf16x8 fbp = *(const bf16x8*)(sBp + (jt_ * 16 + l15) * 72 + ks * 32 + q4 * 8), fkp = *(const bf16x8*)(sKp + (jt_ * 16 + l15) * 72 + ks * 32 + q4 * 8);
                const bf16x8 fkk = *(const bf16x8*)(sKKm + (tt_ * 16 + l15) * 72 + ks * 32 + q4 * 8), frg = *(const bf16x8*)(sRg + (tt_ * 16 + l15) * 72 + ks * 32 + q4 * 8);
                aM = __builtin_amdgcn_mfma_f32_16x16x32_bf16(fbp, fkk, aM, 0, 0, 0); aN = __builtin_amdgcn_mfma_f32_16x16x32_bf16(fkp, fkk, aN, 0, 0, 0);
                aA = __builtin_amdgcn_mfma_f32_16x16x32_bf16(fbp, frg, aA, 0, 0, 0); aR = __builtin_amdgcn_mfma_f32_16x16x32_bf16(fkp, frg, aR, 0, 0, 0);
            }
            const int t = tt_ * 16 + l15, j0 = jt_ * 16 + q4 * 4;
#pragma unroll
            for (int e = 0; e < 4; ++e) { const bool st = (j0 + e) < t, le = (j0 + e) <= t; aM[e] = st ? aM[e] : 0.f; aN[e] = st ? aN[e] : 0.f; aA[e] = le ? aA[e] : 0.f; aR[e] = le ? aR[e] : 0.f; }
            *(f32x4*)(MT + t * 68 + j0) = aM;
            u32x2 wv; wv.x = pk2(aN[0], aN[1]); wv.y = pk2(aN[2], aN[3]); *(u32x2*)(sNT + t * 72 + j0) = wv;
            wv.x = pk2(aA[0], aA[1]); wv.y = pk2(aA[2], aA[3]); *(u32x2*)(sArT + t * 72 + j0) = wv;
            wv.x = pk2(aR[0], aR[1]); wv.y = pk2(aR[2], aR[3]); *(u32x2*)(sNrT + t * 72 + j0) = wv;
        }
        __syncthreads();
        if (w == 0) {
            float tm[64];
#pragma unroll
            for (int j = 0; j < 64; ++j) tm[j] = 0.f;
#pragma unroll
            for (int t = 0; t < 64; ++t) {
                float sacc = (t == lane) ? 1.f : 0.f;
#pragma unroll
                for (int j4 = 0; j4 < (t + 3) / 4; ++j4) { const f32x4 m4 = *(const f32x4*)(MT + t * 68 + j4 * 4);
#pragma unroll
                    for (int e = 0; e < 4; ++e) sacc -= tm[j4 * 4 + e] * m4[e]; }
                tm[t] = sacc;
                sTmT[t * 72 + lane] = f2bf(sacc);
            }
        } else {
            for (int tile = w - 1; tile < 16; tile += 7) {
                const int vt_ = tile >> 2, tt_ = tile & 3;
                f32x4 acc = {0.f, 0.f, 0.f, 0.f};
#pragma unroll
                for (int ks = 0; ks < 2; ++ks) {
                    const bf16x8 fa = *(const bf16x8*)(sNT + (tt_ * 16 + l15) * 72 + ks * 32 + q4 * 8), fb = *(const bf16x8*)(sVT + (vt_ * 16 + l15) * 72 + ks * 32 + q4 * 8);
                    acc = __builtin_amdgcn_mfma_f32_16x16x32_bf16(fa, fb, acc, 0, 0, 0);
                }
                u32x2 wv; wv.x = pk2(acc[0], acc[1]); wv.y = pk2(acc[2], acc[3]); *(u32x2*)(sX2 + (vt_ * 16 + l15) * 72 + tt_ * 16 + q4 * 4) = wv;
            }
        }
        __syncthreads();
#pragma unroll
        for (int rep = 0; rep < 4; ++rep) {
            const int tile = w * 4 + rep, it_ = tile >> 2, tt_ = tile & 3;
            const bf16_t* rhs = it_ < 4 ? sKKmT + (it_ * 16 + l15) * 72 : sX2 + ((it_ - 4) * 16 + l15) * 72;
            f32x4 acc = {0.f, 0.f, 0.f, 0.f};
#pragma unroll
            for (int ks = 0; ks < 2; ++ks) {
                const bf16x8 fa = *(const bf16x8*)(sTmT + (tt_ * 16 + l15) * 72 + ks * 32 + q4 * 8), fb = *(const bf16x8*)(rhs + ks * 32 + q4 * 8);
                acc = __builtin_amdgcn_mfma_f32_16x16x32_bf16(fa, fb, acc, 0, 0, 0);
            }
            bf16_t* dst = it_ < 4 ? sWn + (it_ * 16 + l15) * 72 : sU2n + ((it_ - 4) * 16 + l15) * 72;
            u32x2 wv; wv.x = pk2(-acc[0], -acc[1]); wv.y = pk2(-acc[2], -acc[3]); *(u32x2*)(dst + tt_ * 16 + q4 * 4) = wv;
        }
        __syncthreads();
        {
            const int kind = w >> 1;
            bf16_t* GM = p.GMT + (size_t)u * 4096; bf16_t* QM = p.QMT + (size_t)u * 4096; bf16_t* HM = p.HMB + (size_t)u * 4096; bf16_t* OM = p.OMB + (size_t)u * 4096;
#pragma unroll 1
            for (int rep = 0; rep < 8; ++rep) {
                const int tile = (w & 1) * 8 + rep, rt_ = tile >> 2, ct_ = tile & 3;
                const bf16_t* bmat = (kind < 2) ? sBpT : sArT;
                const bf16_t* amat = (kind == 0 || kind == 2) ? sWn : sU2n;
                f32x4 acc = {0.f, 0.f, 0.f, 0.f};
                if (kind == 0 || kind == 2) {
#pragma unroll
                    for (int ks = 0; ks < 2; ++ks) {
                        const bf16x8 fa = *(const bf16x8*)(amat + (ct_ * 16 + l15) * 72 + ks * 32 + q4 * 8), fb = *(const bf16x8*)(bmat + (rt_ * 16 + l15) * 72 + ks * 32 + q4 * 8);
                        acc = __builtin_amdgcn_mfma_f32_16x16x32_bf16(fa, fb, acc, 0, 0, 0);
                    }
                    const int r = rt_ * 16 + l15, cc = ct_ * 16 + q4 * 4;
                    if (kind == 0) { const float g = gcv[r]; u32x2 wv; wv.x = pk2(g * ((cc == r ? 1.f : 0.f) + acc[0]), g * ((cc + 1 == r ? 1.f : 0.f) + acc[1])); wv.y = pk2(g * ((cc + 2 == r ? 1.f : 0.f) + acc[2]), g * ((cc + 3 == r ? 1.f : 0.f) + acc[3])); *(u32x2*)(GM + r * 64 + cc) = wv; }
                    else { const u32x2 rg = *(const u32x2*)(sRg + r * 72 + cc);
                        u32x2 wv; wv.x = pk2(acc[0] + __uint_as_float(rg.x << 16), acc[1] + __uint_as_float(rg.x & 0xffff0000u)); wv.y = pk2(acc[2] + __uint_as_float(rg.y << 16), acc[3] + __uint_as_float(rg.y & 0xffff0000u)); *(u32x2*)(QM + r * 64 + cc) = wv; }
                } else {
                    const bf16_t* b2 = (kind == 1) ? sKpT : sNrT;
#pragma unroll
                    for (int ks = 0; ks < 2; ++ks) {
                        const bf16x8 fa = *(const bf16x8*)(bmat + (rt_ * 16 + l15) * 72 + ks * 32 + q4 * 8), fb = *(const bf16x8*)(amat + (ct_ * 16 + l15) * 72 + ks * 32 + q4 * 8);
                        acc = __builtin_amdgcn_mfma_f32_16x16x32_bf16(fa, fb, acc, 0, 0, 0);
                        const bf16x8 fa2 = *(const bf16x8*)(b2 + (rt_ * 16 + l15) * 72 + ks * 32 + q4 * 8), fb2 = *(const bf16x8*)(sVT + (ct_ * 16 + l15) * 72 + ks * 32 + q4 * 8);
                        acc = __builtin_amdgcn_mfma_f32_16x16x32_bf16(fa2, fb2, acc, 0, 0, 0);
                    }
                    const int vv = ct_ * 16 + l15, r0 = rt_ * 16 + q4 * 4;
                    if (kind == 1) { const f32x4 g4 = *(const f32x4*)(gcv + r0); acc = acc * g4; }
                    u32x2 wv; wv.x = pk2(acc[0], acc[1]); wv.y = pk2(acc[2], acc[3]);
                    *(u32x2*)((kind == 1 ? HM : OM) + vv * 64 + r0) = wv;
                }
            }
        }
    }
}
__device__ __forceinline__ void phase_rwseq(const Params& p) {
    const int tid = threadIdx.x, lane = tid & 63, w = tid >> 6, q4 = lane >> 4, l15 = lane & 15;
    if (w >= 4) return;
    const int vs = w;
    for (int unit = blockIdx.x; unit < 128; unit += gridDim.x) {
        const int h = unit & 7, b = (unit >> 3) & 7, dir = unit >> 6;
        f32x4 Sacc[4];
#pragma unroll
        for (int t = 0; t < 4; ++t) Sacc[t] = (f32x4){0.f, 0.f, 0.f, 0.f};
        u32x2 gA[4][2][2], qA[4][2][2], gB[4][2][2], qB[4][2][2]; u32x2 hA[4], oA[4], hB[4], oB[4];
#define RWS_LOAD(cc, G_, Q_, H_, O_) do { const size_t cu = (size_t)unit * 68 + (cc); \
        const bf16_t* GM = p.GMT + cu * 4096; const bf16_t* HM = p.HMB + cu * 4096; \
        _Pragma("unroll") for (int kt_ = 0; kt_ < 4; ++kt_) { _Pragma("unroll") for (int ks = 0; ks < 2; ++ks) { \
            G_[kt_][ks][0] = *(const u32x2*)(GM + (kt_ * 16 + l15) * 64 + ks * 32 + q4 * 4); G_[kt_][ks][1] = *(const u32x2*)(GM + (kt_ * 16 + l15) * 64 + ks * 32 + 16 + q4 * 4); } \
            H_[kt_] = *(const u32x2*)(HM + (vs * 16 + l15) * 64 + kt_ * 16 + q4 * 4); } \
        if ((cc) >= 4) { const bf16_t* QM = p.QMT + cu * 4096; const bf16_t* OM = p.OMB + cu * 4096; \
        _Pragma("unroll") for (int kt_ = 0; kt_ < 4; ++kt_) { _Pragma("unroll") for (int ks = 0; ks < 2; ++ks) { \
            Q_[kt_][ks][0] = *(const u32x2*)(QM + (kt_ * 16 + l15) * 64 + ks * 32 + q4 * 4); Q_[kt_][ks][1] = *(const u32x2*)(QM + (kt_ * 16 + l15) * 64 + ks * 32 + 16 + q4 * 4); } \
            O_[kt_] = *(const u32x2*)(OM + (vs * 16 + l15) * 64 + kt_ * 16 + q4 * 4); } } } while (0)
#define RWS_COMP(cc, G_, Q_, H_, O_) do { bf16x8 sb[2]; \
        _Pragma("unroll") for (int ks = 0; ks < 2; ++ks) sb[ks] = pack8(Sacc[2 * ks], Sacc[2 * ks + 1]); \
        if ((cc) >= 4) { _Pragma("unroll") for (int tt_ = 0; tt_ < 4; ++tt_) { f32x4 acc = {__uint_as_float(O_[tt_].x << 16), __uint_as_float(O_[tt_].x & 0xffff0000u), __uint_as_float(O_[tt_].y << 16), __uint_as_float(O_[tt_].y & 0xffff0000u)}; \
            _Pragma("unroll") for (int ks = 0; ks < 2; ++ks) { u32x4 a4; a4.x = Q_[tt_][ks][0].x; a4.y = Q_[tt_][ks][0].y; a4.z = Q_[tt_][ks][1].x; a4.w = Q_[tt_][ks][1].y; \
                acc = __builtin_amdgcn_mfma_f32_16x16x32_bf16(__builtin_bit_cast(bf16x8, a4), sb[ks], acc, 0, 0, 0); } \
            _Pragma("unroll") for (int e = 0; e < 4; ++e) { const int row = row_of(dir, b, (cc) * 64 + tt_ * 16 + q4 * 4 + e); p.O[((size_t)dir * NT + row) * 512 + h * 64 + vs * 16 + l15] = acc[e]; } } } \
        _Pragma("unroll") for (int kt_ = 0; kt_ < 4; ++kt_) { f32x4 acc = {__uint_as_float(H_[kt_].x << 16), __uint_as_float(H_[kt_].x & 0xffff0000u), __uint_as_float(H_[kt_].y << 16), __uint_as_float(H_[kt_].y & 0xffff0000u)}; \
            _Pragma("unroll") for (int ks = 0; ks < 2; ++ks) { u32x4 a4; a4.x = G_[kt_][ks][0].x; a4.y = G_[kt_][ks][0].y; a4.z = G_[kt_][ks][1].x; a4.w = G_[kt_][ks][1].y; \
                acc = __builtin_amdgcn_mfma_f32_16x16x32_bf16(__builtin_bit_cast(bf16x8, a4), sb[ks], acc, 0, 0, 0); } \
            Sacc[kt_] = acc; } } while (0)
        RWS_LOAD(0, gA, qA, hA, oA);
#pragma unroll 1
        for (int c = 0; c < 68; c += 2) {
            RWS_LOAD(c + 1, gB, qB, hB, oB);
            RWS_COMP(c, gA, qA, hA, oA);
            if (c + 2 < 68) RWS_LOAD(c + 2, gA, qA, hA, oA);
            RWS_COMP(c + 1, gB, qB, hB, oB);
        }
#undef RWS_LOAD
#undef RWS_COMP
    }
}
__device__ __forceinline__ void phase_readout1(const Params& p) {
    const int lane = threadIdx.x & 63, h = threadIdx.x >> 6;
    const float lg = p.rw_ln_g[h * 64 + lane], lb = p.rw_ln_b[h * 64 + lane], rk = p.rw_r_k[h * 64 + lane];
    for (int r = NCTX + blockIdx.x; r < NT; r += gridDim.x) {
        const size_t o = (size_t)r * 512 + h * 64 + lane;
        const float ov = p.O[o] + p.O[(size_t)NT * 512 + o];
        const float mean = wave_sum(ov) * (1.f / 64.f); const float d = ov - mean;
        const float var = wave_sum(d * d) * (1.f / 64.f);
        const float on = d * rsqrtf(var + 64e-5f) * lg + lb;
        const float bonus = wave_sum(bf2f(p.RR[o]) * bf2f(p.KP[o]) * rk) * bf2f(p.VV[o]);
        p.Y[(size_t)r * DM + 512 + h * 64 + lane] = f2bf((on + bonus) * bf2f(p.GT[o]));
    }
}

#ifdef PROBE_BUF
__global__ void __launch_bounds__(NTHR) k_probe(Params p) { for (size_t i = (size_t)blockIdx.x * NTHR + threadIdx.x; i < (size_t)NLAT * DM; i += (size_t)gridDim.x * NTHR) {
        float z;
#if PROBE_KIND == 1
        const unsigned q = ((unsigned)i >> 1); z = 0.f; if (q < (unsigned)(NT * 8)) z = (i & 1) ? p.GATE[q] : (float)p.EIDX[q];
#elif PROBE_KIND == 2
        const unsigned q = (unsigned)i; const unsigned ts = q >> 8; z = bf2f(p.ACT[(size_t)p.TOKSLOT[ts] * 256 + (q & 255)]);
#elif PROBE_KIND == 4
        const unsigned q = (unsigned)i; const unsigned ts = q >> 10; z = bf2f(p.YS[((size_t)p.META[0] * 256 + ts) * 1024 + (q & 1023)]);
#elif PROBE_KIND == 6
        const unsigned q = (unsigned)i; const unsigned ts = q >> 8; z = 0.f; if (ts < NT) z = bf2f(p.ACT[((size_t)p.META[0] * 256 + ts) * 256 + (q & 255)]);
#elif PROBE_KIND == 7
        const unsigned q = (unsigned)i; z = 0.f; if (q < 2u * 256u * 1024u) z = p.sh_w2[q]; else if (q < 2u * 256u * 1024u + 2u * 1024u * 512u) z = p.sh_w13[q - 2u * 256u * 1024u];
#elif PROBE_KIND == 5
        const unsigned q = (unsigned)i; const unsigned ts = (q >> 10) * 8 + 3; z = bf2f(p.YS[(size_t)p.TOKSLOT[ts] * 1024 + (q & 1023)]);
#elif PROBE_KIND == 3
        const unsigned q = (unsigned)i; const unsigned ts = q >> 8; z = bf2f(p.YS[(size_t)p.TOKSLOT[ts] * 1024 + (q & 255)]);
#else
        const float* src = (const float*)p.PROBE_BUF; z = src[i + PROBE_OFF];
#endif
        if (!(fabsf(z) < 1e4f)) z = 100.f; p.out[i] = z; } }
#endif

#define XB_TMO      128
#define XB_XCNT(j)  (256  + 64 * (j))
#define XB_XSUB(j)  (1280 + 64 * (j))
#define XB_XGEN(j)  (2304 + 64 * (j))
#define XB_TOP      3328
#define XB_TOPGEN   3392
#define XCD_BAR_WORDS 3456
#define XB_SPIN_CAP (1u << 18)
#define LAS __attribute__((address_space(3)))

__device__ __forceinline__ unsigned xb_ld(unsigned* p)              { return __hip_atomic_load(p, __ATOMIC_RELAXED, __HIP_MEMORY_SCOPE_AGENT); }
__device__ __forceinline__ unsigned xb_add(unsigned* p, unsigned v) { return __hip_atomic_fetch_add(p, v, __ATOMIC_RELAXED, __HIP_MEMORY_SCOPE_AGENT); }
__device__ __forceinline__ unsigned xb_xcc_id() { return (unsigned)__builtin_amdgcn_s_getreg((3 << 11) | 20) & 0xFu; }
#define XB_SPIN(cond, bar) do { unsigned _sp = 0; while (cond) { __builtin_amdgcn_s_sleep(1); \
    if ((++_sp & 255u) == 0u) { if (xb_ld(&(bar)[XB_TMO])) break; if (_sp > XB_SPIN_CAP) { atomicAdd(&(bar)[XB_TMO], 1u); break; } } } } while (0)

struct XcdBarrier {
    unsigned* bar; unsigned x;
    volatile LAS unsigned* st;
};

__device__ __forceinline__ XcdBarrier xcd_barrier_post(unsigned* bar, volatile LAS unsigned* st) {
    XcdBarrier b; b.bar = bar; b.x = xb_xcc_id(); b.st = st;
    if (threadIdx.x == 0) (void)xb_add(&bar[XB_XCNT(b.x)], 1u);
    return b;
}
__device__ __forceinline__ void xcd_barrier_complete(unsigned* bar, unsigned x, unsigned& nloc, unsigned& nx) {
    const unsigned G = gridDim.x * gridDim.y * gridDim.z;
    unsigned sum, cnt, mine, sp = 0u;
    for (;;) {
        sum = 0u; cnt = 0u; mine = 0u;
#pragma unroll
        for (unsigned j = 0; j < 16; ++j) { const unsigned c = xb_ld(&bar[XB_XCNT(j)]); sum += c; cnt += (c > 0u) ? 1u : 0u; mine = (j == x) ? c : mine; }
        if (sum == G) break;
        __builtin_amdgcn_s_sleep(1);
        if ((++sp & 255u) == 0u) { if (xb_ld(&bar[XB_TMO])) break; if (sp > XB_SPIN_CAP) { atomicAdd(&bar[XB_TMO], 1u); break; } }
    }
    nloc = mine > 0u ? mine : 1u; nx = cnt > 0u ? cnt : 1u;
}

__device__ __forceinline__ void xcd_barrier(const XcdBarrier& b) {
    asm volatile("s_waitcnt vmcnt(0)" ::: "memory");
    __syncthreads();
    if (threadIdx.x == 0) {
        unsigned* bar = b.bar;
        __builtin_amdgcn_s_waitcnt(0);
        unsigned nloc = b.st[0], nx = b.st[1];
        if (nloc == 0u) { xcd_barrier_complete(bar, b.x, nloc, nx); b.st[0] = nloc; b.st[1] = nx; }
        const unsigned old = xb_add(&bar[XB_XSUB(b.x)], 1u);
        const unsigned gen = old / nloc;
        if (old + 1u == (gen + 1u) * nloc) {
            __builtin_amdgcn_fence(__ATOMIC_RELEASE, "agent");
            asm volatile("s_waitcnt vmcnt(0)" ::: "memory");
            const unsigned og = xb_add(&bar[XB_TOP], 1u);
            const unsigned tg = og / nx;
            if (og + 1u == (tg + 1u) * nx) xb_add(&bar[XB_TOPGEN], 1u);
            else XB_SPIN(xb_ld(&bar[XB_TOPGEN]) == tg, bar);
            __builtin_amdgcn_fence(__ATOMIC_ACQUIRE, "agent");
            xb_add(&bar[XB_XGEN(b.x)], 1u);
            asm volatile("s_waitcnt vmcnt(0)" ::: "memory");
        } else {
            XB_SPIN(xb_ld(&bar[XB_XGEN(b.x)]) == gen, bar);
            __builtin_amdgcn_fence(__ATOMIC_ACQUIRE, "agent");
            asm volatile("s_waitcnt vmcnt(0)" ::: "memory");
        }
    }
    __syncthreads();
}


__global__ void __launch_bounds__(NTHR, 2) k_fwd(Params p_, int lo, int hi) {
#if defined(__HIP_DEVICE_COMPILE__)
    typedef const __attribute__((address_space(4))) Params* KP;
    const KP kp0 = (KP)__builtin_amdgcn_kernarg_segment_ptr();
#define LOADP KP kq = kp0; asm volatile("" : "+s"(kq)); Params p; __builtin_memcpy(&p, kq, sizeof(Params));
#else
#define LOADP const Params& p = p_;
#endif
    extern __shared__ __attribute__((aligned(16))) unsigned char lds[];
    if (threadIdx.x < 4) ((unsigned*)(lds + 147456))[threadIdx.x] = 0u;
    __syncthreads();
    XcdBarrier bar; bar.bar = nullptr; bar.x = 0; bar.st = nullptr;
#if defined(__HIP_DEVICE_COMPILE__)
    if (hi - lo > 1) bar = xcd_barrier_post((unsigned*)kp0->BAR, (volatile LAS unsigned*)(lds + 147456));
#endif
#define SEAM(k) if (lo <= (k) && (k) + 1 < hi) xcd_barrier(bar);
#ifndef ONLY
#define ONLY -1
#endif
#define IN(k) ((ONLY < 0 || ONLY == (k)) && lo <= (k) && (k) < hi)
#ifndef DUPMASK
#define DUPMASK 0u
#endif
#define PH(k, ...) if (IN(k)) { LOADP __VA_ARGS__ } SEAM(k) if ((DUPMASK >> (k)) & 1u) { xcd_barrier(bar); if (IN(k)) { LOADP __VA_ARGS__ } xcd_barrier(bar); }
    PH(0, if (blockIdx.x == 0) { for (int e = threadIdx.x; e < 512; e += NTHR) p.CNT[e] = 0; if (threadIdx.x < 128) p.META[threadIdx.x] = 0; } phase_mod(p, lds); phase_filt(p, lds); phase_convw(p, lds);)
    PH(2, phase_filtfft(p, lds); phase_hin0(p);)
    PH(1, phase_inproj(p, lds, 0);)
    PH(3, phase_rec0(p, lds);)
    PH(4, phase_readout0(p);)
    PH(5, phase_outproj(p, lds, 0);)
    PH(6, phase_ln1(p, 0);)
    PH(7, phase_router(p, lds, 0);)
    PH(8, phase_select(p, 0);)
    PH(9, phase_offsets(p, lds, 0);)
    PH(10, phase_moe1(p, lds, 0);)
    PH(11, phase_moe2(p, lds, 0);)
    PH(12, phase_combine(p, 0);)
    PH(13, phase_inproj(p, lds, 1);)
    PH(14, phase_shortconv(p, lds);)
    PH(27, phase_rwstreams(p, lds);)
    PH(15, phase_hyena(p, lds);)
    PH(16, phase_rwprep(p, lds);)
    PH(17, phase_rwseq(p);)
    PH(18, phase_readout1(p); phase_zt2y(p, lds);)
    PH(19, phase_outproj(p, lds, 1);)
    PH(20, phase_ln1(p, 1);)
    PH(21, phase_router(p, lds, 1);)
    PH(22, phase_select(p, 1);)
    PH(23, phase_offsets(p, lds, 1);)
    PH(24, phase_moe1(p, lds, 1);)
    PH(25, phase_moe2(p, lds, 1);)
    PH(26, phase_combine(p, 1);)
#undef IN
}
#define N_PHASES 28
#define LDS_BYTES (147456 + 64)

extern "C" void kernel_launch(void* const* d_in, const int* in_sizes, int n_in, void* d_out, int out_size, void* d_ws, size_t ws_size, hipStream_t stream) {
    Params p;
    memset(&p, 0, sizeof(p));
    if (n_in != 45) { fprintf(stderr, "kernel_launch: expected 45 inputs, got %d\n", n_in); return; }
    const float** pin = (const float**)&p;
    for (int i = 0; i < 45; ++i) pin[i] = (const float*)d_in[i];
    p.out = (float*)d_out;
    size_t off = 0;
    unsigned char* ws = (unsigned char*)d_ws;
    auto take = [&](size_t bytes) { void* r = ws + off; off += (bytes + 255) & ~(size_t)255; return r; };
    p.BAR = (unsigned*)take(16384);
    p.CNT = (int*)take(2 * 256 * 4);
    p.META = (int*)take(2 * 64 * 4);
    const size_t zero_bytes = off;
    p.MOD = (float*)take((size_t)2 * 9 * 6144 * 4);
    p.G = (float*)take((size_t)2 * 8192 * 512 * 4);
    p.P = (bf16_t*)take((size_t)NT * EVW * 4);
    p.LA = nullptr;
    p.O = (float*)take((size_t)2 * NT * 1024 * 4);
    p.Y = (bf16_t*)take((size_t)NT * 1024 * 2);
    p.PRE = (float*)take((size_t)NT * 1024 * 4);
    p.X1 = (float*)take((size_t)NT * 1024 * 4);
    p.U = (bf16_t*)take((size_t)NT * 1024 * 2);
    p.LOGITS = (float*)take((size_t)NT * 256 * 4);
    p.EIDX = (int*)take((size_t)NT * 8 * 4); p.GATE = (float*)take((size_t)NT * 8 * 4); p.POS = (int*)take((size_t)NT * 8 * 4); p.TOKSLOT = (int*)take((size_t)NT * 8 * 4);
    p.TILE_E = (int*)take(2048 * 4);
    p.SLOT_TOK = (int*)take((size_t)MAXSLOT * 4); p.SLOT_GATE = (float*)take((size_t)MAXSLOT * 4);
    unsigned char* regA = (unsigned char*)take((size_t)MAXSLOT * 1024 * 2 + (size_t)MAXSLOT * 256 * 2);
    p.YS = (bf16_t*)regA; p.ACT = (bf16_t*)(regA + (size_t)MAXSLOT * 1024 * 2);
    { size_t o2 = 0; auto sub = [&](size_t bytes) { void* r = regA + o2; o2 += (bytes + 255) & ~(size_t)255; return r; };
      p.UH = (float*)sub((size_t)NLAT * 1536 * 4); p.Z1 = (float*)sub((size_t)NLAT * 512 * 4);
      p.RR = (bf16_t*)sub((size_t)NT * 512 * 2); p.KP = (bf16_t*)sub((size_t)NT * 512 * 2); p.VV = (bf16_t*)sub((size_t)NT * 512 * 2);
      p.KK = (bf16_t*)sub((size_t)NT * 512 * 2); p.BV = (bf16_t*)sub((size_t)NT * 512 * 2); p.GT = (bf16_t*)sub((size_t)NT * 512 * 2);
      p.DEC = (float*)sub((size_t)2 * NT * 512 * 4);
      if (o2 > (size_t)MAXSLOT * 1024 * 2 + (size_t)MAXSLOT * 256 * 2) { fprintf(stderr, "kernel_launch: region A overflow\n"); return; } }
    { unsigned char* rp = (unsigned char*)p.P; p.GMT = (bf16_t*)rp; p.QMT = (bf16_t*)(rp + (size_t)RW_NUNIT * 4096 * 2); p.HMB = (bf16_t*)(rp + (size_t)RW_NUNIT * 4096 * 4); p.OMB = (bf16_t*)(rp + (size_t)RW_NUNIT * 4096 * 6); }
    p.X2 = (float*)take((size_t)NT * 1024 * 4);
    p.FF = (f32x2_p)take((size_t)2 * 512 * 8192 * 8);
    p.HIN = (bf16_t*)take((size_t)NT * 1024 * 2);
    p.WT_EVIN = (bf16_t*)take((size_t)4352 * 1024 * 2); p.WT_EVOUT = (bf16_t*)take((size_t)1024 * 1024 * 2);
    p.WT_ODIN = (bf16_t*)take((size_t)3584 * 1024 * 2); p.WT_ODOUT = (bf16_t*)take((size_t)1024 * 1024 * 2);
    p.WT_ROUT = (bf16_t*)take((size_t)2 * 256 * 1024 * 2); p.WT_SH13 = (bf16_t*)take((size_t)2 * 512 * 1024 * 2); p.WT_SH2 = (bf16_t*)take((size_t)2 * 1024 * 256 * 2);
    p.WT_RWF = (bf16_t*)take(512 * 64 * 2); p.WT_RWB = (bf16_t*)take(512 * 64 * 2); p.WT_RWA = (bf16_t*)take(512 * 64 * 2); p.WT_RWG = (bf16_t*)take(512 * 128 * 2);
    p.WT_W13 = (bf16_t*)take((size_t)2 * 256 * 512 * 1024 * 2); p.WT_W2 = (bf16_t*)take((size_t)2 * 256 * 1024 * 256 * 2);
    if (off > ws_size) { fprintf(stderr, "kernel_launch: workspace too small: need %zu, have %zu\n", off, ws_size); return; }
    static bool attr_done = false;
    if (!attr_done) { (void)hipFuncSetAttribute((const void*)k_fwd, hipFuncAttributeMaxDynamicSharedMemorySize, LDS_BYTES); attr_done = true; }
    (void)hipMemsetAsync(d_ws, 0, zero_bytes, stream);
#ifdef PROBE_BUF
    for (int ph = 0; ph <= PROBE_UPTO; ++ph) hipLaunchKernelGGL(k_fwd, dim3(256), dim3(NTHR), LDS_BYTES, stream, p, ph, ph + 1);
    hipLaunchKernelGGL(k_fwd, dim3(256), dim3(NTHR), LDS_BYTES, stream, p, 98, 99);
    hipLaunchKernelGGL(k_fwd, dim3(256), dim3(NTHR), LDS_BYTES, stream, p, 98, 99);
    hipLaunchKernelGGL(k_probe, dim3(1024), dim3(NTHR), 0, stream, p);
#else
#ifdef MULTI_LAUNCH
    for (int ph = 0; ph < N_PHASES; ++ph) {
        hipLaunchKernelGGL(k_fwd, dim3(256), dim3(NTHR), LDS_BYTES, stream, p, ph, ph + 1);
    }
#else
    static int grid = 0;
    if (grid == 0) {
        int dev = 0, cus = 0, per_cu = 0;
        (void)hipGetDevice(&dev); (void)hipDeviceGetAttribute(&cus, hipDeviceAttributeMultiprocessorCount, dev);
        if (hipOccupancyMaxActiveBlocksPerMultiprocessor(&per_cu, (const void*)k_fwd, NTHR, LDS_BYTES) != hipSuccess || per_cu < 1) { fprintf(stderr, "kernel_launch: occupancy query says %d blocks per CU\n", per_cu); per_cu = 1; }
        (void)hipGetLastError();
        grid = cus > 0 ? cus : 256;
    }
    hipLaunchKernelGGL(k_fwd, dim3(grid), dim3(NTHR), LDS_BYTES, stream, p, 0, N_PHASES);
#endif
#endif
}
```

```cpp
#include <hip/hip_runtime.h>
#include <stdint.h>
#include <stdio.h>
#include <string.h>

typedef unsigned short bf16_t;
typedef short bf16x8 __attribute__((ext_vector_type(8)));
typedef float f32x4 __attribute__((ext_vector_type(4)));
typedef unsigned u32x4 __attribute__((ext_vector_type(4)));
typedef unsigned u32x2 __attribute__((ext_vector_type(2)));

#define NTHR 512
#define DM 1024
#define NB 8
#define SEQ 4096
#define CTXL 256
#define NCTX (NB * CTXL)
#define NLAT (NB * SEQ)
#define NT (NCTX + NLAT)
#define EVW 4128
#define ODW 3392
#define MAXSLOT 378880
#define DN_ALPHA 1.41421356237f
#define NPHASE 40

typedef float __attribute__((ext_vector_type(2)))* f32x2_p;
struct Params {
    const float *x, *c, *ctx, *c_ctx, *mod_w, *mod_b, *ln1_g, *ln1_b, *ln2_g, *ln2_b;
    const float *ev_w_in, *ev_w_out, *gla_gate_w2, *gla_gate_b, *gla_norm_g, *hg_lb_logits, *hg_norm_g;
    const float *od_w_in, *od_w_out, *hy_conv_w, *hy_conv_b, *hy_ffn_w1, *hy_ffn_b1, *hy_ffn_w2, *hy_ffn_b2, *hy_ffn_w3, *hy_sin_freq, *hy_bias;
    const float *rw_mu, *rw_w0, *rw_w2, *rw_a0, *rw_a2, *rw_g2, *rw_k_k, *rw_k_a, *rw_r_k, *rw_ln_g, *rw_ln_b;
    const float *router_w, *router_bias, *exp_w13, *exp_w2, *sh_w13, *sh_w2;
    float* out;
    float* MOD;
    float* G;
    bf16_t* P;
    float* LA;
    float* O;
    bf16_t* Y;
    float* PRE;
    float* X1;
    bf16_t* U;
    float* LOGITS;
    int* EIDX; float* GATE; int* POS; int* TOKSLOT;
    int* CNT;
    int* META;
    int* TILE_E;
    int* SLOT_TOK; float* SLOT_GATE;
    bf16_t* ACT;
    bf16_t* YS;
    float* X2;
    f32x2_p FF;
    float* UH;
    float* Z1;
    bf16_t *RR, *KP, *VV, *KK, *BV, *GT;
    float* DEC;
    bf16_t *GMT, *QMT, *HMB, *OMB;
    bf16_t* HIN;
    bf16_t *WT_RWF, *WT_RWB, *WT_RWA, *WT_RWG;
    bf16_t *WT_EVIN, *WT_EVOUT, *WT_ODIN, *WT_ODOUT, *WT_ROUT, *WT_SH13, *WT_SH2, *WT_W13, *WT_W2;
    unsigned* BAR;
};

typedef float f32x2_t __attribute__((ext_vector_type(2)));
typedef __bf16 bf16x2_t __attribute__((ext_vector_type(2)));
__device__ __forceinline__ unsigned pk2(float lo, float hi) { const f32x2_t v = {lo, hi}; return __builtin_bit_cast(unsigned, __builtin_convertvector(v, bf16x2_t)); }
__device__ __forceinline__ bf16x8 pack8(f32x4 a, f32x4 b) { u32x4 w; w.x = pk2(a[0], a[1]); w.y = pk2(a[2], a[3]); w.z = pk2(b[0], b[1]); w.w = pk2(b[2], b[3]); return __builtin_bit_cast(bf16x8, w); }
__device__ __forceinline__ float bf2f(bf16_t h) { return __uint_as_float((unsigned)h << 16); }
__device__ __forceinline__ f32x4 bf4_to_f32(u32x2 w) { return (f32x4){__uint_as_float(w.x << 16), __uint_as_float(w.x & 0xffff0000u), __uint_as_float(w.y << 16), __uint_as_float(w.y & 0xffff0000u)}; }
__device__ __forceinline__ u32x2 f32_to_bf4(f32x4 v) { u32x2 w; w.x = pk2(v[0], v[1]); w.y = pk2(v[2], v[3]); return w; }
__device__ __forceinline__ bf16_t f2bf(float f) { return (bf16_t)(pk2(f, 0.f) & 0xffffu); }
__device__ __forceinline__ float sigmoid_f(float x) { return 1.f / (1.f + expf(-x)); }
__device__ __forceinline__ float silu_f(float x) { return x / (1.f + expf(-x)); }
__device__ __forceinline__ float logsigmoid_f(float x) { return x >= 0.f ? -log1pf(expf(-x)) : x - log1pf(expf(x)); }
#define DPPF(v, ctrl, rmask) __int_as_float(__builtin_amdgcn_update_dpp(0, __float_as_int(v), (ctrl), (rmask), 0xF, false))
__device__ __forceinline__ float wave_sum(float v) {
    v += DPPF(v, 0xB1, 0xF); v += DPPF(v, 0x4E, 0xF); v += DPPF(v, 0x141, 0xF); v += DPPF(v, 0x140, 0xF);
    v += DPPF(v, 0x142, 0xA); v += DPPF(v, 0x143, 0xC);
    return __int_as_float(__builtin_amdgcn_readlane(__float_as_int(v), 63));
}
__device__ __forceinline__ float wave_max(float v) {
    const float NEGI = -__builtin_inff();
#define DPPM(v, ctrl, rmask) __int_as_float(__builtin_amdgcn_update_dpp(__float_as_int(NEGI), __float_as_int(v), (ctrl), (rmask), 0xF, false))
    v = fmaxf(v, DPPM(v, 0xB1, 0xF)); v = fmaxf(v, DPPM(v, 0x4E, 0xF)); v = fmaxf(v, DPPM(v, 0x141, 0xF)); v = fmaxf(v, DPPM(v, 0x140, 0xF));
    v = fmaxf(v, DPPM(v, 0x142, 0xA)); v = fmaxf(v, DPPM(v, 0x143, 0xC));
#undef DPPM
    return __int_as_float(__builtin_amdgcn_readlane(__float_as_int(v), 63));
}
__device__ __forceinline__ int row_of(int dir, int b, int s) {
    if (s < CTXL) { const int pos = dir ? (CTXL - 1 - s) : s; return b * CTXL + pos; }
    const int q = s - CTXL; const int pos = dir ? (SEQ - 1 - q) : q; return NCTX + b * SEQ + pos;
}
__device__ __forceinline__ int row_mod(int r) { return r < NCTX ? 8 : ((r - NCTX) >> 12); }
__device__ __forceinline__ const float* xin_row(const Params& p, int layer, int r) {
    if (layer == 0) return r < NCTX ? p.ctx + (size_t)r * DM : p.x + (size_t)(r - NCTX) * DM;
    return p.X2 + (size_t)r * DM;
}

#define LSTR 72
#define GEMM_LDS_BYTES (2 * (256 + 128) * LSTR * 2)
template <class AL, class BL, class EP>
__device__ __forceinline__ void gemm_tile(const AL& al, const BL& bl, const EP& ep, const int K, unsigned char* lds) {
    bf16_t* As0 = (bf16_t*)lds;
    bf16_t* Bs0 = As0 + 2 * 256 * LSTR;
    const int tid = threadIdx.x, lane = tid & 63, w = tid >> 6, wm = w & 3, wn = w >> 2;
    const int ar = tid >> 1, ah = tid & 1;
    const int bn = tid & 127, bkg = tid >> 7;
    const typename AL::Row r0 = al.row(ar);
    const typename BL::Col c0 = bl.col(bn);
    f32x4 acc[4][4];
#pragma unroll
    for (int i = 0; i < 4; ++i)
#pragma unroll
        for (int j = 0; j < 4; ++j) acc[i][j] = (f32x4){0.f, 0.f, 0.f, 0.f};
    bf16x8 ra[4], rb[2];
#define G2_LOAD(k0) do { _Pragma("unroll") for (int _g = 0; _g < 4; ++_g) ra[_g] = al.load(r0, (k0) + ah * 32 + _g * 8); rb[0] = bl.load(c0, (k0) + bkg * 16); rb[1] = bl.load(c0, (k0) + bkg * 16 + 8); } while (0)
#define G2_STORE(buf) do { bf16_t* _a = As0 + (buf) * 256 * LSTR + ar * LSTR + ah * 32; _Pragma("unroll") for (int _g = 0; _g < 4; ++_g) *(bf16x8*)(_a + _g * 8) = ra[_g]; \
        bf16_t* _b = Bs0 + (buf) * 128 * LSTR + bn * LSTR + bkg * 16; *(bf16x8*)_b = rb[0]; *(bf16x8*)(_b + 8) = rb[1]; } while (0)
    const int nk = K / 64;
    __syncthreads();
    G2_LOAD(0); G2_STORE(0);
    if (nk > 1) G2_LOAD(64);
    __syncthreads();
    for (int it = 0; it < nk; ++it) {
        const bf16_t* As = As0 + (it & 1) * 256 * LSTR; const bf16_t* Bs = Bs0 + (it & 1) * 128 * LSTR;
#pragma unroll
        for (int ks = 0; ks < 2; ++ks) {
            bf16x8 af[4], bfr[4];
#pragma unroll
            for (int i = 0; i < 4; ++i) af[i] = *(const bf16x8*)(As + (wm * 64 + i * 16 + (lane & 15)) * LSTR + ks * 32 + (lane >> 4) * 8);
#pragma unroll
            for (int j = 0; j < 4; ++j) bfr[j] = *(const bf16x8*)(Bs + (wn * 64 + j * 16 + (lane & 15)) * LSTR + ks * 32 + (lane >> 4) * 8);
#pragma unroll
            for (int i = 0; i < 4; ++i)
#pragma unroll
                for (int j = 0; j < 4; ++j) acc[i][j] = __builtin_amdgcn_mfma_f32_16x16x32_bf16(bfr[j], af[i], acc[i][j], 0, 0, 0);
        }
        if (it + 1 < nk) { G2_STORE((it + 1) & 1); if (it + 2 < nk) G2_LOAD((it + 2) * 64); }
        __syncthreads();
    }
#undef G2_LOAD
#undef G2_STORE
    ep(acc, wm, wn, lane);
}
#define EP_ROW(i) (wm * 64 + (i) * 16 + (lane & 15))
#define EP_COL(j) (wn * 64 + (j) * 16 + (lane >> 4) * 4)


namespace mg8 {
#define MG_LAS __attribute__((address_space(3)))
constexpr int BM = 256, BK = 64, HALF = 128, HTB = HALF * BK * 2, STAGE_BYTES = 8 * HTB, NXCD = 8, WGM = 8;
__host__ __device__ __forceinline__ int lds_byte(int r, int c) { const int st = (r >> 4) * 2 + (c >> 5), rr = r & 15, cc = c & 31, ob = rr * 64 + cc * 2; return st * 1024 + (ob ^ (((ob >> 9) & 1) << 5)); }
__host__ __device__ __forceinline__ void stage_rc(int b, int& R, int& C) { const int st = b / 1024, sb = b % 1024, swz = sb ^ (((sb >> 9) & 1) << 5); R = (st >> 1) * 16 + swz / 64; C = (st & 1) * 32 + (swz % 64) / 2; }
__host__ __device__ __forceinline__ int perm32(int rho) { const int n = rho >> 4, i = rho & 15; return 8 * (i >> 2) + 4 * n + (i & 3); }
struct Unit { int pm, pn; const char* A; const char* B; const int* gidx; };
__device__ __forceinline__ int xcd_remap(int wgid, int nwg) { const int q = nwg / NXCD, r = nwg % NXCD, xcd = wgid % NXCD, off = wgid / NXCD; return (xcd < r ? xcd * (q + 1) : r * (q + 1) + (xcd - r) * q) + off; }
struct DenseOrder {
    int nM, nN, nwg, G, c; const char* A; const char* Bt; size_t tstep;
    __device__ void init(const bf16_t* A_, const bf16_t* Bt_, int M, int N, int K, int G_, int c_) { nM = M / BM; nN = N / BM; nwg = nM * nN; G = G_; c = c_; A = (const char*)A_; Bt = (const char*)Bt_; tstep = (size_t)BM * K * 2; }
    __device__ bool next(int i, Unit& u) const {
        const long L = (long)i * G + c; if (L >= nwg) return false;
        const int wgid = xcd_remap((int)L, nwg);
        const int nig = WGM * nN, gid = wgid / nig, fm = gid * WGM, gsz = (nM - fm) < WGM ? (nM - fm) : WGM;
        u.pm = fm + ((wgid % nig) % gsz); u.pn = (wgid % nig) / gsz; u.A = A + (size_t)u.pm * tstep; u.B = Bt + (size_t)u.pn * tstep; u.gidx = nullptr; return true;
    }
};
struct MoeOrder {
    int ntr, npn, nwg, G, c, K, rbase; bool gather; const char* A; const char* Wexp; size_t wstride; const char* Wsh; const int* tile_e; const int* slot_tok;
    __device__ bool next(int i, Unit& u) const {
        const long L = (long)i * G + c; if (L >= nwg) return false;
        const int wv = xcd_remap((int)L, nwg); const int tile = wv / npn, pn = wv % npn; const size_t tstep = (size_t)BM * K * 2;
        u.pm = tile; u.pn = pn; u.gidx = nullptr;
        if (tile < ntr) { const int e = tile_e[tile]; u.B = Wexp + (size_t)e * wstride + (size_t)pn * tstep; if (gather) { u.A = A; u.gidx = slot_tok + tile * 256; } else u.A = A + (size_t)tile * tstep; }
        else { u.B = Wsh + (size_t)pn * tstep; u.A = gather ? A + (size_t)(rbase + (tile - ntr) * 256) * K * 2 : A + (size_t)tile * tstep; }
        return true;
    }
};
template <class Epi, class Sched, bool GATHER>
__device__ __forceinline__ void gemm_phase(MG_LAS unsigned char* lds, const int K, const Sched& S, const Epi& E) {
    const int tid = threadIdx.x, wid = __builtin_amdgcn_readfirstlane(tid >> 6), lane = tid & 63, wr = wid >> 2, wc = wid & 3, fr = lane & 15, fq = lane >> 4;
    const int nt = K / BK;
    int RR[2], CC[2]; unsigned voffB[2], vA[2][2], vN[2][2];
#pragma unroll
    for (int i = 0; i < 2; ++i) { int R, C; stage_rc(tid * 16 + i * 8192, R, C); RR[i] = R; CC[i] = C; const int Rb = Epi::PERM ? ((R & ~31) + perm32(R & 31)) : R; voffB[i] = (unsigned)(Rb * K + C) * 2u; }
#define MG_MKV(v, u) do { _Pragma("unroll") for (int _h = 0; _h < 2; ++_h) _Pragma("unroll") for (int _i = 0; _i < 2; ++_i) { const int _row = _h * HALF + RR[_i]; \
        const int _src = (GATHER && (u).gidx) ? (u).gidx[_row] : _row; v[_h][_i] = (unsigned)(_src * K + CC[_i]) * 2u; } } while (0)
    const size_t kstep = (size_t)(BK * 2);
    const size_t hstep = (size_t)HALF * K * 2;
    const unsigned ldsw = (unsigned)wid * 1024u;
    const int aoff = lds_byte(wr * 64 + fr, fq * 8), boff = lds_byte(wc * 32 + fr, fq * 8);
#define MG_SA(b, h) (((b) * 2 + (h)) * HTB)
#define MG_SB(b, h) ((4 + (b) * 2 + (h)) * HTB)
#define MG_STAGE(bufoff, gbase, voff) do { _Pragma("unroll") for (int _i = 0; _i < 2; ++_i) \
        __builtin_amdgcn_global_load_lds((const unsigned*)((const char*)(gbase) + (voff)[_i]), (MG_LAS unsigned*)(lds + (bufoff) + ldsw + _i * 8192), 16, 0, 0); } while (0)
#define MG_LDA(dst, b, h) do { _Pragma("unroll") for (int m = 0; m < 4; ++m) _Pragma("unroll") for (int k = 0; k < 2; ++k) dst[m][k] = *(const MG_LAS bf16x8*)(lds + MG_SA(b, h) + aoff + m * 2048 + k * 1024); } while (0)
#define MG_LDB(dst, b, h) do { _Pragma("unroll") for (int n = 0; n < 2; ++n) _Pragma("unroll") for (int k = 0; k < 2; ++k) dst[n][k] = *(const MG_LAS bf16x8*)(lds + MG_SB(b, h) + boff + n * 2048 + k * 1024); } while (0)
#define MG_MMA(ai, bj, At, Bt) do { __builtin_amdgcn_s_setprio(1); _Pragma("unroll") for (int m = 0; m < 4; ++m) _Pragma("unroll") for (int n = 0; n < 2; ++n) _Pragma("unroll") for (int k = 0; k < 2; ++k) \
        acc[ai][bj][m][n] = __builtin_amdgcn_mfma_f32_16x16x32_bf16(Bt[n][k], At[m][k], acc[ai][bj][m][n], 0, 0, 0); __builtin_amdgcn_s_setprio(0); } while (0)
#define MG_WAIT_V(n) asm volatile("s_waitcnt vmcnt(" #n ")" ::: "memory")
#define MG_WAIT_L(n) asm volatile("s_waitcnt lgkmcnt(" #n ")" ::: "memory")
#define MG_BAR __builtin_amdgcn_s_barrier()
#define MG_SCHED __builtin_amdgcn_sched_barrier(0)
    Unit cur, nxt; int ui = 0;
    if (!S.next(0, cur)) return;
    f32x4 acc[2][2][4][2];
#pragma unroll
    for (int a = 0; a < 2; ++a)
#pragma unroll
        for (int b = 0; b < 2; ++b)
#pragma unroll
            for (int m = 0; m < 4; ++m)
#pragma unroll
                for (int n = 0; n < 2; ++n) acc[a][b][m][n] = (f32x4){0.f, 0.f, 0.f, 0.f};
    bf16x8 At[4][2], B0[2][2], B1[2][2];
    const char* cA = cur.A; const char* cB = cur.B;
    MG_MKV(vA, cur);
    MG_STAGE(MG_SB(0, 0), cB, voffB); MG_STAGE(MG_SB(0, 1), cB + hstep, voffB); MG_STAGE(MG_SA(0, 0), cA, vA[0]); MG_STAGE(MG_SA(0, 1), cA, vA[1]);
    if (wr == 1) MG_BAR;
    MG_WAIT_V(2); MG_BAR;
    MG_STAGE(MG_SB(1, 0), cB + kstep, voffB); MG_STAGE(MG_SA(1, 0), cA + kstep, vA[0]); MG_STAGE(MG_SB(1, 1), cB + hstep + kstep, voffB);
    MG_WAIT_V(6); MG_BAR;
    for (;;) {
        const bool has_next = S.next(ui + 1, nxt);
        const char* nA = has_next ? nxt.A : cA; const char* nB = has_next ? nxt.B : cB;
#pragma unroll 1
        for (int t = 0; t < nt; t += 2) {
            const bool last = (t == nt - 2);
            const char* a1 = cA + (size_t)(t + 1) * kstep;
            const char* a2 = last ? nA : cA + (size_t)(t + 2) * kstep; const char* b2 = last ? nB : cB + (size_t)(t + 2) * kstep;
            const char* a3 = a2 + kstep; const char* b3 = b2 + kstep;
            unsigned x0[2], x1[2];
            if constexpr (GATHER) {
                if (last) { if (has_next) { MG_MKV(vN, nxt); } else {
#pragma unroll
                    for (int h = 0; h < 2; ++h)
#pragma unroll
                        for (int i = 0; i < 2; ++i) vN[h][i] = vA[h][i]; } }
#pragma unroll
                for (int i = 0; i < 2; ++i) { x0[i] = last ? vN[0][i] : vA[0][i]; x1[i] = last ? vN[1][i] : vA[1][i]; }
            } else {
#pragma unroll
                for (int i = 0; i < 2; ++i) { x0[i] = vA[0][i]; x1[i] = vA[1][i]; }
            }
            MG_LDB(B0, 0, 0); MG_LDB(B1, 0, 1); MG_SCHED; MG_LDA(At, 0, 0); MG_STAGE(MG_SA(1, 1), a1, vA[1]);
            MG_WAIT_V(8); MG_WAIT_L(0); MG_BAR; MG_MMA(0, 0, At, B0); MG_MMA(0, 1, At, B1); MG_BAR; MG_SCHED;
            MG_LDA(At, 0, 1); MG_STAGE(MG_SB(0, 0), b2, voffB); MG_STAGE(MG_SB(0, 1), b2 + hstep, voffB); MG_STAGE(MG_SA(0, 0), a2, x0);
            MG_WAIT_V(8); MG_WAIT_L(0); MG_BAR; MG_MMA(1, 0, At, B0); MG_MMA(1, 1, At, B1); MG_BAR; MG_SCHED;
            MG_LDB(B0, 1, 0); MG_LDB(B1, 1, 1); MG_SCHED; MG_LDA(At, 1, 0); MG_STAGE(MG_SA(0, 1), a2, x1);
            MG_WAIT_V(8); MG_WAIT_L(0); MG_BAR; MG_MMA(0, 0, At, B0); MG_MMA(0, 1, At, B1); MG_BAR; MG_SCHED;
            MG_LDA(At, 1, 1); MG_STAGE(MG_SB(1, 0), b3, voffB); MG_STAGE(MG_SB(1, 1), b3 + hstep, voffB); MG_STAGE(MG_SA(1, 0), a3, x0);
            MG_WAIT_V(8); MG_WAIT_L(0); MG_BAR; MG_MMA(1, 0, At, B0); MG_MMA(1, 1, At, B1); MG_BAR; MG_SCHED;
        }
        if (wr == 0) MG_BAR;
        E(acc, cur, wr, wc, fr, fq);
        if (!has_next) break;
#pragma unroll
        for (int a = 0; a < 2; ++a)
#pragma unroll
            for (int b = 0; b < 2; ++b)
#pragma unroll
                for (int m = 0; m < 4; ++m)
#pragma unroll
                    for (int n = 0; n < 2; ++n) acc[a][b][m][n] = (f32x4){0.f, 0.f, 0.f, 0.f};
        cur = nxt; cA = nA; cB = nB; ++ui;
        if constexpr (GATHER) {
#pragma unroll
            for (int h = 0; h < 2; ++h)
#pragma unroll
                for (int i = 0; i < 2; ++i) vA[h][i] = vN[h][i];
        }
        if (wr == 1) MG_BAR;
    }
    MG_WAIT_V(0);
    MG_BAR;
#undef MG_MKV
#undef MG_SA
#undef MG_SB
#undef MG_STAGE
#undef MG_LDA
#undef MG_LDB
#undef MG_MMA
#undef MG_WAIT_V
#undef MG_WAIT_L
#undef MG_BAR
#undef MG_SCHED
}
struct EpiF32 {
    static constexpr bool PERM = false;
    float* C; int ldc; int row0; int nvalid;
    __device__ __forceinline__ void operator()(const f32x4 (&acc)[2][2][4][2], const Unit& u, int wr, int wc, int fr, int fq) const {
        const int rb = row0 + u.pm * BM + wr * 64 + fr, cb = u.pn * BM + wc * 32 + 4 * fq;
#pragma unroll
        for (int ai = 0; ai < 2; ++ai)
#pragma unroll
            for (int m = 0; m < 4; ++m) { float* rowp = C + (size_t)(rb + ai * HALF + m * 16) * ldc;
#pragma unroll
                for (int bj = 0; bj < 2; ++bj)
#pragma unroll
                    for (int n = 0; n < 2; ++n) { const int col = cb + bj * HALF + n * 16; if (col < nvalid) *(f32x4*)(rowp + col) = acc[ai][bj][m][n]; } }
    }
};
struct EpiBf16 {
    static constexpr bool PERM = true;
    bf16_t* C; int ldc; int row0; int nvalid;
    __device__ __forceinline__ void operator()(const f32x4 (&acc)[2][2][4][2], const Unit& u, int wr, int wc, int fr, int fq) const {
        const int rb = row0 + u.pm * BM + wr * 64 + fr, cb = u.pn * BM + wc * 32 + 8 * fq;
#pragma unroll
        for (int ai = 0; ai < 2; ++ai)
#pragma unroll
            for (int m = 0; m < 4; ++m) { bf16_t* rowp = C + (size_t)(rb + ai * HALF + m * 16) * ldc;
#pragma unroll
                for (int bj = 0; bj < 2; ++bj) { const int col = cb + bj * HALF; if (col < nvalid) *(bf16x8*)(rowp + col) = pack8(acc[ai][bj][m][0] + 0.f, acc[ai][bj][m][1] + 0.f); } }
    }
};
struct EpiPre {
    static constexpr bool PERM = false;
    const Params* p; int layer; int row0;
    __device__ __forceinline__ void operator()(const f32x4 (&acc)[2][2][4][2], const Unit& u, int wr, int wc, int fr, int fq) const {
        const int rb = row0 + u.pm * BM + wr * 64 + fr, cb = u.pn * BM + wc * 32 + 4 * fq;
#pragma unroll
        for (int ai = 0; ai < 2; ++ai)
#pragma unroll
            for (int m = 0; m < 4; ++m) { const int row = rb + ai * HALF + m * 16; const float* xr = xin_row(*p, layer, row); const float* g1 = p->MOD + ((size_t)layer * 9 + row_mod(row)) * 6144 + 2048;
#pragma unroll
                for (int bj = 0; bj < 2; ++bj)
#pragma unroll
                    for (int n = 0; n < 2; ++n) { const int col = cb + bj * HALF + n * 16;
                        *(f32x4*)(p->PRE + (size_t)row * DM + col) = *(const f32x4*)(xr + col) * DN_ALPHA + *(const f32x4*)(g1 + col) * acc[ai][bj][m][n]; } }
    }
};
struct EpiAct {
    static constexpr bool PERM = true;
    bf16_t* ACT;
    __device__ __forceinline__ void operator()(const f32x4 (&acc)[2][2][4][2], const Unit& u, int wr, int wc, int fr, int fq) const {
        const int rb = u.pm * BM + wr * 64 + fr, cb = u.pn * HALF + wc * 32 + 8 * fq;
#pragma unroll
        for (int ai = 0; ai < 2; ++ai)
#pragma unroll
            for (int m = 0; m < 4; ++m) {
                const f32x4 a0 = acc[ai][0][m][0], a1 = acc[ai][0][m][1], b0 = acc[ai][1][m][0], b1 = acc[ai][1][m][1];
                f32x4 o0, o1;
#pragma unroll
                for (int e = 0; e < 4; ++e) { o0[e] = a0[e] / (1.f + __expf(-a0[e])) * b0[e]; o1[e] = a1[e] / (1.f + __expf(-a1[e])) * b1[e]; }
                *(bf16x8*)(ACT + (size_t)(rb + ai * HALF + m * 16) * 256 + cb) = pack8(o0, o1);
            }
    }
};
struct EpiYs {
    static constexpr bool PERM = true;
    bf16_t* YS; const float* gate; int ntr;
    __device__ __forceinline__ void operator()(const f32x4 (&acc)[2][2][4][2], const Unit& u, int wr, int wc, int fr, int fq) const {
        const int rb = u.pm * BM + wr * 64 + fr, cb = u.pn * BM + wc * 32 + 8 * fq;
#pragma unroll
        for (int ai = 0; ai < 2; ++ai)
#pragma unroll
            for (int m = 0; m < 4; ++m) { const int row = rb + ai * HALF + m * 16; const float g = gate[row] * 64.f;
#pragma unroll
                for (int bj = 0; bj < 2; ++bj) { const f32x4 v0 = acc[ai][bj][m][0] * g, v1 = acc[ai][bj][m][1] * g; int w0 = 0, w1 = 0;
                    w0 = __builtin_amdgcn_cvt_pk_fp8_f32(v0[0], v0[1], w0, false); w0 = __builtin_amdgcn_cvt_pk_fp8_f32(v0[2], v0[3], w0, true);
                    w1 = __builtin_amdgcn_cvt_pk_fp8_f32(v1[0], v1[1], w1, false); w1 = __builtin_amdgcn_cvt_pk_fp8_f32(v1[2], v1[3], w1, true);
                    u32x2 wv; wv.x = (unsigned)w0; wv.y = (unsigned)w1; *(u32x2*)((unsigned char*)YS + (size_t)row * DM + cb + bj * HALF) = wv; } }
    }
};
}

struct AModRow { const float* x; const float* sh; };
struct ALoadMod {
    const Params* p; int layer; int row0; int sec;
    typedef AModRow Row;
    __device__ __forceinline__ Row row(int r) const { const int g = row0 + r; Row R; R.x = xin_row(*p, layer, g); R.sh = p->MOD + ((size_t)layer * 9 + row_mod(g)) * 6144 + sec * 1024; return R; }
    __device__ __forceinline__ bf16x8 load(const Row& R, int k) const {
        const f32x4 x0 = *(const f32x4*)(R.x + k), x1 = *(const f32x4*)(R.x + k + 4);
        const f32x4 h0 = *(const f32x4*)(R.sh + k), h1 = *(const f32x4*)(R.sh + k + 4);
        const f32x4 s0 = *(const f32x4*)(R.sh + 1024 + k), s1 = *(const f32x4*)(R.sh + 1024 + k + 4);
        return pack8(x0 * (s0 + 1.f) + h0, x1 * (s1 + 1.f) + h1);
    }
};
struct ALoadBf {
    const bf16_t* A; int lda; int row0;
    typedef const bf16_t* Row;
    __device__ __forceinline__ Row row(int r) const { return A + (size_t)(row0 + r) * lda; }
    __device__ __forceinline__ bf16x8 load(Row R, int k) const { return *(const bf16x8*)(R + k); }
};
struct ALoadGather {
    const bf16_t* A; int lda; const int* idx;
    typedef const bf16_t* Row;
    __device__ __forceinline__ Row row(int r) const { return A + (size_t)idx[r] * lda; }
    __device__ __forceinline__ bf16x8 load(Row R, int k) const { return *(const bf16x8*)(R + k); }
};
__device__ __forceinline__ bf16x8 bload8(const float* c, int k, int ldb) {
    const float* q = c + (size_t)k * ldb;
    f32x4 a, b;
    a[0] = q[0]; a[1] = q[ldb]; a[2] = q[2 * ldb]; a[3] = q[3 * ldb];
    b[0] = q[4 * (size_t)ldb]; b[1] = q[5 * (size_t)ldb]; b[2] = q[6 * (size_t)ldb]; b[3] = q[7 * (size_t)ldb];
    return pack8(a, b);
}
struct BLoadF32 {
    const float* B; int ldb; int n0; int nvalid;
    typedef const float* Col;
    __device__ __forceinline__ Col col(int n) const { const int g = n0 + n; return g < nvalid ? B + g : nullptr; }
    __device__ __forceinline__ bf16x8 load(Col c, int k) const { if (!c) return (bf16x8){0, 0, 0, 0, 0, 0, 0, 0}; return bload8(c, k, ldb); }
};
struct BLoadW13 {
    const float* B; int nt;
    typedef const float* Col;
    __device__ __forceinline__ Col col(int n) const { const int wn = n >> 6, j = (n >> 4) & 3, c16 = n & 15; return B + (j >> 1) * 256 + nt * 64 + wn * 32 + (j & 1) * 16 + c16; }
    __device__ __forceinline__ bf16x8 load(Col c, int k) const { return bload8(c, k, 512); }
};

__device__ __forceinline__ void phase_mod(const Params& p, unsigned char* lds) {
    float* sv = (float*)lds;
    float* red = sv + 9 * 1024;
    const int tid = threadIdx.x;
    for (int e = tid; e < 9 * 1024; e += NTHR) { const int j = e >> 10, k = e & 1023; const float v = j < 8 ? p.c[j * 1024 + k] : p.c_ctx[k]; sv[e] = silu_f(v); }
    __syncthreads();
    const int kg = tid >> 6, nl = tid & 63;
    for (int u = blockIdx.x; u < 192; u += gridDim.x) {
        const int l = u / 96, n0 = (u % 96) * 64;
        const float* W = p.mod_w + (size_t)l * 1024 * 6144 + n0 + nl;
        float acc[9];
#pragma unroll
        for (int j = 0; j < 9; ++j) acc[j] = 0.f;
        for (int k = kg; k < 1024; k += 8) {
            const float wv = W[(size_t)k * 6144];
#pragma unroll
            for (int j = 0; j < 9; ++j) acc[j] += sv[j * 1024 + k] * wv;
        }
#pragma unroll
        for (int j = 0; j < 9; ++j) red[(kg * 9 + j) * 64 + nl] = acc[j];
        __syncthreads();
        for (int e = tid; e < 576; e += NTHR) {
            const int j = e >> 6, n = e & 63; float s = 0.f;
#pragma unroll
            for (int g = 0; g < 8; ++g) s += red[(g * 9 + j) * 64 + n];
            p.MOD[((size_t)l * 9 + j) * 6144 + n0 + n] = s + p.mod_b[l * 6144 + n0 + n];
        }
        __syncthreads();
    }
}

__device__ __forceinline__ void phase_filt(const Params& p, unsigned char* lds) {
    float* zs = (float*)lds;
    float* h1 = zs + 8 * 33;
    float* h2 = h1 + 8 * 64;
    const int tid = threadIdx.x;
    const float min_decay = logf(1e-2f) / 1.5f, max_decay = logf(1e-2f) / 0.3f;
    for (int u = blockIdx.x; u < 512; u += gridDim.x) {
        __syncthreads();
        if (tid < 8 * 33) {
            const int tt = tid / 33, i = tid % 33; const int t = u * 8 + tt;
            float v;
            if (i == 0) v = (float)t / 4095.f;
            else {
                const int bi = (i - 1) & 15; const float fr = 1e-4f + (float)bi * ((15.f - 1e-4f) / 15.f);
                const float wpos = 6.283185307179586f * (float)t / 4096.f;
                v = (i <= 16) ? cosf(fr * wpos) : -sinf(fr * wpos);
            }
            zs[tid] = v;
        }
        __syncthreads();
        const int tt = tid >> 6, j = tid & 63;
        {
            float s = p.hy_ffn_b1[j];
            for (int i = 0; i < 33; ++i) s += zs[tt * 33 + i] * p.hy_ffn_w1[i * 64 + j];
            h1[tt * 64 + j] = sinf(p.hy_sin_freq[j] * s);
        }
        __syncthreads();
        {
            float s = p.hy_ffn_b2[j];
            for (int i = 0; i < 64; ++i) s += h1[tt * 64 + i] * p.hy_ffn_w2[i * 64 + j];
            h2[tt * 64 + j] = sinf(p.hy_sin_freq[64 + j] * s);
        }
        __syncthreads();
#pragma unroll 1
        for (int mi = 0; mi < 4; ++mi) {
            const int m = tid + 512 * mi; const int n = m >> 10, side = (m >> 9) & 1, c = m & 511;
            float acc[8];
#pragma unroll
            for (int t2 = 0; t2 < 8; ++t2) acc[t2] = 0.f;
            for (int jj = 0; jj < 64; ++jj) {
                const float wv = p.hy_ffn_w3[jj * 2048 + m];
#pragma unroll
                for (int t2 = 0; t2 < 8; ++t2) acc[t2] += h2[t2 * 64 + jj] * wv;
            }
            const float delta = min_decay + (float)c * ((max_decay - min_decay) / 511.f);
#pragma unroll
            for (int t2 = 0; t2 < 8; ++t2) {
                const int t = u * 8 + t2; const float win = expf(-((float)t / 4095.f) * fabsf(delta)); const float val = acc[t2] * win;
                if (side == 0) p.G[((size_t)n * 512 + c) * 8192 + 4096 + t] = val;
                else if (t > 0) p.G[((size_t)n * 512 + c) * 8192 + 4096 - t] = val;
            }
        }
        if (u == 0) for (int e = tid; e < 1024; e += NTHR) p.G[(size_t)e * 8192] = 0.f;
    }
}

struct ConvJob { const float* src; bf16_t* dst; int ld, ncols, col0, k0, K; };
__device__ __forceinline__ int w13_col(int nrow) { const int pn = nrow >> 8, within = nrow & 255; return (within >> 7) * 256 + pn * 128 + (within & 127); }
#define CONV_TOTAL (3008 + 65536 + 32768 + 40)
__device__ __forceinline__ ConvJob conv_job(const Params& p, int g) {
    ConvJob j;
    if (g < 1088) { const int rt = g >> 4, kt = g & 15; j = {p.ev_w_in, p.WT_EVIN + (size_t)rt * 64 * 1024, EVW, EVW, rt * 64, kt * 64, 1024}; }
    else if (g < 1344) { const int t = g - 1088, rt = t >> 4, kt = t & 15; j = {p.ev_w_out, p.WT_EVOUT + (size_t)rt * 64 * 1024, 1024, 1024, rt * 64, kt * 64, 1024}; }
    else if (g < 2240) { const int t = g - 1344, rt = t >> 4, kt = t & 15; j = {p.od_w_in, p.WT_ODIN + (size_t)rt * 64 * 1024, ODW, ODW, rt * 64, kt * 64, 1024}; }
    else if (g < 2496) { const int t = g - 2240, rt = t >> 4, kt = t & 15; j = {p.od_w_out, p.WT_ODOUT + (size_t)rt * 64 * 1024, 1024, 1024, rt * 64, kt * 64, 1024}; }
    else if (g < 2624) { const int t = g - 2496, l = t >> 6, rt = (t >> 4) & 3, kt = t & 15; j = {p.router_w + (size_t)l * 1024 * 256, p.WT_ROUT + ((size_t)l * 256 + rt * 64) * 1024, 256, 256, rt * 64, kt * 64, 1024}; }
    else if (g < 2880) { const int t = g - 2624, l = t >> 7, rt = (t >> 4) & 7, kt = t & 15; j = {p.sh_w13 + (size_t)l * 1024 * 512, p.WT_SH13 + ((size_t)l * 512 + rt * 64) * 1024, 512, 512, w13_col(rt * 64), kt * 64, 1024}; }
    else if (g < 3008) { const int t = g - 2880, l = t >> 6, rt = (t >> 2) & 15, kt = t & 3; j = {p.sh_w2 + (size_t)l * 256 * 1024, p.WT_SH2 + ((size_t)l * 1024 + rt * 64) * 256, 1024, 1024, rt * 64, kt * 64, 256}; }
    else if (g < 3008 + 65536) { const int t = g - 3008, le = t >> 7, rt = (t >> 4) & 7, kt = t & 15; j = {p.exp_w13 + (size_t)le * 1024 * 512, p.WT_W13 + ((size_t)le * 512 + rt * 64) * 1024, 512, 512, w13_col(rt * 64), kt * 64, 1024}; }
    else if (g < 3008 + 65536 + 32768) { const int t = g - 3008 - 65536, le = t >> 6, rt = (t >> 2) & 15, kt = t & 3; j = {p.exp_w2 + (size_t)le * 256 * 1024, p.WT_W2 + ((size_t)le * 1024 + rt * 64) * 256, 1024, 1024, rt * 64, kt * 64, 256}; }
    else { const int t = g - 3008 - 65536 - 32768;
        if (t < 8) j = {p.rw_w2, p.WT_RWF + (size_t)t * 64 * 64, 512, 512, t * 64, 0, 64};
        else if (t < 16) j = {p.rw_w2 + 64 * 512, p.WT_RWB + (size_t)(t - 8) * 64 * 64, 512, 512, (t - 8) * 64, 0, 64};
        else if (t < 24) j = {p.rw_a2, p.WT_RWA + (size_t)(t - 16) * 64 * 64, 512, 512, (t - 16) * 64, 0, 64};
        else { const int t2 = t - 24; j = {p.rw_g2, p.WT_RWG + (size_t)(t2 >> 1) * 64 * 128, 512, 512, (t2 >> 1) * 64, (t2 & 1) * 64, 128}; } }
    return j;
}
__device__ __forceinline__ int conv_count(int part) { return part == 0 ? (3008 + 32768 + 16384 + 40) : (part == 1 ? 32768 : 16384); }
__device__ __forceinline__ int conv_index(int part, int i) {
    if (part == 0) return i < 3008 + 32768 ? i : i + 32768 + 16384;
    if (part == 1) return 3008 + 32768 + i;
    return 3008 + 65536 + i;
}
__device__ __forceinline__ void phase_convw(const Params& p, unsigned char* lds, const int part, const int blk, const int nblk) {
    bf16_t* T = (bf16_t*)lds;
    const int tid = threadIdx.x, kk = tid >> 4, nq = tid & 15;
    f32x4 n0 = {0.f, 0.f, 0.f, 0.f}, n1 = n0;
#define CONV_LOAD(jb) do { const int col_ = (jb).col0 + nq * 4; const bool ok_ = col_ < (jb).ncols; const float* sp_ = (jb).src + (size_t)((jb).k0 + kk) * (jb).ld + (ok_ ? col_ : 0); \
        n0 = *(const f32x4*)sp_; n1 = *(const f32x4*)(sp_ + (size_t)32 * (jb).ld); if (!ok_) { n0 = (f32x4){0.f, 0.f, 0.f, 0.f}; n1 = n0; } } while (0)
    const int total = conv_count(part);
    int g = blk;
    ConvJob cur = conv_job(p, conv_index(part, g < total ? g : 0));
    if (g < total) CONV_LOAD(cur);
    for (; g < total; g += nblk) {
        const f32x4 v0 = n0, v1 = n1; const ConvJob job = cur;
        const int gn = g + nblk;
        if (gn < total) { cur = conv_job(p, conv_index(part, gn)); CONV_LOAD(cur); }
        asm volatile("" ::: "memory");
        __syncthreads();
#pragma unroll
        for (int e = 0; e < 4; ++e) { T[(nq * 4 + e) * 66 + kk] = f2bf(v0[e]); T[(nq * 4 + e) * 66 + kk + 32] = f2bf(v1[e]); }
        __syncthreads();
        const int n = tid >> 3, seg = tid & 7;
        const unsigned* tp = (const unsigned*)(T + n * 66 + seg * 8);
        u32x4 o; o.x = tp[0]; o.y = tp[1]; o.z = tp[2]; o.w = tp[3];
        *(u32x4*)(job.dst + (size_t)n * job.K + job.k0 + seg * 8) = o;
    }
#undef CONV_LOAD
}
__device__ __forceinline__ void phase_hin0(const Params& p) {
    for (int i = blockIdx.x * NTHR + threadIdx.x; i < NT * 128; i += gridDim.x * NTHR) {
        const int r = i >> 7, k = (i & 127) * 8;
        const float* xr = xin_row(p, 0, r) + k; const float* md = p.MOD + (size_t)row_mod(r) * 6144 + k;
        const f32x4 x0 = *(const f32x4*)xr, x1 = *(const f32x4*)(xr + 4), h0 = *(const f32x4*)md, h1 = *(const f32x4*)(md + 4), s0 = *(const f32x4*)(md + 1024), s1 = *(const f32x4*)(md + 1028);
        *(bf16x8*)(p.HIN + (size_t)r * 1024 + k) = pack8(x0 * (s0 + 1.f) + h0, x1 * (s1 + 1.f) + h1);
    }
}
struct EpStoreF32 {
    float* C; int ldc; int row0; int n0; int nvalid;
    __device__ __forceinline__ void operator()(const f32x4 (&acc)[4][4], int wm, int wn, int lane) const {
#pragma unroll
        for (int i = 0; i < 4; ++i)
#pragma unroll
            for (int j = 0; j < 4; ++j) { const int col = n0 + EP_COL(j); if (col < nvalid) *(f32x4*)(C + (size_t)(row0 + EP_ROW(i)) * ldc + col) = acc[i][j]; }
    }
};
__device__ __forceinline__ void phase_inproj(const Params& p, unsigned char* lds, int layer) {
    mg8::DenseOrder S; S.init(p.HIN, layer == 0 ? p.WT_EVIN : p.WT_ODIN, NT, layer == 0 ? 4352 : 3584, 1024, gridDim.x, blockIdx.x);
    const int N = layer == 0 ? EVW : ODW;
    mg8::EpiBf16 E{p.P, N, 0, N};
    mg8::gemm_phase<mg8::EpiBf16, mg8::DenseOrder, false>((MG_LAS unsigned char*)lds, 1024, S, E);
}

template <int DK, int TYPE>
__device__ __forceinline__ void rec0_chunked(const Params& p, unsigned char* lds, int blk, int nblk) {
    constexpr int DKP = DK + 8, TPT = DK / 8, NPART = 512 / DK, NT16 = DK / 16;
    bf16_t* Qs = (bf16_t*)lds;
    bf16_t* Ks = Qs + 64 * DKP;
    bf16_t* KsT = Ks + 64 * DKP;
    bf16_t* Vt = KsT + DK * 72;
    bf16_t* Ps = Vt + 64 * 72;
    float* ptot = (float*)(Ps + 64 * 72);
    float* lref = ptot + 8 * 128;
    float* decv = lref + 128; float* elv = decv + 128; float* erv = elv + 128;
    const int tid = threadIdx.x, lane = tid & 63, w = tid >> 6, cw = w & 3, mh = w >> 2, q4 = lane >> 4, l15 = lane & 15;
    const int d = tid % DK, part = tid / DK;
    for (int e = tid; e < 64 * 72; e += NTHR) Ps[e] = 0;
    for (int unit = blk; unit < 128; unit += nblk) {
        const int half = unit & 1, h = (unit >> 1) & 3, b = (unit >> 3) & 7, dir = unit >> 6;
        float wg[16]; float gbias = 0.f, lbv = 0.f;
        if (TYPE == 0) {
#pragma unroll
            for (int i = 0; i < 16; ++i) wg[i] = p.gla_gate_w2[(dir * 16 + i) * 256 + h * 64 + d];
            gbias = p.gla_gate_b[dir * 256 + h * 64 + d];
        } else {
            const float l0 = p.hg_lb_logits[dir * 512 + h * 128 + d], l1 = p.hg_lb_logits[1024 + dir * 512 + h * 128 + d];
            lbv = 1.f / (1.f + expf(l1 - l0));
        }
        f32x4 Sacc[NT16];
#pragma unroll
        for (int t = 0; t < NT16; ++t) Sacc[t] = (f32x4){0.f, 0.f, 0.f, 0.f};
        const int vcol0 = (TYPE == 0 ? 512 : 3104) + h * 128 + half * 64;
        float ra[TPT], rb[TPT], rv[8]; f32x4 rg = {0.f, 0.f, 0.f, 0.f};
        float* sga = erv + 128;
#define REC_LOAD(cc) do { _Pragma("unroll") for (int tt = 0; tt < TPT; ++tt) { const bf16_t* pr = p.P + (size_t)row_of(dir, b, (cc) * 64 + part * TPT + tt) * EVW; \
            if (TYPE == 0) { ra[tt] = bf2f(pr[h * 64 + d]); rb[tt] = bf2f(pr[256 + h * 64 + d]); } else { ra[tt] = bf2f(pr[1568 + h * 128 + d]); rb[tt] = bf2f(pr[2080 + dir * 512 + h * 128 + d]); } } \
        _Pragma("unroll") for (int e = 0; e < 8; ++e) rv[e] = bf2f(p.P[(size_t)row_of(dir, b, (cc) * 64 + (tid >> 6) * 8 + e) * EVW + vcol0 + (tid & 63)]); \
        if (TYPE == 0 && tid < 256) rg = bf4_to_f32(*(const u32x2*)(p.P + (size_t)row_of(dir, b, (cc) * 64 + (tid >> 2)) * EVW + 1536 + dir * 16 + (tid & 3) * 4)); } while (0)
        REC_LOAD(0);
        for (int c = 0; c < (CTXL + SEQ) / 64; ++c) {
            __syncthreads();
            if (TYPE == 0) { if (tid < 256) *(f32x4*)(sga + tid * 4) = rg; __syncthreads(); }
            float qv[TPT], kv[TPT], lcv[TPT]; float lc = 0.f;
#pragma unroll
            for (int tt = 0; tt < TPT; ++tt) {
                float la;
                if (TYPE == 0) {
                    qv[tt] = ra[tt] * 0.125f; kv[tt] = rb[tt];
                    const float* ap = sga + (part * TPT + tt) * 16; float sg = gbias;
#pragma unroll
                    for (int i = 0; i < 16; i += 4) { const f32x4 a4 = *(const f32x4*)(ap + i); sg += a4[0] * wg[i] + a4[1] * wg[i + 1] + a4[2] * wg[i + 2] + a4[3] * wg[i + 3]; }
                    const float ex = __expf(-fabsf(sg)); la = (fminf(sg, 0.f) - __logf(1.f + ex)) * (1.f / 16.f);
                } else {
                    qv[tt] = ra[tt] * __builtin_amdgcn_rcpf(1.f + __expf(-ra[tt]));
                    const float f = lbv + (1.f - lbv) * __builtin_amdgcn_rcpf(1.f + __expf(-rb[tt]));
                    kv[tt] = 1.f - f; la = __logf(f);
                }
                lc += la; lcv[tt] = lc;
            }
            ptot[part * 128 + d] = lc;
            if (part == 32 / TPT) lref[d] = lcv[32 % TPT];
            *(bf16x8*)(Vt + (tid & 63) * 72 + (tid >> 6) * 8) = pack8((f32x4){rv[0], rv[1], rv[2], rv[3]}, (f32x4){rv[4], rv[5], rv[6], rv[7]});
            __syncthreads();
            float off = 0.f, bref = lref[d], blast = 0.f;
#pragma unroll
            for (int pp = 0; pp < NPART; ++pp) { const float tv = ptot[pp * 128 + d]; if (pp < part) off += tv; if (pp < 32 / TPT) bref += tv; blast += tv; }
            if (part == 0) { decv[d] = __expf(blast); elv[d] = __expf(blast - bref); erv[d] = __expf(bref); }
            {
                float ksv[TPT];
#pragma unroll
                for (int tt = 0; tt < TPT; ++tt) {
                    const int j = part * TPT + tt; const float bj = lcv[tt] + off;
                    const float e1 = __expf(bj - bref), e2 = __expf(bref - bj);
                    Qs[j * DKP + d] = f2bf(qv[tt] * e1); ksv[tt] = kv[tt] * e2; Ks[j * DKP + d] = f2bf(ksv[tt]);
                }
#pragma unroll
                for (int g = 0; g < TPT / 8; ++g) {
                    f32x4 a0 = {ksv[g * 8], ksv[g * 8 + 1], ksv[g * 8 + 2], ksv[g * 8 + 3]}, a1 = {ksv[g * 8 + 4], ksv[g * 8 + 5], ksv[g * 8 + 6], ksv[g * 8 + 7]};
                    *(bf16x8*)(KsT + d * 72 + part * TPT + g * 8) = pack8(a0, a1);
                }
            }
            __syncthreads();
            if (c + 1 < (CTXL + SEQ) / 64) REC_LOAD(c + 1);
#pragma unroll
            for (int rep = 0; rep < 2; ++rep) {
                const int t = w + rep * 8;
                if (t < 10) {
                    const int it = t < 1 ? 0 : (t < 3 ? 1 : (t < 6 ? 2 : 3)); const int jt = t - (it * (it + 1)) / 2;
                    f32x4 acc = {0.f, 0.f, 0.f, 0.f};
#pragma unroll
                    for (int ks = 0; ks < DK / 32; ++ks) {
                        const bf16x8 ka = *(const bf16x8*)(Ks + (jt * 16 + l15) * DKP + ks * 32 + q4 * 8);
                        const bf16x8 qb = *(const bf16x8*)(Qs + (it * 16 + l15) * DKP + ks * 32 + q4 * 8);
                        acc = __builtin_amdgcn_mfma_f32_16x16x32_bf16(ka, qb, acc, 0, 0, 0);
                    }
                    const int i = it * 16 + l15, j0 = jt * 16 + q4 * 4;
                    u32x2 wv; wv.x = pk2(i >= j0 ? acc[0] : 0.f, i >= j0 + 1 ? acc[1] : 0.f); wv.y = pk2(i >= j0 + 2 ? acc[2] : 0.f, i >= j0 + 3 ? acc[3] : 0.f);
                    *(u32x2*)(Ps + i * 72 + j0) = wv;
                }
            }
            __syncthreads();
            bf16x8 vb[2];
#pragma unroll
            for (int ks = 0; ks < 2; ++ks) vb[ks] = *(const bf16x8*)(Vt + (cw * 16 + l15) * 72 + ks * 32 + q4 * 8);
            bf16x8 sb[DK / 32];
#pragma unroll
            for (int ks = 0; ks < DK / 32; ++ks) {
                const f32x4 e0 = *(const f32x4*)(erv + ks * 32 + q4 * 4), e1 = *(const f32x4*)(erv + ks * 32 + 16 + q4 * 4);
                sb[ks] = pack8(Sacc[2 * ks] * e0, Sacc[2 * ks + 1] * e1);
            }
#pragma unroll
            for (int r2 = 0; r2 < 2; ++r2) {
                const int it = mh * 2 + r2;
                f32x4 acc = {0.f, 0.f, 0.f, 0.f};
#pragma unroll
                for (int ks = 0; ks < 2; ++ks) {
                    if (ks == 0 || it >= 2) {
                        const bf16x8 pa = *(const bf16x8*)(Ps + (it * 16 + l15) * 72 + ks * 32 + q4 * 8);
                        acc = __builtin_amdgcn_mfma_f32_16x16x32_bf16(pa, vb[ks], acc, 0, 0, 0);
                    }
                }
#pragma unroll
                for (int ks = 0; ks < DK / 32; ++ks) {
                    const u32x2 lo2 = *(const u32x2*)(Qs + (it * 16 + l15) * DKP + ks * 32 + q4 * 4), hi2 = *(const u32x2*)(Qs + (it * 16 + l15) * DKP + ks * 32 + 16 + q4 * 4);
                    u32x4 qa4; qa4.x = lo2.x; qa4.y = lo2.y; qa4.z = hi2.x; qa4.w = hi2.y;
                    acc = __builtin_amdgcn_mfma_f32_16x16x32_bf16(__builtin_bit_cast(bf16x8, qa4), sb[ks], acc, 0, 0, 0);
                }
#pragma unroll
                for (int e = 0; e < 4; ++e) {
                    const int row = row_of(dir, b, c * 64 + it * 16 + q4 * 4 + e);
                    p.O[((size_t)dir * NT + row) * 1024 + TYPE * 512 + h * 128 + half * 64 + cw * 16 + l15] = acc[e];
                }
            }
#pragma unroll
            for (int t = 0; t < NT16; ++t) {
                f32x4 acc = {0.f, 0.f, 0.f, 0.f};
#pragma unroll
                for (int ks = 0; ks < 2; ++ks) {
                    const bf16x8 ka = *(const bf16x8*)(KsT + (t * 16 + l15) * 72 + ks * 32 + q4 * 8);
                    acc = __builtin_amdgcn_mfma_f32_16x16x32_bf16(ka, vb[ks], acc, 0, 0, 0);
                }
                const f32x4 dv = *(const f32x4*)(decv + t * 16 + q4 * 4), ev = *(const f32x4*)(elv + t * 16 + q4 * 4);
                Sacc[t] = Sacc[t] * dv + ev * acc;
            }
        }
#undef REC_LOAD
    }
}
__device__ __forceinline__ void phase_rec0(const Params& p, unsigned char* lds) {
    const int nb = gridDim.x, b = blockIdx.x;
    if (nb >= 256) { if (b < 128) rec0_chunked<128, 1>(p, lds, b, 128); else { rec0_chunked<64, 0>(p, lds, b - 128, nb - 128); __syncthreads(); phase_convw(p, lds, 2, b - 128, nb - 128); } }
    else { rec0_chunked<128, 1>(p, lds, b, nb); rec0_chunked<64, 0>(p, lds, b, nb); __syncthreads(); phase_convw(p, lds, 2, b, nb); }
}

__device__ __forceinline__ void phase_readout0(const Params& p) {
    const int lane = threadIdx.x & 63, w = __builtin_amdgcn_readfirstlane(threadIdx.x >> 6);
    const int c = w * 128 + lane * 2;
    const float* gn = w < 4 ? p.gla_norm_g : p.hg_norm_g;
    const float g0 = gn[lane * 2], g1 = gn[lane * 2 + 1];
    const int goff = w < 4 ? (1024 + c) : (3616 + (c - 512));
    f32x2_t n0[4], n1[4]; unsigned ng[4];
#define RO0_LOAD(bi) do { _Pragma("unroll") for (int j = 0; j < 4; ++j) { const int r_ = (bi) * 4 + j; n0[j] = *(const f32x2_t*)(p.O + (size_t)r_ * 1024 + c); n1[j] = *(const f32x2_t*)(p.O + ((size_t)NT + r_) * 1024 + c); \
        ng[j] = *(const unsigned*)(p.P + (size_t)r_ * EVW + goff); } } while (0)
    if ((int)blockIdx.x < NT / 4) RO0_LOAD((int)blockIdx.x);
    for (int bi = blockIdx.x; bi < NT / 4; bi += gridDim.x) {
        f32x2_t c0[4], c1[4]; unsigned cg[4];
#pragma unroll
        for (int j = 0; j < 4; ++j) { c0[j] = n0[j]; c1[j] = n1[j]; cg[j] = ng[j]; }
        if (bi + (int)gridDim.x < NT / 4) RO0_LOAD(bi + (int)gridDim.x);
        asm volatile("" ::: "memory");
#pragma unroll
        for (int j = 0; j < 4; ++j) {
            const float a = c0[j].x + c1[j].x, b = c0[j].y + c1[j].y;
            const float ss = wave_sum(a * a + b * b);
            const float rs = rsqrtf(ss * (1.f / 128.f) + 1e-6f);
            const float ga = __uint_as_float(cg[j] << 16), gb = __uint_as_float(cg[j] & 0xffff0000u);
            *(unsigned*)(p.Y + (size_t)(bi * 4 + j) * 1024 + c) = pk2(a * rs * g0 * silu_f(ga), b * rs * g1 * silu_f(gb));
        }
        asm volatile("" ::: "memory");
    }
#undef RO0_LOAD
}

struct EpPre {
    const Params* p; int layer; int row0; int n0;
    __device__ __forceinline__ void operator()(const f32x4 (&acc)[4][4], int wm, int wn, int lane) const {
#pragma unroll
        for (int i = 0; i < 4; ++i) {
            const int row = row0 + EP_ROW(i);
            const float* xr = xin_row(*p, layer, row);
            const float* g1 = p->MOD + ((size_t)layer * 9 + row_mod(row)) * 6144 + 2048;
#pragma unroll
            for (int j = 0; j < 4; ++j) {
                const int col = n0 + EP_COL(j);
                const f32x4 xv = *(const f32x4*)(xr + col), gv = *(const f32x4*)(g1 + col);
                *(f32x4*)(p->PRE + (size_t)row * DM + col) = xv * DN_ALPHA + gv * acc[i][j];
            }
        }
    }
};
__device__ __forceinline__ void phase_outproj(const Params& p, unsigned char* lds, int layer) {
    const int rbase = layer == 0 ? 0 : NCTX;
    mg8::DenseOrder S; S.init(p.Y + (size_t)rbase * DM, layer == 0 ? p.WT_EVOUT : p.WT_ODOUT, NT - rbase, 1024, 1024, gridDim.x, blockIdx.x);
    mg8::EpiPre E{&p, layer, rbase};
    mg8::gemm_phase<mg8::EpiPre, mg8::DenseOrder, false>((MG_LAS unsigned char*)lds, 1024, S, E);
}

__device__ __forceinline__ void phase_ln1(const Params& p, int layer) {
    const int lane = threadIdx.x & 63, w = __builtin_amdgcn_readfirstlane(threadIdx.x >> 6);
    const int rbase = layer == 0 ? 0 : NCTX; const int npair = (NT - rbase) / 2;
    const float* lg = p.ln1_g + layer * DM; const float* lb = p.ln1_b + layer * DM;
    f32x4 nv[2][4];
#define LN1_LOAD(pi) do { _Pragma("unroll") for (int j = 0; j < 2; ++j) _Pragma("unroll") for (int i = 0; i < 4; ++i) nv[j][i] = *(const f32x4*)(p.PRE + (size_t)(rbase + (pi) * 2 + j) * DM + i * 256 + lane * 4); } while (0)
    const int pi0 = blockIdx.x * 8 + w, pstep = gridDim.x * 8;
    if (pi0 < npair) LN1_LOAD(pi0);
    for (int pi = pi0; pi < npair; pi += pstep) {
        f32x4 cv[2][4];
#pragma unroll
        for (int j = 0; j < 2; ++j)
#pragma unroll
            for (int i = 0; i < 4; ++i) cv[j][i] = nv[j][i];
        if (pi + pstep < npair) LN1_LOAD(pi + pstep);
        asm volatile("" ::: "memory");
#pragma unroll
        for (int j = 0; j < 2; ++j) {
            const int r = rbase + pi * 2 + j; float s = 0.f;
#pragma unroll
            for (int i = 0; i < 4; ++i) s += (cv[j][i][0] + cv[j][i][1]) + (cv[j][i][2] + cv[j][i][3]);
            const float mean = wave_sum(s) * (1.f / 1024.f); float q = 0.f;
#pragma unroll
            for (int i = 0; i < 4; ++i) { const f32x4 d = cv[j][i] - mean; q += (d[0] * d[0] + d[1] * d[1]) + (d[2] * d[2] + d[3] * d[3]); }
            const float rstd = rsqrtf(wave_sum(q) * (1.f / 1024.f) + 1e-5f);
            const float* md = p.MOD + ((size_t)layer * 9 + row_mod(r)) * 6144;
#pragma unroll
            for (int i = 0; i < 4; ++i) {
                const int col = i * 256 + lane * 4;
                const f32x4 y = (cv[j][i] - mean) * rstd * *(const f32x4*)(lg + col) + *(const f32x4*)(lb + col);
                *(f32x4*)(p.X1 + (size_t)r * DM + col) = y;
                const f32x4 uu = y * (*(const f32x4*)(md + 4096 + col) + 1.f) + *(const f32x4*)(md + 3072 + col);
                *(u32x2*)(p.U + (size_t)r * DM + col) = f32_to_bf4(uu);
            }
        }
        asm volatile("" ::: "memory");
    }
#undef LN1_LOAD
}

__device__ __forceinline__ void phase_router(const Params& p, unsigned char* lds, int layer) {
    const int rbase = layer == 0 ? 0 : NCTX;
    mg8::DenseOrder S; S.init(p.U + (size_t)rbase * DM, p.WT_ROUT + (size_t)layer * 256 * 1024, NT - rbase, 256, 1024, gridDim.x, blockIdx.x);
    mg8::EpiF32 E{p.LOGITS, 256, rbase, 256};
    mg8::gemm_phase<mg8::EpiF32, mg8::DenseOrder, false>((MG_LAS unsigned char*)lds, 1024, S, E);
}

__device__ __forceinline__ void phase_select(const Params& p, int layer) {
    const int lane = threadIdx.x & 63, w = __builtin_amdgcn_readfirstlane(threadIdx.x >> 6);
    const int rbase = layer == 0 ? 0 : NCTX; const int nrows = NT - rbase;
    const f32x4 bias = *(const f32x4*)(p.router_bias + layer * 256 + lane * 4);
    int* cnt = p.CNT + layer * 256;
    const float NEG = -__builtin_inff();
    f32x4 lgn = {0.f, 0.f, 0.f, 0.f};
    if ((int)(blockIdx.x * 8 + w) < nrows) lgn = *(const f32x4*)(p.LOGITS + (size_t)(rbase + blockIdx.x * 8 + w) * 256 + lane * 4);
    for (int t = blockIdx.x * 8 + w; t < nrows; t += gridDim.x * 8) {
        const f32x4 lg = lgn;
        if (t + (int)gridDim.x * 8 < nrows) lgn = *(const f32x4*)(p.LOGITS + (size_t)(rbase + t + gridDim.x * 8) * 256 + lane * 4);
        float sc0 = sigmoid_f(lg[0]), sc1 = sigmoid_f(lg[1]), sc2 = sigmoid_f(lg[2]), sc3 = sigmoid_f(lg[3]);
        float s0 = sc0 + bias[0], s1 = sc1 + bias[1], s2 = sc2 + bias[2], s3 = sc3 + bias[3];
        float a = fmaxf(s0, s1), b = fminf(s0, s1), c = fmaxf(s2, s3), d = fminf(s2, s3);
        float m1 = fmaxf(a, c), m2 = fmaxf(fminf(a, c), fmaxf(b, d));
#define SEL_MERGE(ctrl) do { const float o1 = DPPF(m1, ctrl, 0xF), o2 = DPPF(m2, ctrl, 0xF); const float n1 = fmaxf(m1, o1), n2 = fmaxf(fminf(m1, o1), fmaxf(m2, o2)); m1 = n1; m2 = n2; } while (0)
        SEL_MERGE(0xB1); SEL_MERGE(0x4E); SEL_MERGE(0x141);
#undef SEL_MERGE
        const float grp = m1 + m2; const int myg = lane >> 3; int rank = 0;
#pragma unroll
        for (int g = 0; g < 8; ++g) { const float sg = __int_as_float(__builtin_amdgcn_readlane(__float_as_int(grp), g * 8)); rank += (sg > grp || (sg == grp && g < myg)) ? 1 : 0; }
        if (rank >= 4) { s0 = NEG; s1 = NEG; s2 = NEG; s3 = NEG; }
        int my_e = 0; float my_s = 0.f, gsum = 0.f;
#pragma unroll 1
        for (int k = 0; k < 8; ++k) {
            float lm = s0; int li = 0;
            if (s1 > lm) { lm = s1; li = 1; }
            if (s2 > lm) { lm = s2; li = 2; }
            if (s3 > lm) { lm = s3; li = 3; }
            const float wmx = wave_max(lm);
            const unsigned long long bal = __ballot(lm == wmx);
            const int win = __ffsll((long long)bal) - 1;
            const float mysc = li == 0 ? sc0 : (li == 1 ? sc1 : (li == 2 ? sc2 : sc3));
            const int e = win * 4 + __builtin_amdgcn_readlane(li, win);
            const float se = __int_as_float(__builtin_amdgcn_readlane(__float_as_int(mysc), win));
            if (lane == win) { if (li == 0) s0 = NEG; else if (li == 1) s1 = NEG; else if (li == 2) s2 = NEG; else s3 = NEG; }
            if (lane == k) { my_e = e; my_s = se; }
            gsum += se;
        }
        if (lane < 8) {
            const int pos = atomicAdd(&cnt[my_e], 1);
            const size_t o = (size_t)t * 8 + lane;
            p.EIDX[o] = my_e; p.GATE[o] = my_s / gsum * 2.5f; p.POS[o] = pos;
        }
    }
}

__device__ __forceinline__ void phase_offsets(const Params& p, unsigned char* lds, int layer) {
    int* offs = (int*)lds;
    const int tid = threadIdx.x;
    const int rbase = layer == 0 ? 0 : NCTX; const int nrows = NT - rbase;
    const int* cnt = p.CNT + layer * 256;
    __syncthreads();
    if (tid == 0) { int a = 0; for (int e = 0; e < 256; ++e) { offs[e] = a; a += (cnt[e] + 255) & ~255; } offs[256] = a; }
    __syncthreads();
    const int ntr = offs[256] >> 8;
    if (blockIdx.x == 0) {
        if (tid == 0) p.META[layer * 64] = ntr;
        for (int i = tid; i < ntr; i += NTHR) { int lo = 0, hi = 255; const int s = i * 256; while (lo < hi) { const int mid = (lo + hi + 1) >> 1; if (offs[mid] <= s) lo = mid; else hi = mid - 1; }
            p.TILE_E[i] = lo; }
    }
    for (int i = blockIdx.x * NTHR + tid; i < nrows * 8; i += gridDim.x * NTHR) {
        const int e = p.EIDX[i]; const int slot = offs[e] + p.POS[i];
        p.SLOT_TOK[slot] = rbase + (i >> 3); p.SLOT_GATE[slot] = p.GATE[i]; p.TOKSLOT[i] = slot;
    }
    for (int i = blockIdx.x * NTHR + tid; i < nrows; i += gridDim.x * NTHR) p.SLOT_GATE[ntr * 256 + i] = 1.f;
    for (int e = blockIdx.x; e < 256; e += gridDim.x) {
        const int c = cnt[e], pe = (c + 255) & ~255;
        for (int s = c + tid; s < pe; s += NTHR) { p.SLOT_TOK[offs[e] + s] = rbase; p.SLOT_GATE[offs[e] + s] = 0.f; }
    }
}

struct EpAct {
    bf16_t* ACT; int slot0; int nt;
    __device__ __forceinline__ void operator()(const f32x4 (&acc)[4][4], int wm, int wn, int lane) const {
#pragma unroll
        for (int i = 0; i < 4; ++i) {
            const int row = slot0 + EP_ROW(i);
#pragma unroll
            for (int j = 0; j < 2; ++j) {
                const int col = nt * 64 + wn * 32 + j * 16 + (lane >> 4) * 4;
                const f32x4 h1 = acc[i][j], h3 = acc[i][j + 2];
                u32x2 wv; wv.x = pk2(silu_f(h1[0]) * h3[0], silu_f(h1[1]) * h3[1]); wv.y = pk2(silu_f(h1[2]) * h3[2], silu_f(h1[3]) * h3[3]);
                *(u32x2*)(ACT + (size_t)row * 256 + col) = wv;
            }
        }
    }
};
__device__ __forceinline__ void phase_moe1(const Params& p, unsigned char* lds, int layer) {
    const int rbase = layer == 0 ? 0 : NCTX; const int nsh = (NT - rbase) / 256; const int ntr = p.META[layer * 64];
    mg8::MoeOrder S; S.ntr = ntr; S.npn = 2; S.nwg = (ntr + nsh) * 2; S.G = gridDim.x; S.c = blockIdx.x; S.K = 1024; S.rbase = rbase; S.gather = true;
    S.A = (const char*)p.U; S.Wexp = (const char*)(p.WT_W13 + (size_t)layer * 256 * 512 * 1024); S.wstride = (size_t)512 * 1024 * 2; S.Wsh = (const char*)(p.WT_SH13 + (size_t)layer * 512 * 1024);
    S.tile_e = p.TILE_E; S.slot_tok = p.SLOT_TOK;
    mg8::EpiAct E{p.ACT};
    mg8::gemm_phase<mg8::EpiAct, mg8::MoeOrder, true>((MG_LAS unsigned char*)lds, 1024, S, E);
}
struct EpYs {
    bf16_t* YS; const float* gate; int slot0; int n0;
    __device__ __forceinline__ void operator()(const f32x4 (&acc)[4][4], int wm, int wn, int lane) const {
#pragma unroll
        for (int i = 0; i < 4; ++i) {
            const int row = slot0 + EP_ROW(i); const float g = gate ? gate[row] : 1.f;
#pragma unroll
            for (int j = 0; j < 4; ++j) {
                const int col = n0 + EP_COL(j); const f32x4 v = acc[i][j] * g;
                u32x2 wv; wv.x = pk2(v[0], v[1]); wv.y = pk2(v[2], v[3]);
                *(u32x2*)(YS + (size_t)row * DM + col) = wv;
            }
        }
    }
};
__device__ __forceinline__ void phase_moe2(const Params& p, unsigned char* lds, int layer) {
    const int rbase = layer == 0 ? 0 : NCTX; const int nsh = (NT - rbase) / 256; const int ntr = p.META[layer * 64];
    mg8::MoeOrder S; S.ntr = ntr; S.npn = 4; S.nwg = (ntr + nsh) * 4; S.G = gridDim.x; S.c = blockIdx.x; S.K = 256; S.rbase = rbase; S.gather = false;
    S.A = (const char*)p.ACT; S.Wexp = (const char*)(p.WT_W2 + (size_t)layer * 256 * 1024 * 256); S.wstride = (size_t)1024 * 256 * 2; S.Wsh = (const char*)(p.WT_SH2 + (size_t)layer * 1024 * 256);
    S.tile_e = p.TILE_E; S.slot_tok = p.SLOT_TOK;
    mg8::EpiYs E{p.YS, p.SLOT_GATE, ntr};
    mg8::gemm_phase<mg8::EpiYs, mg8::MoeOrder, false>((MG_LAS unsigned char*)lds, 256, S, E);
}
__device__ __forceinline__ int cb_slot(int routed, int shared, int lane) { return lane == 8 ? shared : routed; }
__device__ __forceinline__ void phase_combine(const Params& p, int layer) {
    const int lane = threadIdx.x & 63, w = __builtin_amdgcn_readfirstlane(threadIdx.x >> 6);
    const int rbase = layer == 0 ? 0 : NCTX; const int nrows = NT - rbase;
    const int ntr = p.META[layer * 64];
    const float* lg = p.ln2_g + layer * DM; const float* lb = p.ln2_b + layer * DM;
    const int t0 = blockIdx.x * 8 + w, tstep = gridDim.x * 8;
#define CB_SLOT(tt) cb_slot(p.TOKSLOT[(size_t)(tt) * 8 + (lane & 7)], ntr * 256 + (tt), lane)
#define CB_LOAD(tt, sl, Y_, X_) do { _Pragma("unroll") for (int k = 0; k < 9; ++k) { const int slot_ = __builtin_amdgcn_readlane(sl, k); const unsigned char* yr_ = (const unsigned char*)p.YS + (size_t)slot_ * DM; \
        _Pragma("unroll") for (int i = 0; i < 4; ++i) Y_[k][i] = *(const int*)(yr_ + i * 256 + lane * 4); } \
        _Pragma("unroll") for (int i = 0; i < 4; ++i) X_[i] = *(const f32x4*)(p.X1 + (size_t)(rbase + (tt)) * DM + i * 256 + lane * 4); } while (0)
    int yA[9][4]; f32x4 xA[4];
    int slB = 0, slC = 0;
    if (t0 < nrows) { const int sl0 = CB_SLOT(t0); CB_LOAD(t0, sl0, yA, xA); }
    if (t0 + tstep < nrows) slB = CB_SLOT(t0 + tstep);
    for (int t = t0; t < nrows; t += tstep) {
        const int r = rbase + t;
        f32x4 mo[4];
#pragma unroll
        for (int i = 0; i < 4; ++i) mo[i] = (f32x4){0.f, 0.f, 0.f, 0.f};
#pragma unroll
        for (int k = 0; k < 9; ++k)
#pragma unroll
            for (int i = 0; i < 4; ++i) { const f32x2_t lo = __builtin_amdgcn_cvt_pk_f32_fp8(yA[k][i], false), hi = __builtin_amdgcn_cvt_pk_f32_fp8(yA[k][i], true);
                mo[i][0] += lo.x; mo[i][1] += lo.y; mo[i][2] += hi.x; mo[i][3] += hi.y; }
        const float* md = p.MOD + ((size_t)layer * 9 + row_mod(r)) * 6144 + 5120;
        f32x4 v[4]; float s = 0.f;
#pragma unroll
        for (int i = 0; i < 4; ++i) { const int col = i * 256 + lane * 4; v[i] = xA[i] * DN_ALPHA + *(const f32x4*)(md + col) * (mo[i] * (1.f / 64.f)); s += (v[i][0] + v[i][1]) + (v[i][2] + v[i][3]); }
        const float mean = wave_sum(s) * (1.f / 1024.f); float q = 0.f;
#pragma unroll
        for (int i = 0; i < 4; ++i) { const f32x4 d = v[i] - mean; q += (d[0] * d[0] + d[1] * d[1]) + (d[2] * d[2] + d[3] * d[3]); }
        const float rstd = rsqrtf(wave_sum(q) * (1.f / 1024.f) + 1e-5f);
        asm volatile("" ::: "memory");
        if (t + 2 * tstep < nrows) slC = CB_SLOT(t + 2 * tstep);
        if (t + tstep < nrows) CB_LOAD(t + tstep, slB, yA, xA);
        asm volatile("" ::: "memory");
        float* dst = layer == 0 ? p.X2 + (size_t)r * DM : p.out + (size_t)t * DM;
#pragma unroll
        for (int i = 0; i < 4; ++i) { const int col = i * 256 + lane * 4; const f32x4 ov = (v[i] - mean) * rstd * *(const f32x4*)(lg + col) + *(const f32x4*)(lb + col);
            *(f32x4*)(dst + col) = ov;
            if (layer == 0) { const float* m1 = p.MOD + ((size_t)9 + row_mod(r)) * 6144; const f32x4 hv = ov * (*(const f32x4*)(m1 + 1024 + col) + 1.f) + *(const f32x4*)(m1 + col); *(u32x2*)(p.HIN + (size_t)r * DM + col) = f32_to_bf4(hv); } }
        asm volatile("" ::: "memory");
        slB = slC;
    }
#undef CB_SLOT
#undef CB_LOAD
}

typedef float f32x2 __attribute__((ext_vector_type(2)));
__device__ __forceinline__ f32x2 cmul(f32x2 a, f32x2 b) { return (f32x2){a.x * b.x - a.y * b.y, a.x * b.y + a.y * b.x}; }
#define SQH 0.70710678118654752f
__device__ __forceinline__ void fft_dif8(f32x2* X, const int q) {
    __syncthreads();
#pragma unroll 1
    for (int o = threadIdx.x; o < 1024; o += NTHR) {
        const int pp = o & (q - 1), base = ((o - pp) << 3) + pp;
        f32x2 x[8];
#pragma unroll
        for (int m = 0; m < 8; ++m) x[m] = X[base + m * q];
        const float rev = -(float)pp / (float)(8 * q);
        const f32x2 w1 = {__builtin_amdgcn_cosf(rev), __builtin_amdgcn_sinf(rev)}; const f32x2 w2 = cmul(w1, w1), w4 = cmul(w2, w2);
        { f32x2 a = x[0], b = x[4]; x[0] = a + b; x[4] = cmul(a - b, w1); }
        { f32x2 a = x[1], b = x[5]; x[1] = a + b; x[5] = cmul(a - b, cmul(w1, (f32x2){SQH, -SQH})); }
        { f32x2 a = x[2], b = x[6]; x[2] = a + b; x[6] = cmul(a - b, (f32x2){w1.y, -w1.x}); }
        { f32x2 a = x[3], b = x[7]; x[3] = a + b; x[7] = cmul(a - b, cmul(w1, (f32x2){-SQH, -SQH})); }
#pragma unroll
        for (int blk = 0; blk < 8; blk += 4) {
            { f32x2 a = x[blk], b = x[blk + 2]; x[blk] = a + b; x[blk + 2] = cmul(a - b, w2); }
            { f32x2 a = x[blk + 1], b = x[blk + 3]; x[blk + 1] = a + b; x[blk + 3] = cmul(a - b, (f32x2){w2.y, -w2.x}); }
        }
#pragma unroll
        for (int m = 0; m < 8; m += 2) { f32x2 a = x[m], b = x[m + 1]; x[m] = a + b; x[m + 1] = cmul(a - b, w4); }
#pragma unroll
        for (int m = 0; m < 8; ++m) X[base + m * q] = x[m];
    }
}
__device__ __forceinline__ void fft_dit8(f32x2* X, const int q) {
    __syncthreads();
#pragma unroll 1
    for (int o = threadIdx.x; o < 1024; o += NTHR) {
        const int pp = o & (q - 1), base = ((o - pp) << 3) + pp;
        f32x2 x[8];
#pragma unroll
        for (int m = 0; m < 8; ++m) x[m] = X[base + m * q];
        const float rev = (float)pp / (float)(8 * q);
        const f32x2 w1 = {__builtin_amdgcn_cosf(rev), __builtin_amdgcn_sinf(rev)}; const f32x2 w2 = cmul(w1, w1), w4 = cmul(w2, w2);
#pragma unroll
        for (int m = 0; m < 8; m += 2) { f32x2 a = x[m], b = cmul(x[m + 1], w4); x[m] = a + b; x[m + 1] = a - b; }
#pragma unroll
        for (int blk = 0; blk < 8; blk += 4) {
            { f32x2 a = x[blk], b = cmul(x[blk + 2], w2); x[blk] = a + b; x[blk + 2] = a - b; }
            { f32x2 a = x[blk + 1], b = cmul(x[blk + 3], (f32x2){-w2.y, w2.x}); x[blk + 1] = a + b; x[blk + 3] = a - b; }
        }
        { f32x2 a = x[0], b = cmul(x[4], w1); x[0] = a + b; x[4] = a - b; }
        { f32x2 a = x[1], b = cmul(x[5], cmul(w1, (f32x2){SQH, SQH})); x[1] = a + b; x[5] = a - b; }
        { f32x2 a = x[2], b = cmul(x[6], (f32x2){-w1.y, w1.x}); x[2] = a + b; x[6] = a - b; }
        { f32x2 a = x[3], b = cmul(x[7], cmul(w1, (f32x2){-SQH, SQH})); x[3] = a + b; x[7] = a - b; }
#pragma unroll
        for (int m = 0; m < 8; ++m) X[base + m * q] = x[m];
    }
}
__device__ __forceinline__ void fft_r2(f32x2* X) {
    __syncthreads();
#pragma unroll 1
    for (int k = threadIdx.x; k < 4096; k += NTHR) { const f32x4 v = *(const f32x4*)(X + 2 * k); *(f32x4*)(X + 2 * k) = (f32x4){v[0] + v[2], v[1] + v[3], v[0] - v[2], v[1] - v[3]}; }
}
__device__ __forceinline__ void fft_fwd(f32x2* X) { fft_dif8(X, 1024); fft_dif8(X, 128); fft_dif8(X, 16); fft_dif8(X, 2); fft_r2(X); }
__device__ __forceinline__ void fft_inv(f32x2* X) { fft_r2(X); fft_dit8(X, 2); fft_dit8(X, 16); fft_dit8(X, 128); fft_dit8(X, 1024); }

__device__ __forceinline__ void phase_filtfft(const Params& p, unsigned char* lds) {
    f32x2* X = (f32x2*)lds;
    for (int u = blockIdx.x; u < 1024; u += gridDim.x) {
        const float* g = p.G + (size_t)u * 8192;
        __syncthreads();
        for (int tau = threadIdx.x; tau < 8192; tau += NTHR) X[tau] = (f32x2){g[(tau + 4096) & 8191], 0.f};
        fft_fwd(X);
        __syncthreads();
        f32x2* o = p.FF + (size_t)u * 8192;
        for (int r = threadIdx.x; r < 8192; r += NTHR) o[r] = X[r] * (1.f / 8192.f);
    }
}
__device__ __forceinline__ void phase_shortconv(const Params& p, unsigned char* lds) {
    float* T = (float*)lds;
    const int tid = threadIdx.x, lane = tid & 63, w = tid >> 6;
    float v[10];
#define SC_LOAD(uu) do { const int ct_ = (uu) % 24, tt_ = ((uu) / 24) & 63, b_ = (uu) / (24 * 64); const int t0_ = tt_ * 64 + w * 8; \
        const bf16_t* pr_ = p.P + (size_t)(NCTX + b_ * 4096 + t0_) * ODW + ct_ * 64 + lane; \
        _Pragma("unroll") for (int k = 0; k < 10; ++k) { const int t = t0_ + k - 1; const bool ok_ = (t >= 0 && t < 4096); const bf16_t x_ = pr_[ok_ ? (ptrdiff_t)(k - 1) * ODW : 0]; v[k] = ok_ ? bf2f(x_) : 0.f; } } while (0)
    if ((int)blockIdx.x < 8 * 64 * 24) SC_LOAD((int)blockIdx.x);
    for (int u = blockIdx.x; u < 8 * 64 * 24; u += gridDim.x) {
        const int ct = u % 24, tt = (u / 24) & 63, b = u / (24 * 64);
        const int c = ct * 64 + lane;
        const float w0 = p.hy_conv_w[c], w1 = p.hy_conv_w[1536 + c], w2 = p.hy_conv_w[3072 + c], cb = p.hy_conv_b[c];
        float o[8];
#pragma unroll
        for (int k = 0; k < 8; ++k) o[k] = cb + v[k] * w0 + v[k + 1] * w1 + v[k + 2] * w2;
        if (u + (int)gridDim.x < 8 * 64 * 24) SC_LOAD(u + (int)gridDim.x);
        __syncthreads();
#pragma unroll
        for (int k = 0; k < 8; ++k) T[lane * 65 + w * 8 + k] = o[k];
        __syncthreads();
        const int cc = tid >> 3, seg = tid & 7; const int cg = ct * 64 + cc; const int plane = cg >> 9, cl = cg & 511;
        float* dst = p.UH + (((size_t)plane * 8 + b) * 512 + cl) * 4096 + tt * 64 + seg * 8;
        f32x4 o0, o1;
#pragma unroll
        for (int e = 0; e < 4; ++e) { o0[e] = T[cc * 65 + seg * 8 + e]; o1[e] = T[cc * 65 + seg * 8 + 4 + e]; }
        *(f32x4*)dst = o0; *(f32x4*)(dst + 4) = o1;
    }
#undef SC_LOAD
}
__device__ __forceinline__ void phase_hyena(const Params& p, unsigned char* lds) {
    f32x2* X = (f32x2*)lds;
    const int tid = threadIdx.x;
    for (int u = blockIdx.x; u < 2048; u += gridDim.x) {
        const int c = u >> 2, b0 = (u & 3) * 2, b1 = b0 + 1;
        const float* v0p = p.UH + ((size_t)(0 * 8 + b0) * 512 + c) * 4096; const float* v1p = p.UH + ((size_t)(0 * 8 + b1) * 512 + c) * 4096;
        float zr[8], zi[8];
        __syncthreads();
#pragma unroll
        for (int k = 0; k < 8; ++k) { const int t = tid + NTHR * k; zr[k] = v0p[t]; zi[k] = v1p[t]; X[t] = (f32x2){zr[k], zi[k]}; X[t + 4096] = (f32x2){0.f, 0.f}; }
#pragma unroll 1
        for (int n = 0; n < 2; ++n) {
            fft_fwd(X);
            __syncthreads();
            const f32x2* ff = p.FF + ((size_t)n * 512 + c) * 8192;
            for (int r = tid; r < 8192; r += NTHR) X[r] = cmul(X[r], ff[r]);
            fft_inv(X);
            __syncthreads();
            const float bias = p.hy_bias[n * 512 + c];
            const float* g0p = p.UH + ((size_t)((n + 1) * 8 + b0) * 512 + c) * 4096; const float* g1p = p.UH + ((size_t)((n + 1) * 8 + b1) * 512 + c) * 4096;
#pragma unroll
            for (int k = 0; k < 8; ++k) {
                const int t = tid + NTHR * k; const f32x2 y = X[t];
                zr[k] = g0p[t] * (y.x + zr[k] * bias); zi[k] = g1p[t] * (y.y + zi[k] * bias);
                if (n == 0) { X[t] = (f32x2){zr[k], zi[k]}; X[t + 4096] = (f32x2){0.f, 0.f}; }
                else { p.Z1[((size_t)b0 * 512 + c) * 4096 + t] = zr[k]; p.Z1[((size_t)b1 * 512 + c) * 4096 + t] = zi[k]; }
            }
        }
    }
}
__device__ __forceinline__ void phase_zt2y(const Params& p, unsigned char* lds) {
    float* T = (float*)lds;
    const int tid = threadIdx.x;
    for (int u = blockIdx.x; u < 8 * 64 * 8; u += gridDim.x) {
        const int ct = u & 7, tt = (u >> 3) & 63, b = u >> 9;
        const int cc = tid >> 3, seg = tid & 7;
        const float* src = p.Z1 + ((size_t)b * 512 + ct * 64 + cc) * 4096 + tt * 64 + seg * 8;
        const f32x4 i0 = *(const f32x4*)src, i1 = *(const f32x4*)(src + 4);
        __syncthreads();
#pragma unroll
        for (int e = 0; e < 4; ++e) { T[cc * 65 + seg * 8 + e] = i0[e]; T[cc * 65 + seg * 8 + 4 + e] = i1[e]; }
        __syncthreads();
        const int t = tid >> 3, cs = tid & 7; f32x4 o0, o1;
#pragma unroll
        for (int e = 0; e < 4; ++e) { o0[e] = T[(cs * 8 + e) * 65 + t]; o1[e] = T[(cs * 8 + 4 + e) * 65 + t]; }
        *(bf16x8*)(p.Y + (size_t)(NCTX + b * 4096 + tt * 64 + t) * DM + ct * 64 + cs * 8) = pack8(o0, o1);
    }
}
struct RwRaw { f32x4 own, sh; };
__device__ __forceinline__ RwRaw rw_raw4(const Params& p, int r, int cc) {
    const bf16_t* pr = p.P + (size_t)r * ODW + 1536 + cc;
    const bool isctx = r < NCTX; const int t = isctx ? (r & 255) : ((r - NCTX) & 4095); const int gr = t >> 6, gc = t & 63;
    const bool v0 = isctx ? (t > 0) : (gc > 0), v1 = isctx ? (t < 255) : (gc < 63), v2 = isctx ? (t > 0) : (gr > 0), v3 = isctx ? (t < 255) : (gr < 63);
    const int o2 = isctx ? -ODW : -64 * ODW, o3 = isctx ? ODW : 64 * ODW;
    const bf16_t x0 = pr[v0 ? -ODW : 0], x1 = pr[(v1 ? ODW : 0) + 1], x2 = pr[(v2 ? o2 : 0) + 2], x3 = pr[(v3 ? o3 : 0) + 3];
    RwRaw R; R.own = bf4_to_f32(*(const u32x2*)pr);
    R.sh[0] = v0 ? bf2f(x0) : 0.f; R.sh[1] = v1 ? bf2f(x1) : 0.f; R.sh[2] = v2 ? bf2f(x2) : 0.f; R.sh[3] = v3 ? bf2f(x3) : 0.f;
    return R;
}
__device__ __forceinline__ f32x4 rw_mix(const RwRaw& R, const f32x4 mu4) { return R.own + mu4 * (R.sh - R.own); }
__device__ __forceinline__ f32x4 rw_mix4(const Params& p, int r, int cc) { const RwRaw R = rw_raw4(p, r, cc); return rw_mix(R, *(const f32x4*)(p.rw_mu + cc)); }
__device__ __forceinline__ float fsig(float x) { return __builtin_amdgcn_rcpf(1.f + __expf(-x)); }
__device__ __forceinline__ void phase_rwstreams(const Params& p, unsigned char* lds) {
    constexpr int XS = 328, KS = 520;
    bf16_t* X = (bf16_t*)lds;
    float* ss = (float*)(X + 64 * XS);
    bf16_t* KMX = (bf16_t*)(ss + 512);
    const int tid = threadIdx.x, lane = tid & 63, h = tid >> 6, q4 = lane >> 4, l15 = lane & 15;
    for (int ti = blockIdx.x; ti < NT / 64; ti += gridDim.x) {
        const int tile = mg8::xcd_remap(ti, NT / 64);
        const int r0 = tile * 64;
        __syncthreads();
#pragma unroll 5
        for (int it = tid; it < 64 * 80; it += NTHR) {
            const int row = it / 80, qd = it % 80, cc = qd * 4;
            f32x4 v = rw_mix4(p, r0 + row, 1536 + cc);
            if (cc < 128) {
#pragma unroll
                for (int e = 0; e < 4; ++e) v[e] = 1.f - 2.f * __builtin_amdgcn_rcpf(1.f + __expf(2.f * v[e]));
            } else if (cc >= 192) {
#pragma unroll
                for (int e = 0; e < 4; ++e) v[e] = fsig(v[e]);
            }
            u32x2 wv; wv.x = pk2(v[0], v[1]); wv.y = pk2(v[2], v[3]);
            *(u32x2*)(X + row * XS + cc) = wv;
        }
        {
            RwRaw cur[6], nxt[6];
#pragma unroll
            for (int j = 0; j < 6; ++j) { const int it = tid + j * NTHR; nxt[j] = rw_raw4(p, r0 + it / 384, (it % 384) * 4); }
#pragma unroll 1
            for (int bt = 0; bt < 8; ++bt) {
#pragma unroll
                for (int j = 0; j < 6; ++j) cur[j] = nxt[j];
                if (bt + 1 < 8) {
#pragma unroll
                    for (int j = 0; j < 6; ++j) { const int it = tid + ((bt + 1) * 6 + j) * NTHR; nxt[j] = rw_raw4(p, r0 + it / 384, (it % 384) * 4); }
                }
                asm volatile("" ::: "memory");
#pragma unroll
                for (int j = 0; j < 6; ++j) {
                    const int it = tid + (bt * 6 + j) * NTHR; const int row = it / 384, qd = it % 384; const int r = r0 + row;
                    const f32x4 v = rw_mix(cur[j], *(const f32x4*)(p.rw_mu + qd * 4));
                    if (qd < 128) *(u32x2*)(p.RR + (size_t)r * 512 + qd * 4) = f32_to_bf4(v);
                    else if (qd >= 256) *(u32x2*)(p.VV + (size_t)r * 512 + (qd - 256) * 4) = f32_to_bf4(v);
                    else {
                        const int kq = qd - 128;
                        const f32x4 kr = v * *(const f32x4*)(p.rw_k_k + kq * 4);
                        float sacc = (kr[0] * kr[0] + kr[1] * kr[1]) + (kr[2] * kr[2] + kr[3] * kr[3]);
                        sacc += DPPF(sacc, 0xB1, 0xF); sacc += DPPF(sacc, 0x4E, 0xF); sacc += DPPF(sacc, 0x141, 0xF); sacc += DPPF(sacc, 0x140, 0xF);
                        if ((lane & 15) == 0) ss[row * 8 + (kq >> 4)] = sacc;
                        *(u32x2*)(KMX + row * KS + kq * 4) = f32_to_bf4(v);
                    }
                }
                asm volatile("" ::: "memory");
            }
        }
        __syncthreads();
#pragma unroll 4
        for (int it = tid; it < 64 * 128; it += NTHR) {
            const int row = it >> 7, kq = it & 127;
            const u32x2 mk = *(const u32x2*)(KMX + row * KS + kq * 4);
            const f32x4 k4 = {__uint_as_float(mk.x << 16), __uint_as_float(mk.x & 0xffff0000u), __uint_as_float(mk.y << 16), __uint_as_float(mk.y & 0xffff0000u)};
            const float rn = __builtin_amdgcn_rsqf(fmaxf(ss[row * 8 + (kq >> 4)], 1e-24f));
            *(u32x2*)(p.KK + (size_t)(r0 + row) * 512 + kq * 4) = f32_to_bf4(k4 * *(const f32x4*)(p.rw_k_k + kq * 4) * rn);
        }
#pragma unroll 1
        for (int ct = 0; ct < 4; ++ct) {
            const int c0 = h * 64 + ct * 16 + q4 * 4;
            const int cw = h * 64 + ct * 16 + l15;
            bf16x8 wf[2], wb[2], wa[2], wg[4];
#pragma unroll
            for (int ks = 0; ks < 2; ++ks) { wf[ks] = *(const bf16x8*)(p.WT_RWF + (size_t)cw * 64 + ks * 32 + q4 * 8); wb[ks] = *(const bf16x8*)(p.WT_RWB + (size_t)cw * 64 + ks * 32 + q4 * 8); wa[ks] = *(const bf16x8*)(p.WT_RWA + (size_t)cw * 64 + ks * 32 + q4 * 8); }
#pragma unroll
            for (int ks = 0; ks < 4; ++ks) wg[ks] = *(const bf16x8*)(p.WT_RWG + (size_t)cw * 128 + ks * 32 + q4 * 8);
            const f32x4 w0f = *(const f32x4*)(p.rw_w0 + c0), w0b = *(const f32x4*)(p.rw_w0 + 512 + c0), a0 = *(const f32x4*)(p.rw_a0 + c0), kkw = *(const f32x4*)(p.rw_k_k + c0), kaw = *(const f32x4*)(p.rw_k_a + c0);
#pragma unroll 1
            for (int rt = 0; rt < 4; ++rt) {
                const int rloc = rt * 16 + l15; const int row = r0 + rloc;
                f32x4 aF = {0.f, 0.f, 0.f, 0.f}, aB = aF, aA = aF, aG = aF;
                const bf16_t* xr = X + rloc * XS + q4 * 8;
#pragma unroll
                for (int ks = 0; ks < 2; ++ks) {
                    aF = __builtin_amdgcn_mfma_f32_16x16x32_bf16(wf[ks], *(const bf16x8*)(xr + ks * 32), aF, 0, 0, 0);
                    aB = __builtin_amdgcn_mfma_f32_16x16x32_bf16(wb[ks], *(const bf16x8*)(xr + 64 + ks * 32), aB, 0, 0, 0);
                    aA = __builtin_amdgcn_mfma_f32_16x16x32_bf16(wa[ks], *(const bf16x8*)(xr + 128 + ks * 32), aA, 0, 0, 0);
                }
#pragma unroll
                for (int ks = 0; ks < 4; ++ks) aG = __builtin_amdgcn_mfma_f32_16x16x32_bf16(wg[ks], *(const bf16x8*)(xr + 192 + ks * 32), aG, 0, 0, 0);
                const u32x2 mk = *(const u32x2*)(KMX + rloc * KS + c0);
                const f32x4 k4 = {__uint_as_float(mk.x << 16), __uint_as_float(mk.x & 0xffff0000u), __uint_as_float(mk.y << 16), __uint_as_float(mk.y & 0xffff0000u)};
                const float rn = __builtin_amdgcn_rsqf(fmaxf(ss[rloc * 8 + h], 1e-24f));
                const size_t o = (size_t)row * 512 + c0;
                f32x4 ldf, ldb, bvv, kp;
#pragma unroll
                for (int e = 0; e < 4; ++e) {
                    ldf[e] = -0.60653065971f * fsig(w0f[e] + aF[e]); ldb[e] = -0.60653065971f * fsig(w0b[e] + aB[e]);
                    const float av = fsig(a0[e] + aA[e]);
                    bvv[e] = k4[e] * kkw[e] * rn * av; kp[e] = k4[e] * (1.f + (av - 1.f) * kaw[e]);
                }
                *(f32x4*)(p.DEC + o) = ldf; *(f32x4*)(p.DEC + (size_t)NT * 512 + o) = ldb;
                *(u32x2*)(p.BV + o) = f32_to_bf4(bvv); *(u32x2*)(p.KP + o) = f32_to_bf4(kp); *(u32x2*)(p.GT + o) = f32_to_bf4(aG + 0.f);
            }
        }
    }
}
#define RW_NUNIT 8704
__device__ __forceinline__ void phase_rwprep(const Params& p, unsigned char* lds) {
    constexpr int SL = 64 * 72;
    float* MT = (float*)lds;
    float* ptot = MT + 64 * 68;
    float* gcv = ptot + 512;
    bf16_t* L = (bf16_t*)(gcv + 64);
    bf16_t *sBp = L, *sKp = L + SL, *sKKm = L + 2 * SL, *sRg = L + 3 * SL, *sBpT = L + 4 * SL, *sKpT = L + 5 * SL, *sKKmT = L + 6 * SL, *sVT = L + 7 * SL, *sNT = L + 8 * SL, *sArT = L + 9 * SL, *sNrT = L + 10 * SL;
    bf16_t *sX2 = sBp, *sTmT = sKp, *sWn = sKKm, *sU2n = sNT;
    const int tid = threadIdx.x, lane = tid & 63, w = tid >> 6, q4 = lane >> 4, l15 = lane & 15;
    float pld[8]; bf16_t pkk[8], pbv[8], pkp[8], prr[8], pvv[8];
#define RWP_LOAD(uu) do { const int c_ = (uu) % 68, h_ = ((uu) / 68) & 7, b_ = ((uu) / (68 * 8)) & 7, dir_ = (uu) / (68 * 64); \
        _Pragma("unroll") for (int tt = 0; tt < 8; ++tt) { const size_t o_ = (size_t)row_of(dir_, b_, c_ * 64 + w * 8 + tt) * 512 + h_ * 64 + lane; \
            pld[tt] = p.DEC[(size_t)dir_ * NT * 512 + o_]; pkk[tt] = p.KK[o_]; pbv[tt] = p.BV[o_]; pkp[tt] = p.KP[o_]; prr[tt] = p.RR[o_]; pvv[tt] = p.VV[o_]; } } while (0)
    if ((int)blockIdx.x < RW_NUNIT) RWP_LOAD((int)blockIdx.x);
    for (int u = blockIdx.x; u < RW_NUNIT; u += gridDim.x) {
        const int c = u % 68, h = (u / 68) & 7, b = (u / (68 * 8)) & 7, dir = u / (68 * 64);
        __syncthreads();
        {
            const int k = lane, part = w;
            float lcv[8], ldv[8], kkv[8], bvv[8], kpv[8], rv[8]; float lc = 0.f;
#pragma unroll
            for (int tt = 0; tt < 8; ++tt) {
                ldv[tt] = pld[tt]; kkv[tt] = bf2f(pkk[tt]); bvv[tt] = bf2f(pbv[tt]); kpv[tt] = bf2f(pkp[tt]); rv[tt] = bf2f(prr[tt]);
                lc += ldv[tt]; lcv[tt] = lc;
            }
            ptot[part * 64 + k] = lc;
            *(bf16x8*)(sVT + lane * 72 + w * 8) = pack8((f32x4){bf2f(pvv[0]), bf2f(pvv[1]), bf2f(pvv[2]), bf2f(pvv[3])}, (f32x4){bf2f(pvv[4]), bf2f(pvv[5]), bf2f(pvv[6]), bf2f(pvv[7])});
            __syncthreads();
            float off = 0.f, tot = 0.f;
#pragma unroll
            for (int pp = 0; pp < 8; ++pp) { const float tv = ptot[pp * 64 + k]; if (pp < part) off += tv; tot += tv; }
            if (part == 0) gcv[k] = __expf(tot);
            float xa[8], xb[8], xc[8];
#pragma unroll
            for (int tt = 0; tt < 8; ++tt) {
                const int j = part * 8 + tt; const float lw = lcv[tt] + off;
                const float eg = __expf(lw), ig = __expf(-lw), egm = __expf(lw - ldv[tt]);
                xa[tt] = kkv[tt] * egm; xb[tt] = bvv[tt] * ig; xc[tt] = kpv[tt] * ig;
                sKKm[j * 72 + k] = f2bf(xa[tt]); sBp[j * 72 + k] = f2bf(xb[tt]); sKp[j * 72 + k] = f2bf(xc[tt]); sRg[j * 72 + k] = f2bf(rv[tt] * eg);
            }
            *(bf16x8*)(sKKmT + k * 72 + part * 8) = pack8((f32x4){xa[0], xa[1], xa[2], xa[3]}, (f32x4){xa[4], xa[5], xa[6], xa[7]});
            *(bf16x8*)(sBpT + k * 72 + part * 8) = pack8((f32x4){xb[0], xb[1], xb[2], xb[3]}, (f32x4){xb[4], xb[5], xb[6], xb[7]});
            *(bf16x8*)(sKpT + k * 72 + part * 8) = pack8((f32x4){xc[0], xc[1], xc[2], xc[3]}, (f32x4){xc[4], xc[5], xc[6], xc[7]});
        }
        __syncthreads();
#pragma unroll
        for (int rep = 0; rep < 2; ++rep) {
            const int pos = w + rep * 8, tt_ = pos >> 2, jt_ = pos & 3;
            f32x4 aM = {0.f, 0.f, 0.f, 0.f}, aN = aM, aA = aM, aR = aM;
#pragma unroll
            for (int ks = 0; ks < 2; ++ks) {
                const bf16x8 fbp = *(const bf16x8*)(sBp + (jt_ * 16 + l15) * 72 + ks * 32 + q4 * 8), fkp = *(const bf16x8*)(sKp + (jt_ * 16 + l15) * 72 + ks * 32 + q4 * 8);
                const bf16x8 fkk = *(const bf16x8*)(sKKm + (tt_ * 16 + l15) * 72 + ks * 32 + q4 * 8), frg = *(const bf16x8*)(sRg + (tt_ * 16 + l15) * 72 + ks * 32 + q4 * 8);
                aM = __builtin_amdgcn_mfma_f32_16x16x32_bf16(fbp, fkk, aM, 0, 0, 0); aN = __builtin_amdgcn_mfma_f32_16x16x32_bf16(fkp, fkk, aN, 0, 0, 0);
                aA = __builtin_amdgcn_mfma_f32_16x16x32_bf16(fbp, frg, aA, 0, 0, 0); aR = __builtin_amdgcn_mfma_f32_16x16x32_bf16(fkp, frg, aR, 0, 0, 0);
            }
            const int t = tt_ * 16 + l15, j0 = jt_ * 16 + q4 * 4;
#pragma unroll
            for (int e = 0; e < 4; ++e) { const bool st = (j0 + e) < t, le = (j0 + e) <= t; aM[e] = st ? aM[e] : 0.f; aN[e] = st ? aN[e] : 0.f; aA[e] = le ? aA[e] : 0.f; aR[e] = le ? aR[e] : 0.f; }
#pragma unroll
            for (int e = 0; e < 4; ++e) MT[t * 68 + ((j0 + e) & 7) * 8 + ((j0 + e) >> 3)] = aM[e];
            u32x2 wv; wv.x = pk2(aN[0], aN[1]); wv.y = pk2(aN[2], aN[3]); *(u32x2*)(sNT + t * 72 + j0) = wv;
            wv.x = pk2(aA[0], aA[1]); wv.y = pk2(aA[2], aA[3]); *(u32x2*)(sArT + t * 72 + j0) = wv;
            wv.x = pk2(aR[0], aR[1]); wv.y = pk2(aR[2], aR[3]); *(u32x2*)(sNrT + t * 72 + j0) = wv;
        }
        __syncthreads();
        {
#pragma unroll
            for (int rep = 0; rep < 2; ++rep) {
                const int tile = w * 2 + rep, vt_ = tile >> 2, tt_ = tile & 3;
                f32x4 acc = {0.f, 0.f, 0.f, 0.f};
#pragma unroll
                for (int ks = 0; ks < 2; ++ks) {
                    const bf16x8 fa = *(const bf16x8*)(sNT + (tt_ * 16 + l15) * 72 + ks * 32 + q4 * 8), fb = *(const bf16x8*)(sVT + (vt_ * 16 + l15) * 72 + ks * 32 + q4 * 8);
                    acc = __builtin_amdgcn_mfma_f32_16x16x32_bf16(fa, fb, acc, 0, 0, 0);
                }
                u32x2 wv; wv.x = pk2(acc[0], acc[1]); wv.y = pk2(acc[2], acc[3]); *(u32x2*)(sX2 + (vt_ * 16 + l15) * 72 + tt_ * 16 + q4 * 4) = wv;
            }
            const int srow = w * 8 + (lane >> 3), sub = lane & 7;
            float tm8[8];
#pragma unroll
            for (int jj = 0; jj < 8; ++jj) tm8[jj] = 0.f;
#pragma unroll
            for (int tb = 0; tb < 8; ++tb) {
                f32x4 mA[8], mB[8];
#pragma unroll
                for (int e = 0; e < 8; ++e) { mA[e] = *(const f32x4*)(MT + (tb * 8 + e) * 68 + sub * 8); if (tb >= 4) mB[e] = *(const f32x4*)(MT + (tb * 8 + e) * 68 + sub * 8 + 4); else mB[e] = (f32x4){0.f, 0.f, 0.f, 0.f}; }
#pragma unroll
                for (int e = 0; e < 8; ++e) {
                    const int t = tb * 8 + e;
                    float part = tm8[0] * mA[e][0], part1 = 0.f;
                    if (t > 8) part1 = tm8[1] * mA[e][1];
                    if (t > 16) part += tm8[2] * mA[e][2];
                    if (t > 24) part1 += tm8[3] * mA[e][3];
                    if (t > 32) part += tm8[4] * mB[e][0];
                    if (t > 40) part1 += tm8[5] * mB[e][1];
                    if (t > 48) part += tm8[6] * mB[e][2];
                    if (t > 56) part1 += tm8[7] * mB[e][3];
                    part += part1;
                    part += __int_as_float(__builtin_amdgcn_update_dpp(0, __float_as_int(part), 0xB1, 0xF, 0xF, false));
                    part += __int_as_float(__builtin_amdgcn_update_dpp(0, __float_as_int(part), 0x4E, 0xF, 0xF, false));
                    part += __int_as_float(__builtin_amdgcn_update_dpp(0, __float_as_int(part), 0x141, 0xF, 0xF, false));
                    const float sacc = ((t == srow) ? 1.f : 0.f) - part;
                    if (sub == (t & 7)) { tm8[t >> 3] = sacc; sTmT[t * 72 + srow] = f2bf(sacc); }
                }
            }
        }
        __syncthreads();
#pragma unroll
        for (int rep = 0; rep < 4; ++rep) {
            const int tile = w * 4 + rep, it_ = tile >> 2, tt_ = tile & 3;
            const bf16_t* rhs = it_ < 4 ? sKKmT + (it_ * 16 + l15) * 72 : sX2 + ((it_ - 4) * 16 + l15) * 72;
            f32x4 acc = {0.f, 0.f, 0.f, 0.f};
#pragma unroll
            for (int ks = 0; ks < 2; ++ks) {
                const bf16x8 fa = *(const bf16x8*)(sTmT + (tt_ * 16 + l15) * 72 + ks * 32 + q4 * 8), fb = *(const bf16x8*)(rhs + ks * 32 + q4 * 8);
                acc = __builtin_amdgcn_mfma_f32_16x16x32_bf16(fa, fb, acc, 0, 0, 0);
            }
            bf16_t* dst = it_ < 4 ? sWn + (it_ * 16 + l15) * 72 : sU2n + ((it_ - 4) * 16 + l15) * 72;
            u32x2 wv; wv.x = pk2(-acc[0], -acc[1]); wv.y = pk2(-acc[2], -acc[3]); *(u32x2*)(dst + tt_ * 16 + q4 * 4) = wv;
        }
        __syncthreads();
        { const int un = u + (int)gridDim.x < RW_NUNIT ? u + (int)gridDim.x : u; RWP_LOAD(un); }
        asm volatile("" ::: "memory");
        {
            const int kind = w >> 1;
            bf16_t* GM = p.GMT + (size_t)u * 4096; bf16_t* QM = p.QMT + (size_t)u * 4096; bf16_t* HM = p.HMB + (size_t)u * 4096; bf16_t* OM = p.OMB + (size_t)u * 4096;
#pragma unroll 1
            for (int rep = 0; rep < 8; ++rep) {
                const int tile = (w & 1) * 8 + rep, rt_ = tile >> 2, ct_ = tile & 3;
                const bf16_t* bmat = (kind < 2) ? sBpT : sArT;
                const bf16_t* amat = (kind == 0 || kind == 2) ? sWn : sU2n;
                f32x4 acc = {0.f, 0.f, 0.f, 0.f};
                if (kind == 0 || kind == 2) {
#pragma unroll
                    for (int ks = 0; ks < 2; ++ks) {
                        const bf16x8 fa = *(const bf16x8*)(amat + (ct_ * 16 + l15) * 72 + ks * 32 + q4 * 8), fb = *(const bf16x8*)(bmat + (rt_ * 16 + l15) * 72 + ks * 32 + q4 * 8);
                        acc = __builtin_amdgcn_mfma_f32_16x16x32_bf16(fa, fb, acc, 0, 0, 0);
                    }
                    const int r = rt_ * 16 + l15, cc = ct_ * 16 + q4 * 4;
                    if (kind == 0) { const float g = gcv[r]; u32x2 wv; wv.x = pk2(g * ((cc == r ? 1.f : 0.f) + acc[0]), g * ((cc + 1 == r ? 1.f : 0.f) + acc[1])); wv.y = pk2(g * ((cc + 2 == r ? 1.f : 0.f) + acc[2]), g * ((cc + 3 == r ? 1.f : 0.f) + acc[3])); *(u32x2*)(GM + r * 64 + cc) = wv; }
                    else { const u32x2 rg = *(const u32x2*)(sRg + r * 72 + cc);
                        u32x2 wv; wv.x = pk2(acc[0] + __uint_as_float(rg.x << 16), acc[1] + __uint_as_float(rg.x & 0xffff0000u)); wv.y = pk2(acc[2] + __uint_as_float(rg.y << 16), acc[3] + __uint_as_float(rg.y & 0xffff0000u)); *(u32x2*)(QM + r * 64 + cc) = wv; }
                } else {
                    const bf16_t* b2 = (kind == 1) ? sKpT : sNrT;
#pragma unroll
                    for (int ks = 0; ks < 2; ++ks) {
                        const bf16x8 fa = *(const bf16x8*)(bmat + (rt_ * 16 + l15) * 72 + ks * 32 + q4 * 8), fb = *(const bf16x8*)(amat + (ct_ * 16 + l15) * 72 + ks * 32 + q4 * 8);
                        acc = __builtin_amdgcn_mfma_f32_16x16x32_bf16(fa, fb, acc, 0, 0, 0);
                        const bf16x8 fa2 = *(const bf16x8*)(b2 + (rt_ * 16 + l15) * 72 + ks * 32 + q4 * 8), fb2 = *(const bf16x8*)(sVT + (ct_ * 16 + l15) * 72 + ks * 32 + q4 * 8);
                        acc = __builtin_amdgcn_mfma_f32_16x16x32_bf16(fa2, fb2, acc, 0, 0, 0);
                    }
                    const int vv = ct_ * 16 + l15, r0 = rt_ * 16 + q4 * 4;
                    if (kind == 1) { const f32x4 g4 = *(const f32x4*)(gcv + r0); acc = acc * g4; }
                    u32x2 wv; wv.x = pk2(acc[0], acc[1]); wv.y = pk2(acc[2], acc[3]);
                    *(u32x2*)((kind == 1 ? HM : OM) + vv * 64 + r0) = wv;
                }
            }
        }
    }
}
#undef RWP_LOAD
__device__ __forceinline__ void phase_rwseq(const Params& p) {
    const int tid = threadIdx.x, lane = tid & 63, w = tid >> 6, q4 = lane >> 4, l15 = lane & 15;
    if (w >= 4) return;
    const int vs = w;
    for (int unit = blockIdx.x; unit < 128; unit += gridDim.x) {
        const int h = unit & 7, b = (unit >> 3) & 7, dir = unit >> 6;
        f32x4 Sacc[4];
#pragma unroll
        for (int t = 0; t < 4; ++t) Sacc[t] = (f32x4){0.f, 0.f, 0.f, 0.f};
        u32x2 gA[4][2][2], qA[4][2][2], gB[4][2][2], qB[4][2][2]; u32x2 hA[4], oA[4], hB[4], oB[4];
#define RWS_LOAD(cc, G_, Q_, H_, O_) do { const size_t cu = (size_t)unit * 68 + (cc); \
        const bf16_t* GM = p.GMT + cu * 4096; const bf16_t* HM = p.HMB + cu * 4096; \
        _Pragma("unroll") for (int kt_ = 0; kt_ < 4; ++kt_) { _Pragma("unroll") for (int ks = 0; ks < 2; ++ks) { \
            G_[kt_][ks][0] = *(const u32x2*)(GM + (kt_ * 16 + l15) * 64 + ks * 32 + q4 * 4); G_[kt_][ks][1] = *(const u32x2*)(GM + (kt_ * 16 + l15) * 64 + ks * 32 + 16 + q4 * 4); } \
            H_[kt_] = *(const u32x2*)(HM + (vs * 16 + l15) * 64 + kt_ * 16 + q4 * 4); } \
        if ((cc) >= 4) { const bf16_t* QM = p.QMT + cu * 4096; const bf16_t* OM = p.OMB + cu * 4096; \
        _Pragma("unroll") for (int kt_ = 0; kt_ < 4; ++kt_) { _Pragma("unroll") for (int ks = 0; ks < 2; ++ks) { \
            Q_[kt_][ks][0] = *(const u32x2*)(QM + (kt_ * 16 + l15) * 64 + ks * 32 + q4 * 4); Q_[kt_][ks][1] = *(const u32x2*)(QM + (kt_ * 16 + l15) * 64 + ks * 32 + 16 + q4 * 4); } \
            O_[kt_] = *(const u32x2*)(OM + (vs * 16 + l15) * 64 + kt_ * 16 + q4 * 4); } } } while (0)
#define RWS_COMP(cc, G_, Q_, H_, O_) do { bf16x8 sb[2]; \
        _Pragma("unroll") for (int ks = 0; ks < 2; ++ks) sb[ks] = pack8(Sacc[2 * ks], Sacc[2 * ks + 1]); \
        if ((cc) >= 4) { _Pragma("unroll") for (int tt_ = 0; tt_ < 4; ++tt_) { f32x4 acc = {__uint_as_float(O_[tt_].x << 16), __uint_as_float(O_[tt_].x & 0xffff0000u), __uint_as_float(O_[tt_].y << 16), __uint_as_float(O_[tt_].y & 0xffff0000u)}; \
            _Pragma("unroll") for (int ks = 0; ks < 2; ++ks) { u32x4 a4; a4.x = Q_[tt_][ks][0].x; a4.y = Q_[tt_][ks][0].y; a4.z = Q_[tt_][ks][1].x; a4.w = Q_[tt_][ks][1].y; \
                acc = __builtin_amdgcn_mfma_f32_16x16x32_bf16(__builtin_bit_cast(bf16x8, a4), sb[ks], acc, 0, 0, 0); } \
            _Pragma("unroll") for (int e = 0; e < 4; ++e) { const int row = row_of(dir, b, (cc) * 64 + tt_ * 16 + q4 * 4 + e); p.O[((size_t)dir * NT + row) * 512 + h * 64 + vs * 16 + l15] = acc[e]; } } } \
        _Pragma("unroll") for (int kt_ = 0; kt_ < 4; ++kt_) { f32x4 acc = {__uint_as_float(H_[kt_].x << 16), __uint_as_float(H_[kt_].x & 0xffff0000u), __uint_as_float(H_[kt_].y << 16), __uint_as_float(H_[kt_].y & 0xffff0000u)}; \
            _Pragma("unroll") for (int ks = 0; ks < 2; ++ks) { u32x4 a4; a4.x = G_[kt_][ks][0].x; a4.y = G_[kt_][ks][0].y; a4.z = G_[kt_][ks][1].x; a4.w = G_[kt_][ks][1].y; \
                acc = __builtin_amdgcn_mfma_f32_16x16x32_bf16(__builtin_bit_cast(bf16x8, a4), sb[ks], acc, 0, 0, 0); } \
            Sacc[kt_] = acc; } } while (0)
        RWS_LOAD(0, gA, qA, hA, oA);
#pragma unroll 1
        for (int c = 0; c < 68; c += 2) {
            RWS_LOAD(c + 1, gB, qB, hB, oB);
            RWS_COMP(c, gA, qA, hA, oA);
            if (c + 2 < 68) RWS_LOAD(c + 2, gA, qA, hA, oA);
            RWS_COMP(c + 1, gB, qB, hB, oB);
        }
#undef RWS_LOAD
#undef RWS_COMP
    }
}
__device__ __forceinline__ void phase_readout1(const Params& p) {
    const int lane = threadIdx.x & 63, h = __builtin_amdgcn_readfirstlane(threadIdx.x >> 6);
    const float lg = p.rw_ln_g[h * 64 + lane], lb = p.rw_ln_b[h * 64 + lane], rk = p.rw_r_k[h * 64 + lane];
    float n0[4], n1[4]; bf16_t nr[4], nk[4], nvv[4], ngt[4];
#define RO1_LOAD(bi) do { _Pragma("unroll") for (int j = 0; j < 4; ++j) { const size_t o_ = (size_t)(NCTX + (bi) * 4 + j) * 512 + h * 64 + lane; \
        n0[j] = p.O[o_]; n1[j] = p.O[(size_t)NT * 512 + o_]; nr[j] = p.RR[o_]; nk[j] = p.KP[o_]; nvv[j] = p.VV[o_]; ngt[j] = p.GT[o_]; } } while (0)
    if ((int)blockIdx.x < NLAT / 4) RO1_LOAD((int)blockIdx.x);
    for (int bi = blockIdx.x; bi < NLAT / 4; bi += gridDim.x) {
        float c0[4], c1[4]; bf16_t cr[4], ck[4], cvv[4], cgt[4];
#pragma unroll
        for (int j = 0; j < 4; ++j) { c0[j] = n0[j]; c1[j] = n1[j]; cr[j] = nr[j]; ck[j] = nk[j]; cvv[j] = nvv[j]; cgt[j] = ngt[j]; }
        if (bi + (int)gridDim.x < NLAT / 4) RO1_LOAD(bi + (int)gridDim.x);
        asm volatile("" ::: "memory");
#pragma unroll
        for (int j = 0; j < 4; ++j) {
            const float ov = c0[j] + c1[j];
            const float mean = wave_sum(ov) * (1.f / 64.f); const float d = ov - mean;
            const float var = wave_sum(d * d) * (1.f / 64.f);
            const float on = d * rsqrtf(var + 64e-5f) * lg + lb;
            const float bonus = wave_sum(bf2f(cr[j]) * bf2f(ck[j]) * rk) * bf2f(cvv[j]);
            p.Y[(size_t)(NCTX + bi * 4 + j) * DM + 512 + h * 64 + lane] = f2bf((on + bonus) * bf2f(cgt[j]));
        }
        asm volatile("" ::: "memory");
    }
#undef RO1_LOAD
}

#ifdef PROBE_BUF
__global__ void __launch_bounds__(NTHR) k_probe(Params p) { for (size_t i = (size_t)blockIdx.x * NTHR + threadIdx.x; i < (size_t)NLAT * DM; i += (size_t)gridDim.x * NTHR) {
        float z;
#if PROBE_KIND == 1
        const unsigned q = ((unsigned)i >> 1); z = 0.f; if (q < (unsigned)(NT * 8)) z = (i & 1) ? p.GATE[q] : (float)p.EIDX[q];
#elif PROBE_KIND == 2
        const unsigned q = (unsigned)i; const unsigned ts = q >> 8; z = bf2f(p.ACT[(size_t)p.TOKSLOT[ts] * 256 + (q & 255)]);
#elif PROBE_KIND == 4
        const unsigned q = (unsigned)i; const unsigned ts = q >> 10; z = bf2f(p.YS[((size_t)p.META[0] * 256 + ts) * 1024 + (q & 1023)]);
#elif PROBE_KIND == 6
        const unsigned q = (unsigned)i; const unsigned ts = q >> 8; z = 0.f; if (ts < NT) z = bf2f(p.ACT[((size_t)p.META[0] * 256 + ts) * 256 + (q & 255)]);
#elif PROBE_KIND == 7
        const unsigned q = (unsigned)i; z = 0.f; if (q < 2u * 256u * 1024u) z = p.sh_w2[q]; else if (q < 2u * 256u * 1024u + 2u * 1024u * 512u) z = p.sh_w13[q - 2u * 256u * 1024u];
#elif PROBE_KIND == 5
        const unsigned q = (unsigned)i; const unsigned ts = (q >> 10) * 8 + 3; z = bf2f(p.YS[(size_t)p.TOKSLOT[ts] * 1024 + (q & 1023)]);
#elif PROBE_KIND == 3
        const unsigned q = (unsigned)i; const unsigned ts = q >> 8; z = bf2f(p.YS[(size_t)p.TOKSLOT[ts] * 1024 + (q & 255)]);
#else
        const float* src = (const float*)p.PROBE_BUF; z = src[i + PROBE_OFF];
#endif
        if (!(fabsf(z) < 1e4f)) z = 100.f; p.out[i] = z; } }
#endif

#define XB_TMO      128
#define XB_XCNT(j)  (256  + 64 * (j))
#define XB_XSUB(j)  (1280 + 64 * (j))
#define XB_XGEN(j)  (2304 + 64 * (j))
#define XB_TOP      3328
#define XB_TOPGEN   3392
#define XCD_BAR_WORDS 3456
#define XB_SPIN_CAP (1u << 18)
#define LAS __attribute__((address_space(3)))

__device__ __forceinline__ unsigned xb_ld(unsigned* p)              { return __hip_atomic_load(p, __ATOMIC_RELAXED, __HIP_MEMORY_SCOPE_AGENT); }
__device__ __forceinline__ unsigned xb_add(unsigned* p, unsigned v) { return __hip_atomic_fetch_add(p, v, __ATOMIC_RELAXED, __HIP_MEMORY_SCOPE_AGENT); }
__device__ __forceinline__ unsigned xb_xcc_id() { return (unsigned)__builtin_amdgcn_s_getreg((3 << 11) | 20) & 0xFu; }
#define XB_SPIN(cond, bar) do { unsigned _sp = 0; while (cond) { __builtin_amdgcn_s_sleep(1); \
    if ((++_sp & 255u) == 0u) { if (xb_ld(&(bar)[XB_TMO])) break; if (_sp > XB_SPIN_CAP) { atomicAdd(&(bar)[XB_TMO], 1u); break; } } } } while (0)

struct XcdBarrier {
    unsigned* bar; unsigned x;
    volatile LAS unsigned* st;
};

__device__ __forceinline__ XcdBarrier xcd_barrier_post(unsigned* bar, volatile LAS unsigned* st) {
    XcdBarrier b; b.bar = bar; b.x = xb_xcc_id(); b.st = st;
    if (threadIdx.x == 0) (void)xb_add(&bar[XB_XCNT(b.x)], 1u);
    return b;
}
__device__ __forceinline__ void xcd_barrier_complete(unsigned* bar, unsigned x, unsigned& nloc, unsigned& nx) {
    const unsigned G = gridDim.x * gridDim.y * gridDim.z;
    unsigned sum, cnt, mine, sp = 0u;
    for (;;) {
        sum = 0u; cnt = 0u; mine = 0u;
#pragma unroll
        for (unsigned j = 0; j < 16; ++j) { const unsigned c = xb_ld(&bar[XB_XCNT(j)]); sum += c; cnt += (c > 0u) ? 1u : 0u; mine = (j == x) ? c : mine; }
        if (sum == G) break;
        __builtin_amdgcn_s_sleep(1);
        if ((++sp & 255u) == 0u) { if (xb_ld(&bar[XB_TMO])) break; if (sp > XB_SPIN_CAP) { atomicAdd(&bar[XB_TMO], 1u); break; } }
    }
    nloc = mine > 0u ? mine : 1u; nx = cnt > 0u ? cnt : 1u;
}

__device__ __forceinline__ void xcd_barrier(const XcdBarrier& b) {
    asm volatile("s_waitcnt vmcnt(0)" ::: "memory");
    __syncthreads();
    if (threadIdx.x == 0) {
        unsigned* bar = b.bar;
        __builtin_amdgcn_s_waitcnt(0);
        unsigned nloc = b.st[0], nx = b.st[1];
        if (nloc == 0u) { xcd_barrier_complete(bar, b.x, nloc, nx); b.st[0] = nloc; b.st[1] = nx; }
        const unsigned old = xb_add(&bar[XB_XSUB(b.x)], 1u);
        const unsigned gen = old / nloc;
        if (old + 1u == (gen + 1u) * nloc) {
            __builtin_amdgcn_fence(__ATOMIC_RELEASE, "agent");
            asm volatile("s_waitcnt vmcnt(0)" ::: "memory");
            const unsigned og = xb_add(&bar[XB_TOP], 1u);
            const unsigned tg = og / nx;
            if (og + 1u == (tg + 1u) * nx) xb_add(&bar[XB_TOPGEN], 1u);
            else XB_SPIN(xb_ld(&bar[XB_TOPGEN]) == tg, bar);
            __builtin_amdgcn_fence(__ATOMIC_ACQUIRE, "agent");
            xb_add(&bar[XB_XGEN(b.x)], 1u);
            asm volatile("s_waitcnt vmcnt(0)" ::: "memory");
        } else {
            XB_SPIN(xb_ld(&bar[XB_XGEN(b.x)]) == gen, bar);
            __builtin_amdgcn_fence(__ATOMIC_ACQUIRE, "agent");
            asm volatile("s_waitcnt vmcnt(0)" ::: "memory");
        }
    }
    __syncthreads();
}


__global__ void __launch_bounds__(NTHR, 2) k_fwd(Params p_, int lo, int hi) {
#if defined(__HIP_DEVICE_COMPILE__)
    typedef const __attribute__((address_space(4))) Params* KP;
    const KP kp0 = (KP)__builtin_amdgcn_kernarg_segment_ptr();
#define LOADP KP kq = kp0; asm volatile("" : "+s"(kq)); Params p; __builtin_memcpy(&p, kq, sizeof(Params));
#else
#define LOADP const Params& p = p_;
#endif
    extern __shared__ __attribute__((aligned(16))) unsigned char lds[];
    if (threadIdx.x < 4) ((unsigned*)(lds + 147456))[threadIdx.x] = 0u;
    __syncthreads();
    XcdBarrier bar; bar.bar = nullptr; bar.x = 0; bar.st = nullptr;
#if defined(__HIP_DEVICE_COMPILE__)
    if (hi - lo > 1) bar = xcd_barrier_post((unsigned*)kp0->BAR, (volatile LAS unsigned*)(lds + 147456));
#endif
#define SEAM(k) if (lo <= (k) && (k) + 1 < hi) xcd_barrier(bar);
#ifndef ONLY
#define ONLY -1
#endif
#define IN(k) ((ONLY < 0 || ONLY == (k)) && lo <= (k) && (k) < hi)
#ifndef DUPMASK
#define DUPMASK 0u
#endif
#define PH(k, ...) if (IN(k)) { LOADP __VA_ARGS__ } SEAM(k) if ((DUPMASK >> (k)) & 1u) { xcd_barrier(bar); if (IN(k)) { LOADP __VA_ARGS__ } xcd_barrier(bar); }
    PH(0, if (blockIdx.x == 0) { for (int e = threadIdx.x; e < 512; e += NTHR) p.CNT[e] = 0; if (threadIdx.x < 128) p.META[threadIdx.x] = 0; } phase_mod(p, lds); phase_filt(p, lds); phase_convw(p, lds, 0, blockIdx.x, gridDim.x);)
    PH(2, phase_filtfft(p, lds); phase_hin0(p);)
    PH(1, phase_inproj(p, lds, 0);)
    PH(3, phase_rec0(p, lds);)
    PH(4, phase_readout0(p);)
    PH(5, phase_outproj(p, lds, 0);)
    PH(6, phase_ln1(p, 0);)
    PH(7, phase_router(p, lds, 0);)
    PH(8, phase_select(p, 0);)
    PH(9, phase_offsets(p, lds, 0);)
    PH(10, phase_moe1(p, lds, 0);)
    PH(11, phase_moe2(p, lds, 0);)
    PH(12, phase_combine(p, 0);)
    PH(13, phase_inproj(p, lds, 1);)
    PH(14, phase_shortconv(p, lds);)
    PH(27, phase_rwstreams(p, lds);)
    PH(15, phase_hyena(p, lds);)
    PH(16, phase_rwprep(p, lds);)
    PH(17, if (blockIdx.x >= 128 && gridDim.x > 128) phase_convw(p, lds, 1, blockIdx.x - 128, gridDim.x - 128); else { phase_rwseq(p); if (gridDim.x <= 128) phase_convw(p, lds, 1, blockIdx.x, gridDim.x); })
    PH(18, phase_readout1(p); phase_zt2y(p, lds);)
    PH(19, phase_outproj(p, lds, 1);)
    PH(20, phase_ln1(p, 1);)
    PH(21, phase_router(p, lds, 1);)
    PH(22, phase_select(p, 1);)
    PH(23, phase_offsets(p, lds, 1);)
    PH(24, phase_moe1(p, lds, 1);)
    PH(25, phase_moe2(p, lds, 1);)
    PH(26, phase_combine(p, 1);)
#undef IN
}
#define N_PHASES 28
#define LDS_BYTES (147456 + 64)

extern "C" void kernel_launch(void* const* d_in, const int* in_sizes, int n_in, void* d_out, int out_size, void* d_ws, size_t ws_size, hipStream_t stream) {
    Params p;
    memset(&p, 0, sizeof(p));
    if (n_in != 45) { fprintf(stderr, "kernel_launch: expected 45 inputs, got %d\n", n_in); return; }
    const float** pin = (const float**)&p;
    for (int i = 0; i < 45; ++i) pin[i] = (const float*)d_in[i];
    p.out = (float*)d_out;
    size_t off = 0;
    unsigned char* ws = (unsigned char*)d_ws;
    auto take = [&](size_t bytes) { void* r = ws + off; off += (bytes + 255) & ~(size_t)255; return r; };
    p.BAR = (unsigned*)take(16384);
    p.CNT = (int*)take(2 * 256 * 4);
    p.META = (int*)take(2 * 64 * 4);
    const size_t zero_bytes = off;
    p.MOD = (float*)take((size_t)2 * 9 * 6144 * 4);
    p.G = (float*)take((size_t)2 * 8192 * 512 * 4);
    p.P = (bf16_t*)take((size_t)NT * EVW * 4);
    p.LA = nullptr;
    p.O = (float*)take((size_t)2 * NT * 1024 * 4);
    p.Y = (bf16_t*)take((size_t)NT * 1024 * 2);
    p.PRE = (float*)take((size_t)NT * 1024 * 4);
    p.X1 = (float*)take((size_t)NT * 1024 * 4);
    p.U = (bf16_t*)take((size_t)NT * 1024 * 2);
    p.LOGITS = (float*)take((size_t)NT * 256 * 4);
    p.EIDX = (int*)take((size_t)NT * 8 * 4); p.GATE = (float*)take((size_t)NT * 8 * 4); p.POS = (int*)take((size_t)NT * 8 * 4); p.TOKSLOT = (int*)take((size_t)NT * 8 * 4);
    p.TILE_E = (int*)take(2048 * 4);
    p.SLOT_TOK = (int*)take((size_t)MAXSLOT * 4); p.SLOT_GATE = (float*)take((size_t)MAXSLOT * 4);
    unsigned char* regA = (unsigned char*)take((size_t)MAXSLOT * 1024 * 2 + (size_t)MAXSLOT * 256 * 2);
    p.YS = (bf16_t*)regA; p.ACT = (bf16_t*)(regA + (size_t)MAXSLOT * 1024 * 2);
    { size_t o2 = 0; auto sub = [&](size_t bytes) { void* r = regA + o2; o2 += (bytes + 255) & ~(size_t)255; return r; };
      p.UH = (float*)sub((size_t)NLAT * 1536 * 4); p.Z1 = (float*)sub((size_t)NLAT * 512 * 4);
      p.RR = (bf16_t*)sub((size_t)NT * 512 * 2); p.KP = (bf16_t*)sub((size_t)NT * 512 * 2); p.VV = (bf16_t*)sub((size_t)NT * 512 * 2);
      p.KK = (bf16_t*)sub((size_t)NT * 512 * 2); p.BV = (bf16_t*)sub((size_t)NT * 512 * 2); p.GT = (bf16_t*)sub((size_t)NT * 512 * 2);
      p.DEC = (float*)sub((size_t)2 * NT * 512 * 4);
      if (o2 > (size_t)MAXSLOT * 1024 * 2 + (size_t)MAXSLOT * 256 * 2) { fprintf(stderr, "kernel_launch: region A overflow\n"); return; } }
    { unsigned char* rp = (unsigned char*)p.P; p.GMT = (bf16_t*)rp; p.QMT = (bf16_t*)(rp + (size_t)RW_NUNIT * 4096 * 2); p.HMB = (bf16_t*)(rp + (size_t)RW_NUNIT * 4096 * 4); p.OMB = (bf16_t*)(rp + (size_t)RW_NUNIT * 4096 * 6); }
    p.X2 = (float*)take((size_t)NT * 1024 * 4);
    p.FF = (f32x2_p)take((size_t)2 * 512 * 8192 * 8);
    p.HIN = (bf16_t*)take((size_t)NT * 1024 * 2);
    p.WT_EVIN = (bf16_t*)take((size_t)4352 * 1024 * 2); p.WT_EVOUT = (bf16_t*)take((size_t)1024 * 1024 * 2);
    p.WT_ODIN = (bf16_t*)take((size_t)3584 * 1024 * 2); p.WT_ODOUT = (bf16_t*)take((size_t)1024 * 1024 * 2);
    p.WT_ROUT = (bf16_t*)take((size_t)2 * 256 * 1024 * 2); p.WT_SH13 = (bf16_t*)take((size_t)2 * 512 * 1024 * 2); p.WT_SH2 = (bf16_t*)take((size_t)2 * 1024 * 256 * 2);
    p.WT_RWF = (bf16_t*)take(512 * 64 * 2); p.WT_RWB = (bf16_t*)take(512 * 64 * 2); p.WT_RWA = (bf16_t*)take(512 * 64 * 2); p.WT_RWG = (bf16_t*)take(512 * 128 * 2);
    p.WT_W13 = (bf16_t*)take((size_t)2 * 256 * 512 * 1024 * 2); p.WT_W2 = (bf16_t*)take((size_t)2 * 256 * 1024 * 256 * 2);
    if (off > ws_size) { fprintf(stderr, "kernel_launch: workspace too small: need %zu, have %zu\n", off, ws_size); return; }
    static bool attr_done = false;
    if (!attr_done) { (void)hipFuncSetAttribute((const void*)k_fwd, hipFuncAttributeMaxDynamicSharedMemorySize, LDS_BYTES); attr_done = true; }
    (void)hipMemsetAsync(d_ws, 0, zero_bytes, stream);
#ifdef PROBE_BUF
    for (int ph = 0; ph <= PROBE_UPTO; ++ph) hipLaunchKernelGGL(k_fwd, dim3(256), dim3(NTHR), LDS_BYTES, stream, p, ph, ph + 1);
    hipLaunchKernelGGL(k_fwd, dim3(256), dim3(NTHR), LDS_BYTES, stream, p, 98, 99);
    hipLaunchKernelGGL(k_fwd, dim3(256), dim3(NTHR), LDS_BYTES, stream, p, 98, 99);
    hipLaunchKernelGGL(k_probe, dim3(1024), dim3(NTHR), 0, stream, p);
#else
#ifdef MULTI_LAUNCH
    for (int ph = 0; ph < N_PHASES; ++ph) {
        hipLaunchKernelGGL(k_fwd, dim3(256), dim3(NTHR), LDS_BYTES, stream, p, ph, ph + 1);
    }
#else
    static int grid = 0;
    if (grid == 0) {
        int dev = 0, cus = 0, per_cu = 0;
        (void)hipGetDevice(&dev); (void)hipDeviceGetAttribute(&cus, hipDeviceAttributeMultiprocessorCount, dev);
        if (hipOccupancyMaxActiveBlocksPerMultiprocessor(&per_cu, (const void*)k_fwd, NTHR, LDS_BYTES) != hipSuccess || per_cu < 1) { fprintf(stderr, "kernel_launch: occupancy query says %d blocks per CU\n", per_cu); per_cu = 1; }
        (void)hipGetLastError();
        grid = cus > 0 ? cus : 256;
    }
    hipLaunchKernelGGL(k_fwd, dim3(grid), dim3(NTHR), LDS_BYTES, stream, p, 0, N_PHASES);
#endif
#endif
}
```

```cpp
#include <hip/hip_runtime.h>
#include <stdint.h>
#include <stdio.h>
#include <string.h>

typedef unsigned short bf16_t;
typedef short bf16x8 __attribute__((ext_vector_type(8)));
typedef float f32x4 __attribute__((ext_vector_type(4)));
typedef unsigned u32x4 __attribute__((ext_vector_type(4)));
typedef unsigned u32x2 __attribute__((ext_vector_type(2)));

#define NTHR 512
#define DM 1024
#define NB 8
#define SEQ 4096
#define CTXL 256
#define NCTX (NB * CTXL)
#define NLAT (NB * SEQ)
#define NT (NCTX + NLAT)
#define EVW 4128
#define ODW 3392
#define MAXSLOT 378880
#define DN_ALPHA 1.41421356237f
#define NPHASE 40

typedef float __attribute__((ext_vector_type(2)))* f32x2_p;
struct Params {
    const float *x, *c, *ctx, *c_ctx, *mod_w, *mod_b, *ln1_g, *ln1_b, *ln2_g, *ln2_b;
    const float *ev_w_in, *ev_w_out, *gla_gate_w2, *gla_gate_b, *gla_norm_g, *hg_lb_logits, *hg_norm_g;
    const float *od_w_in, *od_w_out, *hy_conv_w, *hy_conv_b, *hy_ffn_w1, *hy_ffn_b1, *hy_ffn_w2, *hy_ffn_b2, *hy_ffn_w3, *hy_sin_freq, *hy_bias;
    const float *rw_mu, *rw_w0, *rw_w2, *rw_a0, *rw_a2, *rw_g2, *rw_k_k, *rw_k_a, *rw_r_k, *rw_ln_g, *rw_ln_b;
    const float *router_w, *router_bias, *exp_w13, *exp_w2, *sh_w13, *sh_w2;
    float* out;
    float* MOD;
    float* G;
    bf16_t* P;
    float* LA;
    bf16_t* O;
    bf16_t* Y;
    bf16_t* PRE;
    bf16_t* X1;
    bf16_t* U;
    float* LOGITS;
    int* EIDX; float* GATE; int* POS; int* TOKSLOT;
    int* CNT;
    int* META;
    int* TILE_E;
    int* SLOT_TOK; float* SLOT_GATE;
    bf16_t* ACT;
    bf16_t* YS;
    bf16_t* X2;
    f32x2_p FF;
    bf16_t* UH;
    bf16_t* Z1;
    bf16_t *RR, *KP, *VV, *KK, *BV, *GT;
    bf16_t* DEC;
    bf16_t *GMT, *QMT, *HMB, *OMB;
    bf16_t* HIN;
    bf16_t *WT_RWF, *WT_RWB, *WT_RWA, *WT_RWG;
    bf16_t *WT_EVIN, *WT_EVOUT, *WT_ODIN, *WT_ODOUT, *WT_ROUT, *WT_SH13, *WT_SH2, *WT_W13, *WT_W2;
    unsigned* BAR;
};

typedef float f32x2_t __attribute__((ext_vector_type(2)));
typedef __bf16 bf16x2_t __attribute__((ext_vector_type(2)));
__device__ __forceinline__ unsigned pk2(float lo, float hi) { const f32x2_t v = {lo, hi}; return __builtin_bit_cast(unsigned, __builtin_convertvector(v, bf16x2_t)); }
__device__ __forceinline__ bf16x8 pack8(f32x4 a, f32x4 b) { u32x4 w; w.x = pk2(a[0], a[1]); w.y = pk2(a[2], a[3]); w.z = pk2(b[0], b[1]); w.w = pk2(b[2], b[3]); return __builtin_bit_cast(bf16x8, w); }
__device__ __forceinline__ float bf2f(bf16_t h) { return __uint_as_float((unsigned)h << 16); }
__device__ __forceinline__ f32x4 bf4_to_f32(u32x2 w) { return (f32x4){__uint_as_float(w.x << 16), __uint_as_float(w.x & 0xffff0000u), __uint_as_float(w.y << 16), __uint_as_float(w.y & 0xffff0000u)}; }
__device__ __forceinline__ u32x2 f32_to_bf4(f32x4 v) { u32x2 w; w.x = pk2(v[0], v[1]); w.y = pk2(v[2], v[3]); return w; }
__device__ __forceinline__ bf16_t f2bf(float f) { return (bf16_t)(pk2(f, 0.f) & 0xffffu); }
__device__ __forceinline__ float sigmoid_f(float x) { return 1.f / (1.f + expf(-x)); }
__device__ __forceinline__ float silu_f(float x) { return x / (1.f + expf(-x)); }
__device__ __forceinline__ float logsigmoid_f(float x) { return x >= 0.f ? -log1pf(expf(-x)) : x - log1pf(expf(x)); }
#define DPPF(v, ctrl, rmask) __int_as_float(__builtin_amdgcn_update_dpp(0, __float_as_int(v), (ctrl), (rmask), 0xF, false))
__device__ __forceinline__ float wave_sum(float v) {
    v += DPPF(v, 0xB1, 0xF); v += DPPF(v, 0x4E, 0xF); v += DPPF(v, 0x141, 0xF); v += DPPF(v, 0x140, 0xF);
    v += DPPF(v, 0x142, 0xA); v += DPPF(v, 0x143, 0xC);
    return __int_as_float(__builtin_amdgcn_readlane(__float_as_int(v), 63));
}
__device__ __forceinline__ float wave_max(float v) {
    const float NEGI = -__builtin_inff();
#define DPPM(v, ctrl, rmask) __int_as_float(__builtin_amdgcn_update_dpp(__float_as_int(NEGI), __float_as_int(v), (ctrl), (rmask), 0xF, false))
    v = fmaxf(v, DPPM(v, 0xB1, 0xF)); v = fmaxf(v, DPPM(v, 0x4E, 0xF)); v = fmaxf(v, DPPM(v, 0x141, 0xF)); v = fmaxf(v, DPPM(v, 0x140, 0xF));
    v = fmaxf(v, DPPM(v, 0x142, 0xA)); v = fmaxf(v, DPPM(v, 0x143, 0xC));
#undef DPPM
    return __int_as_float(__builtin_amdgcn_readlane(__float_as_int(v), 63));
}
__device__ __forceinline__ int row_of(int dir, int b, int s) {
    if (s < CTXL) { const int pos = dir ? (CTXL - 1 - s) : s; return b * CTXL + pos; }
    const int q = s - CTXL; const int pos = dir ? (SEQ - 1 - q) : q; return NCTX + b * SEQ + pos;
}
__device__ __forceinline__ int row_mod(int r) { return r < NCTX ? 8 : ((r - NCTX) >> 12); }
__device__ __forceinline__ const float* xin_row(const Params& p, int layer, int r) {
    return r < NCTX ? p.ctx + (size_t)r * DM : p.x + (size_t)(r - NCTX) * DM;
}

namespace mg8 {
#define MG_LAS __attribute__((address_space(3)))
constexpr int BM = 256, BK = 64, HALF = 128, HTB = HALF * BK * 2, STAGE_BYTES = 8 * HTB, NXCD = 8, WGM = 8;
__host__ __device__ __forceinline__ int lds_byte(int r, int c) { const int st = (r >> 4) * 2 + (c >> 5), rr = r & 15, cc = c & 31, ob = rr * 64 + cc * 2; return st * 1024 + (ob ^ (((ob >> 9) & 1) << 5)); }
__host__ __device__ __forceinline__ void stage_rc(int b, int& R, int& C) { const int st = b / 1024, sb = b % 1024, swz = sb ^ (((sb >> 9) & 1) << 5); R = (st >> 1) * 16 + swz / 64; C = (st & 1) * 32 + (swz % 64) / 2; }
__host__ __device__ __forceinline__ int perm32(int rho) { const int n = rho >> 4, i = rho & 15; return 8 * (i >> 2) + 4 * n + (i & 3); }
struct Unit { int pm, pn; const char* A; const char* B; const int* gidx; };
__device__ __forceinline__ int xcd_remap(int wgid, int nwg) { const int q = nwg / NXCD, r = nwg % NXCD, xcd = wgid % NXCD, off = wgid / NXCD; return (xcd < r ? xcd * (q + 1) : r * (q + 1) + (xcd - r) * q) + off; }
struct DenseOrder {
    int nM, nN, nwg, G, c; const char* A; const char* Bt; size_t tstep;
    __device__ void init(const bf16_t* A_, const bf16_t* Bt_, int M, int N, int K, int G_, int c_) { nM = M / BM; nN = N / BM; nwg = nM * nN; G = G_; c = c_; A = (const char*)A_; Bt = (const char*)Bt_; tstep = (size_t)BM * K * 2; }
    __device__ bool next(int i, Unit& u) const {
        const long L = (long)i * G + c; if (L >= nwg) return false;
        const int wgid = xcd_remap((int)L, nwg);
        const int nig = WGM * nN, gid = wgid / nig, fm = gid * WGM, gsz = (nM - fm) < WGM ? (nM - fm) : WGM;
        u.pm = fm + ((wgid % nig) % gsz); u.pn = (wgid % nig) / gsz; u.A = A + (size_t)u.pm * tstep; u.B = Bt + (size_t)u.pn * tstep; u.gidx = nullptr; return true;
    }
};
struct MoeOrder {
    int ntr, npn, nwg, G, c, K, rbase; bool gather; const char* A; const char* Wexp; size_t wstride; const char* Wsh; const int* tile_e; const int* slot_tok;
    __device__ bool next(int i, Unit& u) const {
        const long L = (long)i * G + c; if (L >= nwg) return false;
        const int wv = xcd_remap((int)L, nwg); const int tile = wv / npn, pn = wv % npn; const size_t tstep = (size_t)BM * K * 2;
        u.pm = tile; u.pn = pn; u.gidx = nullptr;
        if (tile < ntr) { const int e = tile_e[tile]; u.B = Wexp + (size_t)e * wstride + (size_t)pn * tstep; if (gather) { u.A = A; u.gidx = slot_tok + tile * 256; } else u.A = A + (size_t)tile * tstep; }
        else { u.B = Wsh + (size_t)pn * tstep; u.A = gather ? A + (size_t)(rbase + (tile - ntr) * 256) * K * 2 : A + (size_t)tile * tstep; }
        return true;
    }
};
template <class Epi, class Sched, bool GATHER>
__device__ __forceinline__ void gemm_phase(MG_LAS unsigned char* lds, const int K, const Sched& S, const Epi& E) {
    const int tid = threadIdx.x, wid = __builtin_amdgcn_readfirstlane(tid >> 6), lane = tid & 63, wr = wid >> 2, wc = wid & 3, fr = lane & 15, fq = lane >> 4;
    const int nt = K / BK;
    int RR[2], CC[2]; unsigned voffB[2], vA[2][2], vN[2][2];
#pragma unroll
    for (int i = 0; i < 2; ++i) { int R, C; stage_rc(tid * 16 + i * 8192, R, C); RR[i] = R; CC[i] = C; const int Rb = Epi::PERM ? ((R & ~31) + perm32(R & 31)) : R; voffB[i] = (unsigned)(Rb * K + C) * 2u; }
#define MG_MKV(v, u) do { _Pragma("unroll") for (int _h = 0; _h < 2; ++_h) _Pragma("unroll") for (int _i = 0; _i < 2; ++_i) { const int _row = _h * HALF + RR[_i]; \
        const int _src = (GATHER && (u).gidx) ? (u).gidx[_row] : _row; v[_h][_i] = (unsigned)(_src * K + CC[_i]) * 2u; } } while (0)
    const size_t kstep = (size_t)(BK * 2);
    const size_t hstep = (size_t)HALF * K * 2;
    const unsigned ldsw = (unsigned)wid * 1024u;
    const int aoff = lds_byte(wr * 64 + fr, fq * 8), boff = lds_byte(wc * 32 + fr, fq * 8);
#define MG_SA(b, h) (((b) * 2 + (h)) * HTB)
#define MG_SB(b, h) ((4 + (b) * 2 + (h)) * HTB)
#define MG_STAGE(bufoff, gbase, voff) do { _Pragma("unroll") for (int _i = 0; _i < 2; ++_i) \
        __builtin_amdgcn_global_load_lds((const unsigned*)((const char*)(gbase) + (voff)[_i]), (MG_LAS unsigned*)(lds + (bufoff) + ldsw + _i * 8192), 16, 0, 0); } while (0)
#define MG_LDA(dst, b, h) do { _Pragma("unroll") for (int m = 0; m < 4; ++m) _Pragma("unroll") for (int k = 0; k < 2; ++k) dst[m][k] = *(const MG_LAS bf16x8*)(lds + MG_SA(b, h) + aoff + m * 2048 + k * 1024); } while (0)
#define MG_LDB(dst, b, h) do { _Pragma("unroll") for (int n = 0; n < 2; ++n) _Pragma("unroll") for (int k = 0; k < 2; ++k) dst[n][k] = *(const MG_LAS bf16x8*)(lds + MG_SB(b, h) + boff + n * 2048 + k * 1024); } while (0)
#define MG_MMA(ai, bj, At, Bt) do { __builtin_amdgcn_s_setprio(1); _Pragma("unroll") for (int m = 0; m < 4; ++m) _Pragma("unroll") for (int n = 0; n < 2; ++n) _Pragma("unroll") for (int k = 0; k < 2; ++k) \
        acc[ai][bj][m][n] = __builtin_amdgcn_mfma_f32_16x16x32_bf16(Bt[n][k], At[m][k], acc[ai][bj][m][n], 0, 0, 0); __builtin_amdgcn_s_setprio(0); } while (0)
#define MG_WAIT_V(n) asm volatile("s_waitcnt vmcnt(" #n ")" ::: "memory")
#define MG_WAIT_L(n) asm volatile("s_waitcnt lgkmcnt(" #n ")" ::: "memory")
#define MG_BAR __builtin_amdgcn_s_barrier()
#define MG_SCHED __builtin_amdgcn_sched_barrier(0)
    Unit cur, nxt; int ui = 0;
    if (!S.next(0, cur)) return;
    f32x4 acc[2][2][4][2];
#pragma unroll
    for (int a = 0; a < 2; ++a)
#pragma unroll
        for (int b = 0; b < 2; ++b)
#pragma unroll
            for (int m = 0; m < 4; ++m)
#pragma unroll
                for (int n = 0; n < 2; ++n) acc[a][b][m][n] = (f32x4){0.f, 0.f, 0.f, 0.f};
    bf16x8 At[4][2], B0[2][2], B1[2][2];
    const char* cA = cur.A; const char* cB = cur.B;
    MG_MKV(vA, cur);
    MG_STAGE(MG_SB(0, 0), cB, voffB); MG_STAGE(MG_SB(0, 1), cB + hstep, voffB); MG_STAGE(MG_SA(0, 0), cA, vA[0]); MG_STAGE(MG_SA(0, 1), cA, vA[1]);
    if (wr == 1) MG_BAR;
    MG_WAIT_V(2); MG_BAR;
    MG_STAGE(MG_SB(1, 0), cB + kstep, voffB); MG_STAGE(MG_SA(1, 0), cA + kstep, vA[0]); MG_STAGE(MG_SB(1, 1), cB + hstep + kstep, voffB);
    MG_WAIT_V(6); MG_BAR;
    for (;;) {
        const bool has_next = S.next(ui + 1, nxt);
        const char* nA = has_next ? nxt.A : cA; const char* nB = has_next ? nxt.B : cB;
#pragma unroll 1
        for (int t = 0; t < nt; t += 2) {
            const bool last = (t == nt - 2);
            const char* a1 = cA + (size_t)(t + 1) * kstep;
            const char* a2 = last ? nA : cA + (size_t)(t + 2) * kstep; const char* b2 = last ? nB : cB + (size_t)(t + 2) * kstep;
            const char* a3 = a2 + kstep; const char* b3 = b2 + kstep;
            unsigned x0[2], x1[2];
            if constexpr (GATHER) {
                if (last) { if (has_next) { MG_MKV(vN, nxt); } else {
#pragma unroll
                    for (int h = 0; h < 2; ++h)
#pragma unroll
                        for (int i = 0; i < 2; ++i) vN[h][i] = vA[h][i]; } }
#pragma unroll
                for (int i = 0; i < 2; ++i) { x0[i] = last ? vN[0][i] : vA[0][i]; x1[i] = last ? vN[1][i] : vA[1][i]; }
            } else {
#pragma unroll
                for (int i = 0; i < 2; ++i) { x0[i] = vA[0][i]; x1[i] = vA[1][i]; }
            }
            MG_LDB(B0, 0, 0); MG_LDB(B1, 0, 1); MG_SCHED; MG_LDA(At, 0, 0); MG_STAGE(MG_SA(1, 1), a1, vA[1]);
            MG_WAIT_V(8); MG_WAIT_L(0); MG_BAR; MG_MMA(0, 0, At, B0); MG_MMA(0, 1, At, B1); MG_BAR; MG_SCHED;
            MG_LDA(At, 0, 1); MG_STAGE(MG_SB(0, 0), b2, voffB); MG_STAGE(MG_SB(0, 1), b2 + hstep, voffB); MG_STAGE(MG_SA(0, 0), a2, x0);
            MG_WAIT_V(8); MG_WAIT_L(0); MG_BAR; MG_MMA(1, 0, At, B0); MG_MMA(1, 1, At, B1); MG_BAR; MG_SCHED;
            MG_LDB(B0, 1, 0); MG_LDB(B1, 1, 1); MG_SCHED; MG_LDA(At, 1, 0); MG_STAGE(MG_SA(0, 1), a2, x1);
            MG_WAIT_V(8); MG_WAIT_L(0); MG_BAR; MG_MMA(0, 0, At, B0); MG_MMA(0, 1, At, B1); MG_BAR; MG_SCHED;
            MG_LDA(At, 1, 1); MG_STAGE(MG_SB(1, 0), b3, voffB); MG_STAGE(MG_SB(1, 1), b3 + hstep, voffB); MG_STAGE(MG_SA(1, 0), a3, x0);
            MG_WAIT_V(8); MG_WAIT_L(0); MG_BAR; MG_MMA(1, 0, At, B0); MG_MMA(1, 1, At, B1); MG_BAR; MG_SCHED;
        }
        if (wr == 0) MG_BAR;
        E(acc, cur, wr, wc, fr, fq);
        if (!has_next) break;
#pragma unroll
        for (int a = 0; a < 2; ++a)
#pragma unroll
            for (int b = 0; b < 2; ++b)
#pragma unroll
                for (int m = 0; m < 4; ++m)
#pragma unroll
                    for (int n = 0; n < 2; ++n) acc[a][b][m][n] = (f32x4){0.f, 0.f, 0.f, 0.f};
        cur = nxt; cA = nA; cB = nB; ++ui;
        if constexpr (GATHER) {
#pragma unroll
            for (int h = 0; h < 2; ++h)
#pragma unroll
                for (int i = 0; i < 2; ++i) vA[h][i] = vN[h][i];
        }
        if (wr == 1) MG_BAR;
    }
    MG_WAIT_V(0);
    MG_BAR;
#undef MG_MKV
#undef MG_SA
#undef MG_SB
#undef MG_STAGE
#undef MG_LDA
#undef MG_LDB
#undef MG_MMA
#undef MG_WAIT_V
#undef MG_WAIT_L
#undef MG_BAR
#undef MG_SCHED
}
struct EpiF32 {
    static constexpr bool PERM = false;
    float* C; int ldc; int row0; int nvalid;
    __device__ __forceinline__ void operator()(const f32x4 (&acc)[2][2][4][2], const Unit& u, int wr, int wc, int fr, int fq) const {
        const int rb = row0 + u.pm * BM + wr * 64 + fr, cb = u.pn * BM + wc * 32 + 4 * fq;
#pragma unroll
        for (int ai = 0; ai < 2; ++ai)
#pragma unroll
            for (int m = 0; m < 4; ++m) { float* rowp = C + (size_t)(rb + ai * HALF + m * 16) * ldc;
#pragma unroll
                for (int bj = 0; bj < 2; ++bj)
#pragma unroll
                    for (int n = 0; n < 2; ++n) { const int col = cb + bj * HALF + n * 16; if (col < nvalid) *(f32x4*)(rowp + col) = acc[ai][bj][m][n]; } }
    }
};
struct EpiBf16 {
    static constexpr bool PERM = true;
    bf16_t* C; int ldc; int row0; int nvalid;
    __device__ __forceinline__ void operator()(const f32x4 (&acc)[2][2][4][2], const Unit& u, int wr, int wc, int fr, int fq) const {
        const int rb = row0 + u.pm * BM + wr * 64 + fr, cb = u.pn * BM + wc * 32 + 8 * fq;
#pragma unroll
        for (int ai = 0; ai < 2; ++ai)
#pragma unroll
            for (int m = 0; m < 4; ++m) { bf16_t* rowp = C + (size_t)(rb + ai * HALF + m * 16) * ldc;
#pragma unroll
                for (int bj = 0; bj < 2; ++bj) { const int col = cb + bj * HALF; if (col < nvalid) *(bf16x8*)(rowp + col) = pack8(acc[ai][bj][m][0] + 0.f, acc[ai][bj][m][1] + 0.f); } }
    }
};
struct EpiPre {
    static constexpr bool PERM = true;
    const Params* p; int layer; int row0;
    __device__ __forceinline__ void operator()(const f32x4 (&acc)[2][2][4][2], const Unit& u, int wr, int wc, int fr, int fq) const {
        const int rb = row0 + u.pm * BM + wr * 64 + fr, cb = u.pn * BM + wc * 32 + 8 * fq;
#pragma unroll
        for (int ai = 0; ai < 2; ++ai)
#pragma unroll
            for (int m = 0; m < 4; ++m) { const int row = rb + ai * HALF + m * 16; const float* g1 = p->MOD + ((size_t)layer * 9 + row_mod(row)) * 6144 + 2048;
#pragma unroll
                for (int bj = 0; bj < 2; ++bj) { const int col = cb + bj * HALF;
                    f32x4 x0, x1;
                    if (layer == 0) { const float* xr = xin_row(*p, 0, row) + col; x0 = *(const f32x4*)xr; x1 = *(const f32x4*)(xr + 4); }
                    else { const u32x4 xw = *(const u32x4*)(p->X2 + (size_t)row * DM + col); x0 = bf4_to_f32((u32x2){xw.x, xw.y}); x1 = bf4_to_f32((u32x2){xw.z, xw.w}); }
                    *(bf16x8*)(p->PRE + (size_t)row * DM + col) = pack8(x0 * DN_ALPHA + *(const f32x4*)(g1 + col) * acc[ai][bj][m][0], x1 * DN_ALPHA + *(const f32x4*)(g1 + col + 4) * acc[ai][bj][m][1]); } }
    }
};
struct EpiAct {
    static constexpr bool PERM = true;
    bf16_t* ACT;
    __device__ __forceinline__ void operator()(const f32x4 (&acc)[2][2][4][2], const Unit& u, int wr, int wc, int fr, int fq) const {
        const int rb = u.pm * BM + wr * 64 + fr, cb = u.pn * HALF + wc * 32 + 8 * fq;
#pragma unroll
        for (int ai = 0; ai < 2; ++ai)
#pragma unroll
            for (int m = 0; m < 4; ++m) {
                const f32x4 a0 = acc[ai][0][m][0], a1 = acc[ai][0][m][1], b0 = acc[ai][1][m][0], b1 = acc[ai][1][m][1];
                f32x4 o0, o1;
#pragma unroll
                for (int e = 0; e < 4; ++e) { o0[e] = a0[e] / (1.f + __expf(-a0[e])) * b0[e]; o1[e] = a1[e] / (1.f + __expf(-a1[e])) * b1[e]; }
                *(bf16x8*)(ACT + (size_t)(rb + ai * HALF + m * 16) * 256 + cb) = pack8(o0, o1);
            }
    }
};
struct EpiYs {
    static constexpr bool PERM = true;
    bf16_t* YS; const float* gate; int ntr;
    __device__ __forceinline__ void operator()(const f32x4 (&acc)[2][2][4][2], const Unit& u, int wr, int wc, int fr, int fq) const {
        const int rb = u.pm * BM + wr * 64 + fr, cb = u.pn * BM + wc * 32 + 8 * fq;
#pragma unroll
        for (int ai = 0; ai < 2; ++ai)
#pragma unroll
            for (int m = 0; m < 4; ++m) { const int row = rb + ai * HALF + m * 16; const float g = gate[row] * 64.f;
#pragma unroll
                for (int bj = 0; bj < 2; ++bj) { const f32x4 v0 = acc[ai][bj][m][0] * g, v1 = acc[ai][bj][m][1] * g; int w0 = 0, w1 = 0;
                    w0 = __builtin_amdgcn_cvt_pk_fp8_f32(v0[0], v0[1], w0, false); w0 = __builtin_amdgcn_cvt_pk_fp8_f32(v0[2], v0[3], w0, true);
                    w1 = __builtin_amdgcn_cvt_pk_fp8_f32(v1[0], v1[1], w1, false); w1 = __builtin_amdgcn_cvt_pk_fp8_f32(v1[2], v1[3], w1, true);
                    u32x2 wv; wv.x = (unsigned)w0; wv.y = (unsigned)w1; *(u32x2*)((unsigned char*)YS + (size_t)row * DM + cb + bj * HALF) = wv; } }
    }
};
}

__device__ __forceinline__ void phase_mod(const Params& p, unsigned char* lds) {
    float* sv = (float*)lds;
    float* red = sv + 9 * 1024;
    const int tid = threadIdx.x;
    for (int e = tid; e < 9 * 1024; e += NTHR) { const int j = e >> 10, k = e & 1023; const float v = j < 8 ? p.c[j * 1024 + k] : p.c_ctx[k]; sv[e] = silu_f(v); }
    __syncthreads();
    const int kg = tid >> 6, nl = tid & 63;
    for (int u = blockIdx.x; u < 192; u += gridDim.x) {
        const int l = u / 96, n0 = (u % 96) * 64;
        const float* W = p.mod_w + (size_t)l * 1024 * 6144 + n0 + nl;
        float acc[9];
#pragma unroll
        for (int j = 0; j < 9; ++j) acc[j] = 0.f;
        for (int k = kg; k < 1024; k += 8) {
            const float wv = W[(size_t)k * 6144];
#pragma unroll
            for (int j = 0; j < 9; ++j) acc[j] += sv[j * 1024 + k] * wv;
        }
#pragma unroll
        for (int j = 0; j < 9; ++j) red[(kg * 9 + j) * 64 + nl] = acc[j];
        __syncthreads();
        for (int e = tid; e < 576; e += NTHR) {
            const int j = e >> 6, n = e & 63; float s = 0.f;
#pragma unroll
            for (int g = 0; g < 8; ++g) s += red[(g * 9 + j) * 64 + n];
            p.MOD[((size_t)l * 9 + j) * 6144 + n0 + n] = s + p.mod_b[l * 6144 + n0 + n];
        }
        __syncthreads();
    }
}

__device__ __forceinline__ void phase_filt(const Params& p, unsigned char* lds) {
    float* zs = (float*)lds;
    float* h1 = zs + 8 * 33;
    float* h2 = h1 + 8 * 64;
    const int tid = threadIdx.x;
    const float min_decay = logf(1e-2f) / 1.5f, max_decay = logf(1e-2f) / 0.3f;
    for (int u = blockIdx.x; u < 512; u += gridDim.x) {
        __syncthreads();
        if (tid < 8 * 33) {
            const int tt = tid / 33, i = tid % 33; const int t = u * 8 + tt;
            float v;
            if (i == 0) v = (float)t / 4095.f;
            else {
                const int bi = (i - 1) & 15; const float fr = 1e-4f + (float)bi * ((15.f - 1e-4f) / 15.f);
                const float wpos = 6.283185307179586f * (float)t / 4096.f;
                v = (i <= 16) ? cosf(fr * wpos) : -sinf(fr * wpos);
            }
            zs[tid] = v;
        }
        __syncthreads();
        const int tt = tid >> 6, j = tid & 63;
        {
            float s = p.hy_ffn_b1[j];
            for (int i = 0; i < 33; ++i) s += zs[tt * 33 + i] * p.hy_ffn_w1[i * 64 + j];
            h1[tt * 64 + j] = sinf(p.hy_sin_freq[j] * s);
        }
        __syncthreads();
        {
            float s = p.hy_ffn_b2[j];
            for (int i = 0; i < 64; ++i) s += h1[tt * 64 + i] * p.hy_ffn_w2[i * 64 + j];
            h2[tt * 64 + j] = sinf(p.hy_sin_freq[64 + j] * s);
        }
        __syncthreads();
#pragma unroll 1
        for (int mi = 0; mi < 4; ++mi) {
            const int m = tid + 512 * mi; const int n = m >> 10, side = (m >> 9) & 1, c = m & 511;
            float acc[8];
#pragma unroll
            for (int t2 = 0; t2 < 8; ++t2) acc[t2] = 0.f;
            for (int jj = 0; jj < 64; ++jj) {
                const float wv = p.hy_ffn_w3[jj * 2048 + m];
#pragma unroll
                for (int t2 = 0; t2 < 8; ++t2) acc[t2] += h2[t2 * 64 + jj] * wv;
            }
            const float delta = min_decay + (float)c * ((max_decay - min_decay) / 511.f);
#pragma unroll
            for (int t2 = 0; t2 < 8; ++t2) {
                const int t = u * 8 + t2; const float win = expf(-((float)t / 4095.f) * fabsf(delta)); const float val = acc[t2] * win;
                if (side == 0) p.G[((size_t)n * 512 + c) * 8192 + 4096 + t] = val;
                else if (t > 0) p.G[((size_t)n * 512 + c) * 8192 + 4096 - t] = val;
            }
        }
        if (u == 0) for (int e = tid; e < 1024; e += NTHR) p.G[(size_t)e * 8192] = 0.f;
    }
}

struct ConvJob { const float* src; bf16_t* dst; int ld, ncols, col0, k0, K; };
__device__ __forceinline__ int w13_col(int nrow) { const int pn = nrow >> 8, within = nrow & 255; return (within >> 7) * 256 + pn * 128 + (within & 127); }
#define CONV_TOTAL (3008 + 65536 + 32768 + 40)
__device__ __forceinline__ ConvJob conv_job(const Params& p, int g) {
    ConvJob j;
    if (g < 1088) { const int rt = g >> 4, kt = g & 15; j = {p.ev_w_in, p.WT_EVIN + (size_t)rt * 64 * 1024, EVW, EVW, rt * 64, kt * 64, 1024}; }
    else if (g < 1344) { const int t = g - 1088, rt = t >> 4, kt = t & 15; j = {p.ev_w_out, p.WT_EVOUT + (size_t)rt * 64 * 1024, 1024, 1024, rt * 64, kt * 64, 1024}; }
    else if (g < 2240) { const int t = g - 1344, rt = t >> 4, kt = t & 15; j = {p.od_w_in, p.WT_ODIN + (size_t)rt * 64 * 1024, ODW, ODW, rt * 64, kt * 64, 1024}; }
    else if (g < 2496) { const int t = g - 2240, rt = t >> 4, kt = t & 15; j = {p.od_w_out, p.WT_ODOUT + (size_t)rt * 64 * 1024, 1024, 1024, rt * 64, kt * 64, 1024}; }
    else if (g < 2624) { const int t = g - 2496, l = t >> 6, rt = (t >> 4) & 3, kt = t & 15; j = {p.router_w + (size_t)l * 1024 * 256, p.WT_ROUT + ((size_t)l * 256 + rt * 64) * 1024, 256, 256, rt * 64, kt * 64, 1024}; }
    else if (g < 2880) { const int t = g - 2624, l = t >> 7, rt = (t >> 4) & 7, kt = t & 15; j = {p.sh_w13 + (size_t)l * 1024 * 512, p.WT_SH13 + ((size_t)l * 512 + rt * 64) * 1024, 512, 512, w13_col(rt * 64), kt * 64, 1024}; }
    else if (g < 3008) { const int t = g - 2880, l = t >> 6, rt = (t >> 2) & 15, kt = t & 3; j = {p.sh_w2 + (size_t)l * 256 * 1024, p.WT_SH2 + ((size_t)l * 1024 + rt * 64) * 256, 1024, 1024, rt * 64, kt * 64, 256}; }
    else if (g < 3008 + 65536) { const int t = g - 3008, le = t >> 7, rt = (t >> 4) & 7, kt = t & 15; j = {p.exp_w13 + (size_t)le * 1024 * 512, p.WT_W13 + ((size_t)le * 512 + rt * 64) * 1024, 512, 512, w13_col(rt * 64), kt * 64, 1024}; }
    else if (g < 3008 + 65536 + 32768) { const int t = g - 3008 - 65536, le = t >> 6, rt = (t >> 2) & 15, kt = t & 3; j = {p.exp_w2 + (size_t)le * 256 * 1024, p.WT_W2 + ((size_t)le * 1024 + rt * 64) * 256, 1024, 1024, rt * 64, kt * 64, 256}; }
    else { const int t = g - 3008 - 65536 - 32768;
        if (t < 8) j = {p.rw_w2, p.WT_RWF + (size_t)t * 64 * 64, 512, 512, t * 64, 0, 64};
        else if (t < 16) j = {p.rw_w2 + 64 * 512, p.WT_RWB + (size_t)(t - 8) * 64 * 64, 512, 512, (t - 8) * 64, 0, 64};
        else if (t < 24) j = {p.rw_a2, p.WT_RWA + (size_t)(t - 16) * 64 * 64, 512, 512, (t - 16) * 64, 0, 64};
        else { const int t2 = t - 24; j = {p.rw_g2, p.WT_RWG + (size_t)(t2 >> 1) * 64 * 128, 512, 512, (t2 >> 1) * 64, (t2 & 1) * 64, 128}; } }
    return j;
}
#define W13L0_HOSTED 6000
__device__ __forceinline__ int conv_count(int part) { return part == 0 ? (3008 + 32768 - W13L0_HOSTED + 40) : (part == 1 ? 32768 + 16384 : 16384 + W13L0_HOSTED); }
__device__ __forceinline__ int conv_index(int part, int i) {
    if (part == 0) return i < 3008 + 32768 - W13L0_HOSTED ? i : i + W13L0_HOSTED + 32768 + 32768;
    if (part == 1) return i < 32768 ? 3008 + 32768 + i : 3008 + 65536 + 16384 + (i - 32768);
    return i < 16384 ? 3008 + 65536 + i : 3008 + 32768 - W13L0_HOSTED + (i - 16384);
}
__device__ __forceinline__ void phase_convw(const Params& p, unsigned char* lds, const int part, const int blk, const int nblk) {
    constexpr int CD = 3;
    bf16_t* T = (bf16_t*)lds;
    const int tid = threadIdx.x, kk = tid >> 4, nq = tid & 15;
    f32x4 q0[CD], q1[CD]; ConvJob jq[CD];
#define CONV_LOAD(d, gi) do { jq[d] = conv_job(p, conv_index(part, (gi))); const int col_ = jq[d].col0 + nq * 4; const bool ok_ = col_ < jq[d].ncols; \
        const float* sp_ = jq[d].src + (size_t)(jq[d].k0 + kk) * jq[d].ld + (ok_ ? col_ : 0); \
        q0[d] = *(const f32x4*)sp_; q1[d] = *(const f32x4*)(sp_ + (size_t)32 * jq[d].ld); if (!ok_) { q0[d] = (f32x4){0.f, 0.f, 0.f, 0.f}; q1[d] = q0[d]; } } while (0)
    const int total = conv_count(part);
    if (blk >= total) return;
#pragma unroll
    for (int d = 0; d < CD; ++d) { const int gi = blk + d * nblk; CONV_LOAD(d, gi < total ? gi : blk); }
    for (int g0 = blk; g0 < total; g0 += CD * nblk) {
#pragma unroll
        for (int d = 0; d < CD; ++d) {
            const int g = g0 + d * nblk;
            if (g < total) {
                const f32x4 v0 = q0[d], v1 = q1[d]; const ConvJob job = jq[d];
                { const int gn = g + CD * nblk; CONV_LOAD(d, gn < total ? gn : g); }
                asm volatile("" ::: "memory");
                __syncthreads();
#pragma unroll
                for (int e = 0; e < 4; ++e) { T[(nq * 4 + e) * 66 + kk] = f2bf(v0[e]); T[(nq * 4 + e) * 66 + kk + 32] = f2bf(v1[e]); }
                __syncthreads();
                const int n = tid >> 3, seg = tid & 7;
                const unsigned* tp = (const unsigned*)(T + n * 66 + seg * 8);
                u32x4 o; o.x = tp[0]; o.y = tp[1]; o.z = tp[2]; o.w = tp[3];
                *(u32x4*)(job.dst + (size_t)n * job.K + job.k0 + seg * 8) = o;
            }
        }
    }
#undef CONV_LOAD
}
__device__ __forceinline__ void phase_hin0(const Params& p) {
    for (int i = blockIdx.x * NTHR + threadIdx.x; i < NT * 128; i += gridDim.x * NTHR) {
        const int r = i >> 7, k = (i & 127) * 8;
        const float* xr = xin_row(p, 0, r) + k; const float* md = p.MOD + (size_t)row_mod(r) * 6144 + k;
        const f32x4 x0 = *(const f32x4*)xr, x1 = *(const f32x4*)(xr + 4), h0 = *(const f32x4*)md, h1 = *(const f32x4*)(md + 4), s0 = *(const f32x4*)(md + 1024), s1 = *(const f32x4*)(md + 1028);
        *(bf16x8*)(p.HIN + (size_t)r * 1024 + k) = pack8(x0 * (s0 + 1.f) + h0, x1 * (s1 + 1.f) + h1);
    }
}
__device__ __forceinline__ void phase_inproj(const Params& p, unsigned char* lds, int layer) {
    mg8::DenseOrder S; S.init(p.HIN, layer == 0 ? p.WT_EVIN : p.WT_ODIN, NT, layer == 0 ? 4352 : 3584, 1024, gridDim.x, blockIdx.x);
    const int N = layer == 0 ? EVW : ODW;
    mg8::EpiBf16 E{p.P, N, 0, N};
    mg8::gemm_phase<mg8::EpiBf16, mg8::DenseOrder, false>((MG_LAS unsigned char*)lds, 1024, S, E);
}

template <int DK, int TYPE>
__device__ __forceinline__ void rec0_chunked(const Params& p, unsigned char* lds, int blk, int nblk) {
    constexpr int DKP = DK + 8, TPT = DK / 8, NPART = 512 / DK, NT16 = DK / 16;
    bf16_t* Qs = (bf16_t*)lds;
    bf16_t* Ks = Qs + 64 * DKP;
    bf16_t* KsT = Ks + 64 * DKP;
    bf16_t* Vt = KsT + DK * 72;
    bf16_t* Ps = Vt + 64 * 72;
    float* ptot = (float*)(Ps + 64 * 72);
    float* lref = ptot + 8 * 128;
    float* decv = lref + 128; float* elv = decv + 128; float* erv = elv + 128;
    const int tid = threadIdx.x, lane = tid & 63, w = tid >> 6, cw = w & 3, mh = w >> 2, q4 = lane >> 4, l15 = lane & 15;
    const int d = tid % DK, part = tid / DK;
    for (int e = tid; e < 64 * 72; e += NTHR) Ps[e] = 0;
    for (int unit = blk; unit < 128; unit += nblk) {
        const int half = unit & 1, h = (unit >> 1) & 3, b = (unit >> 3) & 7, dir = unit >> 6;
        float wg[16]; float gbias = 0.f, lbv = 0.f;
        if (TYPE == 0) {
#pragma unroll
            for (int i = 0; i < 16; ++i) wg[i] = p.gla_gate_w2[(dir * 16 + i) * 256 + h * 64 + d];
            gbias = p.gla_gate_b[dir * 256 + h * 64 + d];
        } else {
            const float l0 = p.hg_lb_logits[dir * 512 + h * 128 + d], l1 = p.hg_lb_logits[1024 + dir * 512 + h * 128 + d];
            lbv = 1.f / (1.f + expf(l1 - l0));
        }
        f32x4 Sacc[NT16];
#pragma unroll
        for (int t = 0; t < NT16; ++t) Sacc[t] = (f32x4){0.f, 0.f, 0.f, 0.f};
        const int vcol0 = (TYPE == 0 ? 512 : 3104) + h * 128 + half * 64;
        float ra[TPT], rb[TPT], rv[8]; f32x4 rg = {0.f, 0.f, 0.f, 0.f};
        float* sga = erv + 128;
#define REC_LOAD(cc) do { _Pragma("unroll") for (int tt = 0; tt < TPT; ++tt) { const bf16_t* pr = p.P + (size_t)row_of(dir, b, (cc) * 64 + part * TPT + tt) * EVW; \
            if (TYPE == 0) { ra[tt] = bf2f(pr[h * 64 + d]); rb[tt] = bf2f(pr[256 + h * 64 + d]); } else { ra[tt] = bf2f(pr[1568 + h * 128 + d]); rb[tt] = bf2f(pr[2080 + dir * 512 + h * 128 + d]); } } \
        _Pragma("unroll") for (int e = 0; e < 8; ++e) rv[e] = bf2f(p.P[(size_t)row_of(dir, b, (cc) * 64 + (tid >> 6) * 8 + e) * EVW + vcol0 + (tid & 63)]); \
        if (TYPE == 0 && tid < 256) rg = bf4_to_f32(*(const u32x2*)(p.P + (size_t)row_of(dir, b, (cc) * 64 + (tid >> 2)) * EVW + 1536 + dir * 16 + (tid & 3) * 4)); } while (0)
        REC_LOAD(0);
        for (int c = 0; c < (CTXL + SEQ) / 64; ++c) {
            __syncthreads();
            if (TYPE == 0) { if (tid < 256) *(f32x4*)(sga + tid * 4) = rg; __syncthreads(); }
            float qv[TPT], kv[TPT], lcv[TPT]; float lc = 0.f;
#pragma unroll
            for (int tt = 0; tt < TPT; ++tt) {
                float la;
                if (TYPE == 0) {
                    qv[tt] = ra[tt] * 0.125f; kv[tt] = rb[tt];
                    const float* ap = sga + (part * TPT + tt) * 16; float sg = gbias;
#pragma unroll
                    for (int i = 0; i < 16; i += 4) { const f32x4 a4 = *(const f32x4*)(ap + i); sg += a4[0] * wg[i] + a4[1] * wg[i + 1] + a4[2] * wg[i + 2] + a4[3] * wg[i + 3]; }
                    const float ex = __expf(-fabsf(sg)); la = (fminf(sg, 0.f) - __logf(1.f + ex)) * (1.f / 16.f);
                } else {
                    qv[tt] = ra[tt] * __builtin_amdgcn_rcpf(1.f + __expf(-ra[tt]));
                    const float f = lbv + (1.f - lbv) * __builtin_amdgcn_rcpf(1.f + __expf(-rb[tt]));
                    kv[tt] = 1.f - f; la = __logf(f);
                }
                lc += la; lcv[tt] = lc;
            }
            ptot[part * 128 + d] = lc;
            if (part == 32 / TPT) lref[d] = lcv[32 % TPT];
            *(bf16x8*)(Vt + (tid & 63) * 72 + (tid >> 6) * 8) = pack8((f32x4){rv[0], rv[1], rv[2], rv[3]}, (f32x4){rv[4], rv[5], rv[6], rv[7]});
            __syncthreads();
            float off = 0.f, bref = lref[d], blast = 0.f;
#pragma unroll
            for (int pp = 0; pp < NPART; ++pp) { const float tv = ptot[pp * 128 + d]; if (pp < part) off += tv; if (pp < 32 / TPT) bref += tv; blast += tv; }
            if (part == 0) { decv[d] = __expf(blast); elv[d] = __expf(blast - bref); erv[d] = __expf(bref); }
            {
                float ksv[TPT];
#pragma unroll
                for (int tt = 0; tt < TPT; ++tt) {
                    const int j = part * TPT + tt; const float bj = lcv[tt] + off;
                    const float e1 = __expf(bj - bref), e2 = __expf(bref - bj);
                    Qs[j * DKP + d] = f2bf(qv[tt] * e1); ksv[tt] = kv[tt] * e2; Ks[j * DKP + d] = f2bf(ksv[tt]);
                }
#pragma unroll
                for (int g = 0; g < TPT / 8; ++g) {
                    f32x4 a0 = {ksv[g * 8], ksv[g * 8 + 1], ksv[g * 8 + 2], ksv[g * 8 + 3]}, a1 = {ksv[g * 8 + 4], ksv[g * 8 + 5], ksv[g * 8 + 6], ksv[g * 8 + 7]};
                    *(bf16x8*)(KsT + d * 72 + part * TPT + g * 8) = pack8(a0, a1);
                }
            }
            __syncthreads();
            if (c + 1 < (CTXL + SEQ) / 64) REC_LOAD(c + 1);
#pragma unroll
            for (int rep = 0; rep < 2; ++rep) {
                const int t = w + rep * 8;
                if (t < 10) {
                    const int it = t < 1 ? 0 : (t < 3 ? 1 : (t < 6 ? 2 : 3)); const int jt = t - (it * (it + 1)) / 2;
                    f32x4 acc = {0.f, 0.f, 0.f, 0.f};
#pragma unroll
                    for (int ks = 0; ks < DK / 32; ++ks) {
                        const bf16x8 ka = *(const bf16x8*)(Ks + (jt * 16 + l15) * DKP + ks * 32 + q4 * 8);
                        const bf16x8 qb = *(const bf16x8*)(Qs + (it * 16 + l15) * DKP + ks * 32 + q4 * 8);
                        acc = __builtin_amdgcn_mfma_f32_16x16x32_bf16(ka, qb, acc, 0, 0, 0);
                    }
                    const int i = it * 16 + l15, j0 = jt * 16 + q4 * 4;
                    u32x2 wv; wv.x = pk2(i >= j0 ? acc[0] : 0.f, i >= j0 + 1 ? acc[1] : 0.f); wv.y = pk2(i >= j0 + 2 ? acc[2] : 0.f, i >= j0 + 3 ? acc[3] : 0.f);
                    *(u32x2*)(Ps + i * 72 + j0) = wv;
                }
            }
            __syncthreads();
            bf16x8 vb[2];
#pragma unroll
            for (int ks = 0; ks < 2; ++ks) vb[ks] = *(const bf16x8*)(Vt + (cw * 16 + l15) * 72 + ks * 32 + q4 * 8);
            bf16x8 sb[DK / 32];
#pragma unroll
            for (int ks = 0; ks < DK / 32; ++ks) {
                const f32x4 e0 = *(const f32x4*)(erv + ks * 32 + q4 * 4), e1 = *(const f32x4*)(erv + ks * 32 + 16 + q4 * 4);
                sb[ks] = pack8(Sacc[2 * ks] * e0, Sacc[2 * ks + 1] * e1);
            }
#pragma unroll
            for (int r2 = 0; r2 < 2; ++r2) {
                const int it = mh * 2 + r2;
                f32x4 acc = {0.f, 0.f, 0.f, 0.f};
#pragma unroll
                for (int ks = 0; ks < 2; ++ks) {
                    if (ks == 0 || it >= 2) {
                        const bf16x8 pa = *(const bf16x8*)(Ps + (it * 16 + l15) * 72 + ks * 32 + q4 * 8);
                        acc = __builtin_amdgcn_mfma_f32_16x16x32_bf16(pa, vb[ks], acc, 0, 0, 0);
                    }
                }
#pragma unroll
                for (int ks = 0; ks < DK / 32; ++ks) {
                    const u32x2 lo2 = *(const u32x2*)(Qs + (it * 16 + l15) * DKP + ks * 32 + q4 * 4), hi2 = *(const u32x2*)(Qs + (it * 16 + l15) * DKP + ks * 32 + 16 + q4 * 4);
                    u32x4 qa4; qa4.x = lo2.x; qa4.y = lo2.y; qa4.z = hi2.x; qa4.w = hi2.y;
                    acc = __builtin_amdgcn_mfma_f32_16x16x32_bf16(__builtin_bit_cast(bf16x8, qa4), sb[ks], acc, 0, 0, 0);
                }
#pragma unroll
                for (int e = 0; e < 4; ++e) {
                    const int row = row_of(dir, b, c * 64 + it * 16 + q4 * 4 + e);
                    p.O[((size_t)dir * NT + row) * 1024 + TYPE * 512 + h * 128 + half * 64 + cw * 16 + l15] = f2bf(acc[e]);
                }
            }
#pragma unroll
            for (int t = 0; t < NT16; ++t) {
                f32x4 acc = {0.f, 0.f, 0.f, 0.f};
#pragma unroll
                for (int ks = 0; ks < 2; ++ks) {
                    const bf16x8 ka = *(const bf16x8*)(KsT + (t * 16 + l15) * 72 + ks * 32 + q4 * 8);
                    acc = __builtin_amdgcn_mfma_f32_16x16x32_bf16(ka, vb[ks], acc, 0, 0, 0);
                }
                const f32x4 dv = *(const f32x4*)(decv + t * 16 + q4 * 4), ev = *(const f32x4*)(elv + t * 16 + q4 * 4);
                Sacc[t] = Sacc[t] * dv + ev * acc;
            }
        }
#undef REC_LOAD
    }
}
__device__ __forceinline__ void phase_rec0(const Params& p, unsigned char* lds) {
    const int nb = gridDim.x, b = blockIdx.x;
    if (nb >= 256) { if (b < 128) rec0_chunked<128, 1>(p, lds, b, 128); else { rec0_chunked<64, 0>(p, lds, b - 128, nb - 128); __syncthreads(); phase_convw(p, lds, 2, b - 128, nb - 128); } }
    else { rec0_chunked<128, 1>(p, lds, b, nb); rec0_chunked<64, 0>(p, lds, b, nb); __syncthreads(); phase_convw(p, lds, 2, b, nb); }
}

__device__ __forceinline__ void phase_readout0(const Params& p) {
    const int lane = threadIdx.x & 63, w = __builtin_amdgcn_readfirstlane(threadIdx.x >> 6);
    const int c = w * 128 + lane * 2;
    const float* gn = w < 4 ? p.gla_norm_g : p.hg_norm_g;
    const float g0 = gn[lane * 2], g1 = gn[lane * 2 + 1];
    const int goff = w < 4 ? (1024 + c) : (3616 + (c - 512));
    unsigned n0[4], n1[4]; unsigned ng[4];
#define RO0_LOAD(bi) do { _Pragma("unroll") for (int j = 0; j < 4; ++j) { const int r_ = (bi) * 4 + j; n0[j] = *(const unsigned*)(p.O + (size_t)r_ * 1024 + c); n1[j] = *(const unsigned*)(p.O + ((size_t)NT + r_) * 1024 + c); \
        ng[j] = *(const unsigned*)(p.P + (size_t)r_ * EVW + goff); } } while (0)
    if ((int)blockIdx.x < NT / 4) RO0_LOAD((int)blockIdx.x);
    for (int bi = blockIdx.x; bi < NT / 4; bi += gridDim.x) {
        unsigned c0[4], c1[4]; unsigned cg[4];
#pragma unroll
        for (int j = 0; j < 4; ++j) { c0[j] = n0[j]; c1[j] = n1[j]; cg[j] = ng[j]; }
        if (bi + (int)gridDim.x < NT / 4) RO0_LOAD(bi + (int)gridDim.x);
        asm volatile("" ::: "memory");
#pragma unroll
        for (int j = 0; j < 4; ++j) {
            const float a = __uint_as_float(c0[j] << 16) + __uint_as_float(c1[j] << 16), b = __uint_as_float(c0[j] & 0xffff0000u) + __uint_as_float(c1[j] & 0xffff0000u);
            const float ss = wave_sum(a * a + b * b);
            const float rs = rsqrtf(ss * (1.f / 128.f) + 1e-6f);
            const float ga = __uint_as_float(cg[j] << 16), gb = __uint_as_float(cg[j] & 0xffff0000u);
            *(unsigned*)(p.Y + (size_t)(bi * 4 + j) * 1024 + c) = pk2(a * rs * g0 * silu_f(ga), b * rs * g1 * silu_f(gb));
        }
        asm volatile("" ::: "memory");
    }
#undef RO0_LOAD
}

__device__ __forceinline__ void phase_outproj(const Params& p, unsigned char* lds, int layer) {
    const int rbase = layer == 0 ? 0 : NCTX;
    mg8::DenseOrder S; S.init(p.Y + (size_t)rbase * DM, layer == 0 ? p.WT_EVOUT : p.WT_ODOUT, NT - rbase, 1024, 1024, gridDim.x, blockIdx.x);
    mg8::EpiPre E{&p, layer, rbase};
    mg8::gemm_phase<mg8::EpiPre, mg8::DenseOrder, false>((MG_LAS unsigned char*)lds, 1024, S, E);
}

__device__ __forceinline__ void phase_ln1(const Params& p, int layer) {
    const int lane = threadIdx.x & 63, w = __builtin_amdgcn_readfirstlane(threadIdx.x >> 6);
    const int rbase = layer == 0 ? 0 : NCTX; const int npair = (NT - rbase) / 2;
    const float* lg = p.ln1_g + layer * DM; const float* lb = p.ln1_b + layer * DM;
    u32x2 nv[2][4];
#define LN1_LOAD(pi) do { _Pragma("unroll") for (int j = 0; j < 2; ++j) _Pragma("unroll") for (int i = 0; i < 4; ++i) nv[j][i] = *(const u32x2*)(p.PRE + (size_t)(rbase + (pi) * 2 + j) * DM + i * 256 + lane * 4); } while (0)
    const int pi0 = blockIdx.x * 8 + w, pstep = gridDim.x * 8;
    if (pi0 < npair) LN1_LOAD(pi0);
    for (int pi = pi0; pi < npair; pi += pstep) {
        f32x4 cv[2][4];
#pragma unroll
        for (int j = 0; j < 2; ++j)
#pragma unroll
            for (int i = 0; i < 4; ++i) cv[j][i] = bf4_to_f32(nv[j][i]);
        if (pi + pstep < npair) LN1_LOAD(pi + pstep);
        asm volatile("" ::: "memory");
#pragma unroll
        for (int j = 0; j < 2; ++j) {
            const int r = rbase + pi * 2 + j; float s = 0.f;
#pragma unroll
            for (int i = 0; i < 4; ++i) s += (cv[j][i][0] + cv[j][i][1]) + (cv[j][i][2] + cv[j][i][3]);
            const float mean = wave_sum(s) * (1.f / 1024.f); float q = 0.f;
#pragma unroll
            for (int i = 0; i < 4; ++i) { const f32x4 d = cv[j][i] - mean; q += (d[0] * d[0] + d[1] * d[1]) + (d[2] * d[2] + d[3] * d[3]); }
            const float rstd = rsqrtf(wave_sum(q) * (1.f / 1024.f) + 1e-5f);
            const float* md = p.MOD + ((size_t)layer * 9 + row_mod(r)) * 6144;
#pragma unroll
            for (int i = 0; i < 4; ++i) {
                const int col = i * 256 + lane * 4;
                const f32x4 y = (cv[j][i] - mean) * rstd * *(const f32x4*)(lg + col) + *(const f32x4*)(lb + col);
                *(u32x2*)(p.X1 + (size_t)r * DM + col) = f32_to_bf4(y);
                const f32x4 uu = y * (*(const f32x4*)(md + 4096 + col) + 1.f) + *(const f32x4*)(md + 3072 + col);
                *(u32x2*)(p.U + (size_t)r * DM + col) = f32_to_bf4(uu);
            }
        }
        asm volatile("" ::: "memory");
    }
#undef LN1_LOAD
}

__device__ __forceinline__ void phase_router(const Params& p, unsigned char* lds, int layer) {
    const int rbase = layer == 0 ? 0 : NCTX;
    mg8::DenseOrder S; S.init(p.U + (size_t)rbase * DM, p.WT_ROUT + (size_t)layer * 256 * 1024, NT - rbase, 256, 1024, gridDim.x, blockIdx.x);
    mg8::EpiF32 E{p.LOGITS, 256, rbase, 256};
    mg8::gemm_phase<mg8::EpiF32, mg8::DenseOrder, false>((MG_LAS unsigned char*)lds, 1024, S, E);
}

__device__ __forceinline__ void phase_select(const Params& p, int layer) {
    const int lane = threadIdx.x & 63, w = __builtin_amdgcn_readfirstlane(threadIdx.x >> 6);
    const int rbase = layer == 0 ? 0 : NCTX; const int nrows = NT - rbase;
    const f32x4 bias = *(const f32x4*)(p.router_bias + layer * 256 + lane * 4);
    int* cnt = p.CNT + layer * 256;
    const float NEG = -__builtin_inff();
    f32x4 lgn = {0.f, 0.f, 0.f, 0.f};
    if ((int)(blockIdx.x * 8 + w) < nrows) lgn = *(const f32x4*)(p.LOGITS + (size_t)(rbase + blockIdx.x * 8 + w) * 256 + lane * 4);
    for (int t = blockIdx.x * 8 + w; t < nrows; t += gridDim.x * 8) {
        const f32x4 lg = lgn;
        if (t + (int)gridDim.x * 8 < nrows) lgn = *(const f32x4*)(p.LOGITS + (size_t)(rbase + t + gridDim.x * 8) * 256 + lane * 4);
        float sc0 = sigmoid_f(lg[0]), sc1 = sigmoid_f(lg[1]), sc2 = sigmoid_f(lg[2]), sc3 = sigmoid_f(lg[3]);
        float s0 = sc0 + bias[0], s1 = sc1 + bias[1], s2 = sc2 + bias[2], s3 = sc3 + bias[3];
        float a = fmaxf(s0, s1), b = fminf(s0, s1), c = fmaxf(s2, s3), d = fminf(s2, s3);
        float m1 = fmaxf(a, c), m2 = fmaxf(fminf(a, c), fmaxf(b, d));
#define SEL_MERGE(ctrl) do { const float o1 = DPPF(m1, ctrl, 0xF), o2 = DPPF(m2, ctrl, 0xF); const float n1 = fmaxf(m1, o1), n2 = fmaxf(fminf(m1, o1), fmaxf(m2, o2)); m1 = n1; m2 = n2; } while (0)
        SEL_MERGE(0xB1); SEL_MERGE(0x4E); SEL_MERGE(0x141);
#undef SEL_MERGE
        const float grp = m1 + m2; const int myg = lane >> 3; int rank = 0;
#pragma unroll
        for (int g = 0; g < 8; ++g) { const float sg = __int_as_float(__builtin_amdgcn_readlane(__float_as_int(grp), g * 8)); rank += (sg > grp || (sg == grp && g < myg)) ? 1 : 0; }
        if (rank >= 4) { s0 = NEG; s1 = NEG; s2 = NEG; s3 = NEG; }
        int my_e = 0; float my_s = 0.f, gsum = 0.f;
#pragma unroll 1
        for (int k = 0; k < 8; ++k) {
            float lm = s0; int li = 0;
            if (s1 > lm) { lm = s1; li = 1; }
            if (s2 > lm) { lm = s2; li = 2; }
            if (s3 > lm) { lm = s3; li = 3; }
            const float wmx = wave_max(lm);
            const unsigned long long bal = __ballot(lm == wmx);
            const int win = __ffsll((long long)bal) - 1;
            const float mysc = li == 0 ? sc0 : (li == 1 ? sc1 : (li == 2 ? sc2 : sc3));
            const int e = win * 4 + __builtin_amdgcn_readlane(li, win);
            const float se = __int_as_float(__builtin_amdgcn_readlane(__float_as_int(mysc), win));
            if (lane == win) { if (li == 0) s0 = NEG; else if (li == 1) s1 = NEG; else if (li == 2) s2 = NEG; else s3 = NEG; }
            if (lane == k) { my_e = e; my_s = se; }
            gsum += se;
        }
        if (lane < 8) {
            const int pos = atomicAdd(&cnt[my_e], 1);
            const size_t o = (size_t)t * 8 + lane;
            p.EIDX[o] = my_e; p.GATE[o] = my_s / gsum * 2.5f; p.POS[o] = pos;
        }
    }
}

__device__ __forceinline__ void phase_offsets(const Params& p, unsigned char* lds, int layer) {
    int* offs = (int*)lds;
    const int tid = threadIdx.x;
    const int rbase = layer == 0 ? 0 : NCTX; const int nrows = NT - rbase;
    const int* cnt = p.CNT + layer * 256;
    __syncthreads();
    if (tid == 0) { int a = 0; for (int e = 0; e < 256; ++e) { offs[e] = a; a += (cnt[e] + 255) & ~255; } offs[256] = a; }
    __syncthreads();
    const int ntr = offs[256] >> 8;
    if (blockIdx.x == 0) {
        if (tid == 0) p.META[layer * 64] = ntr;
        for (int i = tid; i < ntr; i += NTHR) { int lo = 0, hi = 255; const int s = i * 256; while (lo < hi) { const int mid = (lo + hi + 1) >> 1; if (offs[mid] <= s) lo = mid; else hi = mid - 1; }
            p.TILE_E[i] = lo; }
    }
    for (int i = blockIdx.x * NTHR + tid; i < nrows * 8; i += gridDim.x * NTHR) {
        const int e = p.EIDX[i]; const int slot = offs[e] + p.POS[i];
        p.SLOT_TOK[slot] = rbase + (i >> 3); p.SLOT_GATE[slot] = p.GATE[i]; p.TOKSLOT[i] = slot;
    }
    for (int i = blockIdx.x * NTHR + tid; i < nrows; i += gridDim.x * NTHR) p.SLOT_GATE[ntr * 256 + i] = 1.f;
    for (int e = blockIdx.x; e < 256; e += gridDim.x) {
        const int c = cnt[e], pe = (c + 255) & ~255;
        for (int s = c + tid; s < pe; s += NTHR) { p.SLOT_TOK[offs[e] + s] = rbase; p.SLOT_GATE[offs[e] + s] = 0.f; }
    }
}

__device__ __forceinline__ void phase_moe1(const Params& p, unsigned char* lds, int layer) {
    const int rbase = layer == 0 ? 0 : NCTX; const int nsh = (NT - rbase) / 256; const int ntr = p.META[layer * 64];
    mg8::MoeOrder S; S.ntr = ntr; S.npn = 2; S.nwg = (ntr + nsh) * 2; S.G = gridDim.x; S.c = blockIdx.x; S.K = 1024; S.rbase = rbase; S.gather = true;
    S.A = (const char*)p.U; S.Wexp = (const char*)(p.WT_W13 + (size_t)layer * 256 * 512 * 1024); S.wstride = (size_t)512 * 1024 * 2; S.Wsh = (const char*)(p.WT_SH13 + (size_t)layer * 512 * 1024);
    S.tile_e = p.TILE_E; S.slot_tok = p.SLOT_TOK;
    mg8::EpiAct E{p.ACT};
    mg8::gemm_phase<mg8::EpiAct, mg8::MoeOrder, true>((MG_LAS unsigned char*)lds, 1024, S, E);
}
__device__ __forceinline__ void phase_moe2(const Params& p, unsigned char* lds, int layer) {
    const int rbase = layer == 0 ? 0 : NCTX; const int nsh = (NT - rbase) / 256; const int ntr = p.META[layer * 64];
    mg8::MoeOrder S; S.ntr = ntr; S.npn = 4; S.nwg = (ntr + nsh) * 4; S.G = gridDim.x; S.c = blockIdx.x; S.K = 256; S.rbase = rbase; S.gather = false;
    S.A = (const char*)p.ACT; S.Wexp = (const char*)(p.WT_W2 + (size_t)layer * 256 * 1024 * 256); S.wstride = (size_t)1024 * 256 * 2; S.Wsh = (const char*)(p.WT_SH2 + (size_t)layer * 1024 * 256);
    S.tile_e = p.TILE_E; S.slot_tok = p.SLOT_TOK;
    mg8::EpiYs E{p.YS, p.SLOT_GATE, ntr};
    mg8::gemm_phase<mg8::EpiYs, mg8::MoeOrder, false>((MG_LAS unsigned char*)lds, 256, S, E);
}
__device__ __forceinline__ int cb_slot(int routed, int shared, int lane) { return lane == 8 ? shared : routed; }
__device__ __forceinline__ void phase_combine(const Params& p, int layer) {
    const int lane = threadIdx.x & 63, w = __builtin_amdgcn_readfirstlane(threadIdx.x >> 6);
    const int rbase = layer == 0 ? 0 : NCTX; const int nrows = NT - rbase;
    const int ntr = p.META[layer * 64];
    const float* lg = p.ln2_g + layer * DM; const float* lb = p.ln2_b + layer * DM;
    const int t0 = blockIdx.x * 8 + w, tstep = gridDim.x * 8;
#define CB_SLOT(tt) cb_slot(p.TOKSLOT[(size_t)(tt) * 8 + (lane & 7)], ntr * 256 + (tt), lane)
#define CB_LOAD(tt, sl, Y_, X_) do { _Pragma("unroll") for (int k = 0; k < 9; ++k) { const int slot_ = __builtin_amdgcn_readlane(sl, k); const unsigned char* yr_ = (const unsigned char*)p.YS + (size_t)slot_ * DM; \
        _Pragma("unroll") for (int i = 0; i < 4; ++i) Y_[k][i] = *(const int*)(yr_ + i * 256 + lane * 4); } \
        _Pragma("unroll") for (int i = 0; i < 4; ++i) X_[i] = *(const u32x2*)(p.X1 + (size_t)(rbase + (tt)) * DM + i * 256 + lane * 4); } while (0)
    int yA[9][4]; u32x2 xA[4];
    int slB = 0, slC = 0;
    if (t0 < nrows) { const int sl0 = CB_SLOT(t0); CB_LOAD(t0, sl0, yA, xA); }
    if (t0 + tstep < nrows) slB = CB_SLOT(t0 + tstep);
    for (int t = t0; t < nrows; t += tstep) {
        const int r = rbase + t;
        f32x4 mo[4];
#pragma unroll
        for (int i = 0; i < 4; ++i) mo[i] = (f32x4){0.f, 0.f, 0.f, 0.f};
#pragma unroll
        for (int k = 0; k < 9; ++k)
#pragma unroll
            for (int i = 0; i < 4; ++i) { const f32x2_t lo = __builtin_amdgcn_cvt_pk_f32_fp8(yA[k][i], false), hi = __builtin_amdgcn_cvt_pk_f32_fp8(yA[k][i], true);
                mo[i][0] += lo.x; mo[i][1] += lo.y; mo[i][2] += hi.x; mo[i][3] += hi.y; }
        const float* md = p.MOD + ((size_t)layer * 9 + row_mod(r)) * 6144 + 5120;
        f32x4 v[4]; float s = 0.f;
#pragma unroll
        for (int i = 0; i < 4; ++i) { const int col = i * 256 + lane * 4; v[i] = bf4_to_f32(xA[i]) * DN_ALPHA + *(const f32x4*)(md + col) * (mo[i] * (1.f / 64.f)); s += (v[i][0] + v[i][1]) + (v[i][2] + v[i][3]); }
        const float mean = wave_sum(s) * (1.f / 1024.f); float q = 0.f;
#pragma unroll
        for (int i = 0; i < 4; ++i) { const f32x4 d = v[i] - mean; q += (d[0] * d[0] + d[1] * d[1]) + (d[2] * d[2] + d[3] * d[3]); }
        const float rstd = rsqrtf(wave_sum(q) * (1.f / 1024.f) + 1e-5f);
        asm volatile("" ::: "memory");
        if (t + 2 * tstep < nrows) slC = CB_SLOT(t + 2 * tstep);
        if (t + tstep < nrows) CB_LOAD(t + tstep, slB, yA, xA);
        asm volatile("" ::: "memory");
#pragma unroll
        for (int i = 0; i < 4; ++i) { const int col = i * 256 + lane * 4; const f32x4 ov = (v[i] - mean) * rstd * *(const f32x4*)(lg + col) + *(const f32x4*)(lb + col);
            if (layer == 0) *(u32x2*)(p.X2 + (size_t)r * DM + col) = f32_to_bf4(ov); else *(f32x4*)(p.out + (size_t)t * DM + col) = ov;
            if (layer == 0) { const float* m1 = p.MOD + ((size_t)9 + row_mod(r)) * 6144; const f32x4 hv = ov * (*(const f32x4*)(m1 + 1024 + col) + 1.f) + *(const f32x4*)(m1 + col); *(u32x2*)(p.HIN + (size_t)r * DM + col) = f32_to_bf4(hv); } }
        asm volatile("" ::: "memory");
        slB = slC;
    }
#undef CB_SLOT
#undef CB_LOAD
}

typedef float f32x2 __attribute__((ext_vector_type(2)));
__device__ __forceinline__ f32x2 cmul(f32x2 a, f32x2 b) { return (f32x2){a.x * b.x - a.y * b.y, a.x * b.y + a.y * b.x}; }
#define SQH 0.70710678118654752f
__device__ __forceinline__ void fft_dif8(f32x2* X, const int q) {
    __syncthreads();
#pragma unroll 1
    for (int o = threadIdx.x; o < 1024; o += NTHR) {
        const int pp = o & (q - 1), base = ((o - pp) << 3) + pp;
        f32x2 x[8];
#pragma unroll
        for (int m = 0; m < 8; ++m) x[m] = X[base + m * q];
        const float rev = -(float)pp / (float)(8 * q);
        const f32x2 w1 = {__builtin_amdgcn_cosf(rev), __builtin_amdgcn_sinf(rev)}; const f32x2 w2 = cmul(w1, w1), w4 = cmul(w2, w2);
        { f32x2 a = x[0], b = x[4]; x[0] = a + b; x[4] = cmul(a - b, w1); }
        { f32x2 a = x[1], b = x[5]; x[1] = a + b; x[5] = cmul(a - b, cmul(w1, (f32x2){SQH, -SQH})); }
        { f32x2 a = x[2], b = x[6]; x[2] = a + b; x[6] = cmul(a - b, (f32x2){w1.y, -w1.x}); }
        { f32x2 a = x[3], b = x[7]; x[3] = a + b; x[7] = cmul(a - b, cmul(w1, (f32x2){-SQH, -SQH})); }
#pragma unroll
        for (int blk = 0; blk < 8; blk += 4) {
            { f32x2 a = x[blk], b = x[blk + 2]; x[blk] = a + b; x[blk + 2] = cmul(a - b, w2); }
            { f32x2 a = x[blk + 1], b = x[blk + 3]; x[blk + 1] = a + b; x[blk + 3] = cmul(a - b, (f32x2){w2.y, -w2.x}); }
        }
#pragma unroll
        for (int m = 0; m < 8; m += 2) { f32x2 a = x[m], b = x[m + 1]; x[m] = a + b; x[m + 1] = cmul(a - b, w4); }
#pragma unroll
        for (int m = 0; m < 8; ++m) X[base + m * q] = x[m];
    }
}
__device__ __forceinline__ void fft_dit8(f32x2* X, const int q) {
    __syncthreads();
#pragma unroll 1
    for (int o = threadIdx.x; o < 1024; o += NTHR) {
        const int pp = o & (q - 1), base = ((o - pp) << 3) + pp;
        f32x2 x[8];
#pragma unroll
        for (int m = 0; m < 8; ++m) x[m] = X[base + m * q];
        const float rev = (float)pp / (float)(8 * q);
        const f32x2 w1 = {__builtin_amdgcn_cosf(rev), __builtin_amdgcn_sinf(rev)}; const f32x2 w2 = cmul(w1, w1), w4 = cmul(w2, w2);
#pragma unroll
        for (int m = 0; m < 8; m += 2) { f32x2 a = x[m], b = cmul(x[m + 1], w4); x[m] = a + b; x[m + 1] = a - b; }
#pragma unroll
        for (int blk = 0; blk < 8; blk += 4) {
            { f32x2 a = x[blk], b = cmul(x[blk + 2], w2); x[blk] = a + b; x[blk + 2] = a - b; }
            { f32x2 a = x[blk + 1], b = cmul(x[blk + 3], (f32x2){-w2.y, w2.x}); x[blk + 1] = a + b; x[blk + 3] = a - b; }
        }
        { f32x2 a = x[0], b = cmul(x[4], w1); x[0] = a + b; x[4] = a - b; }
        { f32x2 a = x[1], b = cmul(x[5], cmul(w1, (f32x2){SQH, SQH})); x[1] = a + b; x[5] = a - b; }
        { f32x2 a = x[2], b = cmul(x[6], (f32x2){-w1.y, w1.x}); x[2] = a + b; x[6] = a - b; }
        { f32x2 a = x[3], b = cmul(x[7], cmul(w1, (f32x2){-SQH, SQH})); x[3] = a + b; x[7] = a - b; }
#pragma unroll
        for (int m = 0; m < 8; ++m) X[base + m * q] = x[m];
    }
}
__device__ __forceinline__ void fft_r2(f32x2* X) {
    __syncthreads();
#pragma unroll 1
    for (int k = threadIdx.x; k < 4096; k += NTHR) { const f32x4 v = *(const f32x4*)(X + 2 * k); *(f32x4*)(X + 2 * k) = (f32x4){v[0] + v[2], v[1] + v[3], v[0] - v[2], v[1] - v[3]}; }
}
__device__ __forceinline__ void fft_dif8_zp(f32x2* X) {
    constexpr int q = 1024;
    __syncthreads();
#pragma unroll 1
    for (int o = threadIdx.x; o < 1024; o += NTHR) {
        const int pp = o, base = o;
        f32x2 x[8];
#pragma unroll
        for (int m = 0; m < 4; ++m) x[m] = X[base + m * q];
        const float rev = -(float)pp / (float)(8 * q);
        const f32x2 w1 = {__builtin_amdgcn_cosf(rev), __builtin_amdgcn_sinf(rev)}; const f32x2 w2 = cmul(w1, w1), w4 = cmul(w2, w2);
        x[4] = cmul(x[0], w1);
        x[5] = cmul(x[1], cmul(w1, (f32x2){SQH, -SQH}));
        x[6] = cmul(x[2], (f32x2){w1.y, -w1.x});
        x[7] = cmul(x[3], cmul(w1, (f32x2){-SQH, -SQH}));
#pragma unroll
        for (int blk = 0; blk < 8; blk += 4) {
            { f32x2 a = x[blk], b = x[blk + 2]; x[blk] = a + b; x[blk + 2] = cmul(a - b, w2); }
            { f32x2 a = x[blk + 1], b = x[blk + 3]; x[blk + 1] = a + b; x[blk + 3] = cmul(a - b, (f32x2){w2.y, -w2.x}); }
        }
#pragma unroll
        for (int m = 0; m < 8; m += 2) { f32x2 a = x[m], b = x[m + 1]; x[m] = a + b; x[m + 1] = cmul(a - b, w4); }
#pragma unroll
        for (int m = 0; m < 8; ++m) X[base + m * q] = x[m];
    }
}
__device__ __forceinline__ void fft_dit8_half(f32x2* X) {
    constexpr int q = 1024;
    __syncthreads();
#pragma unroll 1
    for (int o = threadIdx.x; o < 1024; o += NTHR) {
        const int pp = o, base = o;
        f32x2 x[8];
#pragma unroll
        for (int m = 0; m < 8; ++m) x[m] = X[base + m * q];
        const float rev = (float)pp / (float)(8 * q);
        const f32x2 w1 = {__builtin_amdgcn_cosf(rev), __builtin_amdgcn_sinf(rev)}; const f32x2 w2 = cmul(w1, w1), w4 = cmul(w2, w2);
#pragma unroll
        for (int m = 0; m < 8; m += 2) { f32x2 a = x[m], b = cmul(x[m + 1], w4); x[m] = a + b; x[m + 1] = a - b; }
#pragma unroll
        for (int blk = 0; blk < 8; blk += 4) {
            { f32x2 a = x[blk], b = cmul(x[blk + 2], w2); x[blk] = a + b; x[blk + 2] = a - b; }
            { f32x2 a = x[blk + 1], b = cmul(x[blk + 3], (f32x2){-w2.y, w2.x}); x[blk + 1] = a + b; x[blk + 3] = a - b; }
        }
        X[base] = x[0] + cmul(x[4], w1);
        X[base + q] = x[1] + cmul(x[5], cmul(w1, (f32x2){SQH, SQH}));
        X[base + 2 * q] = x[2] + cmul(x[6], (f32x2){-w1.y, w1.x});
        X[base + 3 * q] = x[3] + cmul(x[7], cmul(w1, (f32x2){-SQH, SQH}));
    }
}
__device__ __forceinline__ void fft_fwd_zp(f32x2* X) { fft_dif8_zp(X); fft_dif8(X, 128); fft_dif8(X, 16); fft_dif8(X, 2); fft_r2(X); }
__device__ __forceinline__ void fft_inv_half(f32x2* X) { fft_r2(X); fft_dit8(X, 2); fft_dit8(X, 16); fft_dit8(X, 128); fft_dit8_half(X); }
__device__ __forceinline__ void fft_fwd(f32x2* X) { fft_dif8(X, 1024); fft_dif8(X, 128); fft_dif8(X, 16); fft_dif8(X, 2); fft_r2(X); }
__device__ __forceinline__ void fft_inv(f32x2* X) { fft_r2(X); fft_dit8(X, 2); fft_dit8(X, 16); fft_dit8(X, 128); fft_dit8(X, 1024); }

__device__ __forceinline__ void phase_filtfft(const Params& p, unsigned char* lds) {
    f32x2* X = (f32x2*)lds;
    for (int u = blockIdx.x; u < 1024; u += gridDim.x) {
        const float* g = p.G + (size_t)u * 8192;
        __syncthreads();
        for (int tau = threadIdx.x; tau < 8192; tau += NTHR) X[tau] = (f32x2){g[(tau + 4096) & 8191], 0.f};
        fft_fwd(X);
        __syncthreads();
        f32x2* o = p.FF + (size_t)u * 8192;
        for (int r = threadIdx.x; r < 8192; r += NTHR) o[r] = X[r] * (1.f / 8192.f);
    }
}
__device__ __forceinline__ void phase_shortconv(const Params& p, unsigned char* lds) {
    float* T = (float*)lds;
    const int tid = threadIdx.x, lane = tid & 63, w = tid >> 6;
    float v[10];
#define SC_LOAD(uu) do { const int ct_ = (uu) % 24, tt_ = ((uu) / 24) & 63, b_ = (uu) / (24 * 64); const int t0_ = tt_ * 64 + w * 8; \
        const bf16_t* pr_ = p.P + (size_t)(NCTX + b_ * 4096 + t0_) * ODW + ct_ * 64 + lane; \
        _Pragma("unroll") for (int k = 0; k < 10; ++k) { const int t = t0_ + k - 1; const bool ok_ = (t >= 0 && t < 4096); const bf16_t x_ = pr_[ok_ ? (ptrdiff_t)(k - 1) * ODW : 0]; v[k] = ok_ ? bf2f(x_) : 0.f; } } while (0)
    if ((int)blockIdx.x < 8 * 64 * 24) SC_LOAD((int)blockIdx.x);
    for (int u = blockIdx.x; u < 8 * 64 * 24; u += gridDim.x) {
        const int ct = u % 24, tt = (u / 24) & 63, b = u / (24 * 64);
        const int c = ct * 64 + lane;
        const float w0 = p.hy_conv_w[c], w1 = p.hy_conv_w[1536 + c], w2 = p.hy_conv_w[3072 + c], cb = p.hy_conv_b[c];
        float o[8];
#pragma unroll
        for (int k = 0; k < 8; ++k) o[k] = cb + v[k] * w0 + v[k + 1] * w1 + v[k + 2] * w2;
        if (u + (int)gridDim.x < 8 * 64 * 24) SC_LOAD(u + (int)gridDim.x);
        __syncthreads();
#pragma unroll
        for (int k = 0; k < 8; ++k) T[lane * 65 + w * 8 + k] = o[k];
        __syncthreads();
        const int cc = tid >> 3, seg = tid & 7; const int cg = ct * 64 + cc; const int plane = cg >> 9, cl = cg & 511;
        bf16_t* dst = p.UH + (((size_t)plane * 8 + b) * 512 + cl) * 4096 + tt * 64 + seg * 8;
        f32x4 o0, o1;
#pragma unroll
        for (int e = 0; e < 4; ++e) { o0[e] = T[cc * 65 + seg * 8 + e]; o1[e] = T[cc * 65 + seg * 8 + 4 + e]; }
        *(bf16x8*)dst = pack8(o0, o1);
    }
#undef SC_LOAD
}
__device__ __forceinline__ void phase_hyena(const Params& p, unsigned char* lds) {
    f32x2* X = (f32x2*)lds;
    const int tid = threadIdx.x;
    for (int u = blockIdx.x; u < 2048; u += gridDim.x) {
        const int c = u >> 2, b0 = (u & 3) * 2, b1 = b0 + 1;
        const bf16_t* v0p = p.UH + ((size_t)(0 * 8 + b0) * 512 + c) * 4096; const bf16_t* v1p = p.UH + ((size_t)(0 * 8 + b1) * 512 + c) * 4096;
        float zr[8], zi[8];
        __syncthreads();
#pragma unroll
        for (int k = 0; k < 8; ++k) { const int t = tid + NTHR * k; zr[k] = bf2f(v0p[t]); zi[k] = bf2f(v1p[t]); X[t] = (f32x2){zr[k], zi[k]}; }
#pragma unroll 1
        for (int n = 0; n < 2; ++n) {
            fft_fwd_zp(X);
            __syncthreads();
            const f32x2* ff = p.FF + ((size_t)n * 512 + c) * 8192;
            for (int r = tid; r < 8192; r += NTHR) X[r] = cmul(X[r], ff[r]);
            fft_inv_half(X);
            __syncthreads();
            const float bias = p.hy_bias[n * 512 + c];
            const bf16_t* g0p = p.UH + ((size_t)((n + 1) * 8 + b0) * 512 + c) * 4096; const bf16_t* g1p = p.UH + ((size_t)((n + 1) * 8 + b1) * 512 + c) * 4096;
#pragma unroll
            for (int k = 0; k < 8; ++k) {
                const int t = tid + NTHR * k; const f32x2 y = X[t];
                zr[k] = bf2f(g0p[t]) * (y.x + zr[k] * bias); zi[k] = bf2f(g1p[t]) * (y.y + zi[k] * bias);
                if (n == 0) { X[t] = (f32x2){zr[k], zi[k]}; }
                else { p.Z1[((size_t)b0 * 512 + c) * 4096 + t] = f2bf(zr[k]); p.Z1[((size_t)b1 * 512 + c) * 4096 + t] = f2bf(zi[k]); }
            }
        }
    }
}
__device__ __forceinline__ void phase_zt2y(const Params& p, unsigned char* lds) {
    float* T = (float*)lds;
    const int tid = threadIdx.x;
    for (int u = blockIdx.x; u < 8 * 64 * 8; u += gridDim.x) {
        const int ct = u & 7, tt = (u >> 3) & 63, b = u >> 9;
        const int cc = tid >> 3, seg = tid & 7;
        const bf16_t* src = p.Z1 + ((size_t)b * 512 + ct * 64 + cc) * 4096 + tt * 64 + seg * 8;
        const u32x4 iw = *(const u32x4*)src; const f32x4 i0 = bf4_to_f32((u32x2){iw.x, iw.y}), i1 = bf4_to_f32((u32x2){iw.z, iw.w});
        __syncthreads();
#pragma unroll
        for (int e = 0; e < 4; ++e) { T[cc * 65 + seg * 8 + e] = i0[e]; T[cc * 65 + seg * 8 + 4 + e] = i1[e]; }
        __syncthreads();
        const int t = tid >> 3, cs = tid & 7; f32x4 o0, o1;
#pragma unroll
        for (int e = 0; e < 4; ++e) { o0[e] = T[(cs * 8 + e) * 65 + t]; o1[e] = T[(cs * 8 + 4 + e) * 65 + t]; }
        *(bf16x8*)(p.Y + (size_t)(NCTX + b * 4096 + tt * 64 + t) * DM + ct * 64 + cs * 8) = pack8(o0, o1);
    }
}
struct RwRaw { f32x4 own, sh; };
__device__ __forceinline__ RwRaw rw_raw4(const Params& p, int r, int cc) {
    const bf16_t* pr = p.P + (size_t)r * ODW + 1536 + cc;
    const bool isctx = r < NCTX; const int t = isctx ? (r & 255) : ((r - NCTX) & 4095); const int gr = t >> 6, gc = t & 63;
    const bool v0 = isctx ? (t > 0) : (gc > 0), v1 = isctx ? (t < 255) : (gc < 63), v2 = isctx ? (t > 0) : (gr > 0), v3 = isctx ? (t < 255) : (gr < 63);
    const int o2 = isctx ? -ODW : -64 * ODW, o3 = isctx ? ODW : 64 * ODW;
    const bf16_t x0 = pr[v0 ? -ODW : 0], x1 = pr[(v1 ? ODW : 0) + 1], x2 = pr[(v2 ? o2 : 0) + 2], x3 = pr[(v3 ? o3 : 0) + 3];
    RwRaw R; R.own = bf4_to_f32(*(const u32x2*)pr);
    R.sh[0] = v0 ? bf2f(x0) : 0.f; R.sh[1] = v1 ? bf2f(x1) : 0.f; R.sh[2] = v2 ? bf2f(x2) : 0.f; R.sh[3] = v3 ? bf2f(x3) : 0.f;
    return R;
}
__device__ __forceinline__ f32x4 rw_mix(const RwRaw& R, const f32x4 mu4) { return R.own + mu4 * (R.sh - R.own); }
__device__ __forceinline__ f32x4 rw_mix4(const Params& p, int r, int cc) { const RwRaw R = rw_raw4(p, r, cc); return rw_mix(R, *(const f32x4*)(p.rw_mu + cc)); }
__device__ __forceinline__ float fsig(float x) { return __builtin_amdgcn_rcpf(1.f + __expf(-x)); }
__device__ __forceinline__ void phase_rwstreams(const Params& p, unsigned char* lds) {
    constexpr int XS = 328, KS = 520;
    constexpr int TR = 64;
    bf16_t* X = (bf16_t*)lds;
    float* ss = (float*)(X + TR * XS);
    bf16_t* KMX = (bf16_t*)(ss + TR * 8);
    const int tid = threadIdx.x, lane = tid & 63, h = tid >> 6, q4 = lane >> 4, l15 = lane & 15;
    for (int ti = blockIdx.x; ti < NT / TR; ti += gridDim.x) {
        const int tile = mg8::xcd_remap(ti, NT / TR);
        const int r0 = tile * TR;
        __syncthreads();
#pragma unroll 5
        for (int it = tid; it < TR * 80; it += NTHR) {
            const int row = it / 80, qd = it % 80, cc = qd * 4;
            f32x4 v = rw_mix4(p, r0 + row, 1536 + cc);
            if (cc < 128) {
#pragma unroll
                for (int e = 0; e < 4; ++e) v[e] = 1.f - 2.f * __builtin_amdgcn_rcpf(1.f + __expf(2.f * v[e]));
            } else if (cc >= 192) {
#pragma unroll
                for (int e = 0; e < 4; ++e) v[e] = fsig(v[e]);
            }
            u32x2 wv; wv.x = pk2(v[0], v[1]); wv.y = pk2(v[2], v[3]);
            *(u32x2*)(X + row * XS + cc) = wv;
        }
        {
            RwRaw cur[6], nxt[6];
#pragma unroll
            for (int j = 0; j < 6; ++j) { const int it = tid + j * NTHR; nxt[j] = rw_raw4(p, r0 + it / 384, (it % 384) * 4); }
#pragma unroll 1
            for (int bt = 0; bt < TR * 384 / (6 * NTHR); ++bt) {
#pragma unroll
                for (int j = 0; j < 6; ++j) cur[j] = nxt[j];
                if (bt + 1 < TR * 384 / (6 * NTHR)) {
#pragma unroll
                    for (int j = 0; j < 6; ++j) { const int it = tid + ((bt + 1) * 6 + j) * NTHR; nxt[j] = rw_raw4(p, r0 + it / 384, (it % 384) * 4); }
                }
                asm volatile("" ::: "memory");
#pragma unroll
                for (int j = 0; j < 6; ++j) {
                    const int it = tid + (bt * 6 + j) * NTHR; const int row = it / 384, qd = it % 384; const int r = r0 + row;
                    const f32x4 v = rw_mix(cur[j], *(const f32x4*)(p.rw_mu + qd * 4));
                    if (qd < 128) *(u32x2*)(p.RR + (size_t)r * 512 + qd * 4) = f32_to_bf4(v);
                    else if (qd >= 256) *(u32x2*)(p.VV + (size_t)r * 512 + (qd - 256) * 4) = f32_to_bf4(v);
                    else {
                        const int kq = qd - 128;
                        const f32x4 kr = v * *(const f32x4*)(p.rw_k_k + kq * 4);
                        float sacc = (kr[0] * kr[0] + kr[1] * kr[1]) + (kr[2] * kr[2] + kr[3] * kr[3]);
                        sacc += DPPF(sacc, 0xB1, 0xF); sacc += DPPF(sacc, 0x4E, 0xF); sacc += DPPF(sacc, 0x141, 0xF); sacc += DPPF(sacc, 0x140, 0xF);
                        if ((lane & 15) == 0) ss[row * 8 + (kq >> 4)] = sacc;
                        *(u32x2*)(KMX + row * KS + kq * 4) = f32_to_bf4(v);
                    }
                }
                asm volatile("" ::: "memory");
            }
        }
        __syncthreads();
#pragma unroll 4
        for (int it = tid; it < TR * 128; it += NTHR) {
            const int row = it >> 7, kq = it & 127;
            const u32x2 mk = *(const u32x2*)(KMX + row * KS + kq * 4);
            const f32x4 k4 = {__uint_as_float(mk.x << 16), __uint_as_float(mk.x & 0xffff0000u), __uint_as_float(mk.y << 16), __uint_as_float(mk.y & 0xffff0000u)};
            const float rn = __builtin_amdgcn_rsqf(fmaxf(ss[row * 8 + (kq >> 4)], 1e-24f));
            *(u32x2*)(p.KK + (size_t)(r0 + row) * 512 + kq * 4) = f32_to_bf4(k4 * *(const f32x4*)(p.rw_k_k + kq * 4) * rn);
        }
#pragma unroll 1
        for (int ct = 0; ct < 4; ++ct) {
            const int c0 = h * 64 + ct * 16 + q4 * 4;
            const int cw = h * 64 + ct * 16 + l15;
            bf16x8 wf[2], wb[2], wa[2], wg[4];
#pragma unroll
            for (int ks = 0; ks < 2; ++ks) { wf[ks] = *(const bf16x8*)(p.WT_RWF + (size_t)cw * 64 + ks * 32 + q4 * 8); wb[ks] = *(const bf16x8*)(p.WT_RWB + (size_t)cw * 64 + ks * 32 + q4 * 8); wa[ks] = *(const bf16x8*)(p.WT_RWA + (size_t)cw * 64 + ks * 32 + q4 * 8); }
#pragma unroll
            for (int ks = 0; ks < 4; ++ks) wg[ks] = *(const bf16x8*)(p.WT_RWG + (size_t)cw * 128 + ks * 32 + q4 * 8);
            const f32x4 w0f = *(const f32x4*)(p.rw_w0 + c0), w0b = *(const f32x4*)(p.rw_w0 + 512 + c0), a0 = *(const f32x4*)(p.rw_a0 + c0), kkw = *(const f32x4*)(p.rw_k_k + c0), kaw = *(const f32x4*)(p.rw_k_a + c0);
#pragma unroll 1
            for (int rt = 0; rt < TR / 16; ++rt) {
                const int rloc = rt * 16 + l15; const int row = r0 + rloc;
                f32x4 aF = {0.f, 0.f, 0.f, 0.f}, aB = aF, aA = aF, aG = aF;
                const bf16_t* xr = X + rloc * XS + q4 * 8;
#pragma unroll
                for (int ks = 0; ks < 2; ++ks) {
                    aF = __builtin_amdgcn_mfma_f32_16x16x32_bf16(wf[ks], *(const bf16x8*)(xr + ks * 32), aF, 0, 0, 0);
                    aB = __builtin_amdgcn_mfma_f32_16x16x32_bf16(wb[ks], *(const bf16x8*)(xr + 64 + ks * 32), aB, 0, 0, 0);
                    aA = __builtin_amdgcn_mfma_f32_16x16x32_bf16(wa[ks], *(const bf16x8*)(xr + 128 + ks * 32), aA, 0, 0, 0);
                }
#pragma unroll
                for (int ks = 0; ks < 4; ++ks) aG = __builtin_amdgcn_mfma_f32_16x16x32_bf16(wg[ks], *(const bf16x8*)(xr + 192 + ks * 32), aG, 0, 0, 0);
                const u32x2 mk = *(const u32x2*)(KMX + rloc * KS + c0);
                const f32x4 k4 = {__uint_as_float(mk.x << 16), __uint_as_float(mk.x & 0xffff0000u), __uint_as_float(mk.y << 16), __uint_as_float(mk.y & 0xffff0000u)};
                const float rn = __builtin_amdgcn_rsqf(fmaxf(ss[rloc * 8 + h], 1e-24f));
                const size_t o = (size_t)row * 512 + c0;
                f32x4 ldf, ldb, bvv, kp;
#pragma unroll
                for (int e = 0; e < 4; ++e) {
                    ldf[e] = -0.60653065971f * fsig(w0f[e] + aF[e]); ldb[e] = -0.60653065971f * fsig(w0b[e] + aB[e]);
                    const float av = fsig(a0[e] + aA[e]);
                    bvv[e] = k4[e] * kkw[e] * rn * av; kp[e] = k4[e] * (1.f + (av - 1.f) * kaw[e]);
                }
                *(u32x2*)(p.DEC + o) = f32_to_bf4(ldf); *(u32x2*)(p.DEC + (size_t)NT * 512 + o) = f32_to_bf4(ldb);
                *(u32x2*)(p.BV + o) = f32_to_bf4(bvv); *(u32x2*)(p.KP + o) = f32_to_bf4(kp); *(u32x2*)(p.GT + o) = f32_to_bf4(aG + 0.f);
            }
        }
    }
}
#define RW_NUNIT 8704
__device__ __forceinline__ void phase_rwprep(const Params& p, unsigned char* lds) {
    constexpr int SL = 64 * 72;
    float* MT = (float*)lds;
    float* ptot = MT + 64 * 68;
    float* gcv = ptot + 512;
    bf16_t* L = (bf16_t*)(gcv + 64);
    bf16_t *sBp = L, *sKp = L + SL, *sKKm = L + 2 * SL, *sRg = L + 3 * SL, *sBpT = L + 4 * SL, *sKpT = L + 5 * SL, *sKKmT = L + 6 * SL, *sVT = L + 7 * SL, *sNT = L + 8 * SL, *sArT = L + 9 * SL, *sNrT = L + 10 * SL;
    bf16_t *sX2 = sBp, *sTmT = sKp, *sWn = sKKm, *sU2n = sNT;
    const int tid = threadIdx.x, lane = tid & 63, w = tid >> 6, q4 = lane >> 4, l15 = lane & 15;
    float pld[8]; bf16_t pkk[8], pbv[8], pkp[8], prr[8], pvv[8];
#define RWP_LOAD(uu) do { const int c_ = (uu) % 68, h_ = ((uu) / 68) & 7, b_ = ((uu) / (68 * 8)) & 7, dir_ = (uu) / (68 * 64); \
        _Pragma("unroll") for (int tt = 0; tt < 8; ++tt) { const size_t o_ = (size_t)row_of(dir_, b_, c_ * 64 + w * 8 + tt) * 512 + h_ * 64 + lane; \
            pld[tt] = bf2f(p.DEC[(size_t)dir_ * NT * 512 + o_]); pkk[tt] = p.KK[o_]; pbv[tt] = p.BV[o_]; pkp[tt] = p.KP[o_]; prr[tt] = p.RR[o_]; pvv[tt] = p.VV[o_]; } } while (0)
    if ((int)blockIdx.x < RW_NUNIT) RWP_LOAD((int)blockIdx.x);
    for (int u = blockIdx.x; u < RW_NUNIT; u += gridDim.x) {
        const int c = u % 68, h = (u / 68) & 7, b = (u / (68 * 8)) & 7, dir = u / (68 * 64);
        __syncthreads();
        {
            const int k = lane, part = w;
            float lcv[8], ldv[8], kkv[8], bvv[8], kpv[8], rv[8]; float lc = 0.f;
#pragma unroll
            for (int tt = 0; tt < 8; ++tt) {
                ldv[tt] = pld[tt]; kkv[tt] = bf2f(pkk[tt]); bvv[tt] = bf2f(pbv[tt]); kpv[tt] = bf2f(pkp[tt]); rv[tt] = bf2f(prr[tt]);
                lc += ldv[tt]; lcv[tt] = lc;
            }
            ptot[part * 64 + k] = lc;
            *(bf16x8*)(sVT + lane * 72 + w * 8) = pack8((f32x4){bf2f(pvv[0]), bf2f(pvv[1]), bf2f(pvv[2]), bf2f(pvv[3])}, (f32x4){bf2f(pvv[4]), bf2f(pvv[5]), bf2f(pvv[6]), bf2f(pvv[7])});
            __syncthreads();
            float off = 0.f, tot = 0.f;
#pragma unroll
            for (int pp = 0; pp < 8; ++pp) { const float tv = ptot[pp * 64 + k]; if (pp < part) off += tv; tot += tv; }
            if (part == 0) gcv[k] = __expf(tot);
            float xa[8], xb[8], xc[8];
#pragma unroll
            for (int tt = 0; tt < 8; ++tt) {
                const int j = part * 8 + tt; const float lw = lcv[tt] + off;
                const float eg = __expf(lw), ig = __expf(-lw), egm = __expf(lw - ldv[tt]);
                xa[tt] = kkv[tt] * egm; xb[tt] = bvv[tt] * ig; xc[tt] = kpv[tt] * ig;
                sKKm[j * 72 + k] = f2bf(xa[tt]); sBp[j * 72 + k] = f2bf(xb[tt]); sKp[j * 72 + k] = f2bf(xc[tt]); sRg[j * 72 + k] = f2bf(rv[tt] * eg);
            }
            *(bf16x8*)(sKKmT + k * 72 + part * 8) = pack8((f32x4){xa[0], xa[1], xa[2], xa[3]}, (f32x4){xa[4], xa[5], xa[6], xa[7]});
            *(bf16x8*)(sBpT + k * 72 + part * 8) = pack8((f32x4){xb[0], xb[1], xb[2], xb[3]}, (f32x4){xb[4], xb[5], xb[6], xb[7]});
            *(bf16x8*)(sKpT + k * 72 + part * 8) = pack8((f32x4){xc[0], xc[1], xc[2], xc[3]}, (f32x4){xc[4], xc[5], xc[6], xc[7]});
        }
        __syncthreads();
#pragma unroll
        for (int rep = 0; rep < 2; ++rep) {
            const int pos = w + rep * 8, tt_ = pos >> 2, jt_ = pos & 3;
            f32x4 aM = {0.f, 0.f, 0.f, 0.f}, aN = aM, aA = aM, aR = aM;
#pragma unroll
            for (int ks = 0; ks < 2; ++ks) {
                const bf16x8 fbp = *(const bf16x8*)(sBp + (jt_ * 16 + l15) * 72 + ks * 32 + q4 * 8), fkp = *(const bf16x8*)(sKp + (jt_ * 16 + l15) * 72 + ks * 32 + q4 * 8);
                const bf16x8 fkk = *(const bf16x8*)(sKKm + (tt_ * 16 + l15) * 72 + ks * 32 + q4 * 8), frg = *(const bf16x8*)(sRg + (tt_ * 16 + l15) * 72 + ks * 32 + q4 * 8);
                aM = __builtin_amdgcn_mfma_f32_16x16x32_bf16(fbp, fkk, aM, 0, 0, 0); aN = __builtin_amdgcn_mfma_f32_16x16x32_bf16(fkp, fkk, aN, 0, 0, 0);
                aA = __builtin_amdgcn_mfma_f32_16x16x32_bf16(fbp, frg, aA, 0, 0, 0); aR = __builtin_amdgcn_mfma_f32_16x16x32_bf16(fkp, frg, aR, 0, 0, 0);
            }
            const int t = tt_ * 16 + l15, j0 = jt_ * 16 + q4 * 4;
#pragma unroll
            for (int e = 0; e < 4; ++e) { const bool st = (j0 + e) < t, le = (j0 + e) <= t; aM[e] = st ? aM[e] : 0.f; aN[e] = st ? aN[e] : 0.f; aA[e] = le ? aA[e] : 0.f; aR[e] = le ? aR[e] : 0.f; }
#pragma unroll
            for (int e = 0; e < 4; ++e) MT[t * 68 + ((j0 + e) & 7) * 8 + ((j0 + e) >> 3)] = aM[e];
            u32x2 wv; wv.x = pk2(aN[0], aN[1]); wv.y = pk2(aN[2], aN[3]); *(u32x2*)(sNT + t * 72 + j0) = wv;
            wv.x = pk2(aA[0], aA[1]); wv.y = pk2(aA[2], aA[3]); *(u32x2*)(sArT + t * 72 + j0) = wv;
            wv.x = pk2(aR[0], aR[1]); wv.y = pk2(aR[2], aR[3]); *(u32x2*)(sNrT + t * 72 + j0) = wv;
        }
        __syncthreads();
        {
#pragma unroll
            for (int rep = 0; rep < 2; ++rep) {
                const int tile = w * 2 + rep, vt_ = tile >> 2, tt_ = tile & 3;
                f32x4 acc = {0.f, 0.f, 0.f, 0.f};
#pragma unroll
                for (int ks = 0; ks < 2; ++ks) {
                    const bf16x8 fa = *(const bf16x8*)(sNT + (tt_ * 16 + l15) * 72 + ks * 32 + q4 * 8), fb = *(const bf16x8*)(sVT + (vt_ * 16 + l15) * 72 + ks * 32 + q4 * 8);
                    acc = __builtin_amdgcn_mfma_f32_16x16x32_bf16(fa, fb, acc, 0, 0, 0);
                }
                u32x2 wv; wv.x = pk2(acc[0], acc[1]); wv.y = pk2(acc[2], acc[3]); *(u32x2*)(sX2 + (vt_ * 16 + l15) * 72 + tt_ * 16 + q4 * 4) = wv;
            }
            const int srow = w * 8 + (lane >> 3), sub = lane & 7;
            float tm8[8];
#pragma unroll
            for (int jj = 0; jj < 8; ++jj) tm8[jj] = 0.f;
#pragma unroll
            for (int tb = 0; tb < 8; ++tb) {
                f32x4 mA[8], mB[8];
#pragma unroll
                for (int e = 0; e < 8; ++e) { mA[e] = *(const f32x4*)(MT + (tb * 8 + e) * 68 + sub * 8); if (tb >= 4) mB[e] = *(const f32x4*)(MT + (tb * 8 + e) * 68 + sub * 8 + 4); else mB[e] = (f32x4){0.f, 0.f, 0.f, 0.f}; }
#pragma unroll
                for (int e = 0; e < 8; ++e) {
                    const int t = tb * 8 + e;
                    float part = tm8[0] * mA[e][0], part1 = 0.f;
                    if (t > 8) part1 = tm8[1] * mA[e][1];
                    if (t > 16) part += tm8[2] * mA[e][2];
                    if (t > 24) part1 += tm8[3] * mA[e][3];
                    if (t > 32) part += tm8[4] * mB[e][0];
                    if (t > 40) part1 += tm8[5] * mB[e][1];
                    if (t > 48) part += tm8[6] * mB[e][2];
                    if (t > 56) part1 += tm8[7] * mB[e][3];
                    part += part1;
                    part += __int_as_float(__builtin_amdgcn_update_dpp(0, __float_as_int(part), 0xB1, 0xF, 0xF, false));
                    part += __int_as_float(__builtin_amdgcn_update_dpp(0, __float_as_int(part), 0x4E, 0xF, 0xF, false));
                    part += __int_as_float(__builtin_amdgcn_update_dpp(0, __float_as_int(part), 0x141, 0xF, 0xF, false));
                    const float sacc = ((t == srow) ? 1.f : 0.f) - part;
                    if (sub == (t & 7)) { tm8[t >> 3] = sacc; sTmT[t * 72 + srow] = f2bf(sacc); }
                }
            }
        }
        __syncthreads();
#pragma unroll
        for (int rep = 0; rep < 4; ++rep) {
            const int tile = w * 4 + rep, it_ = tile >> 2, tt_ = tile & 3;
            const bf16_t* rhs = it_ < 4 ? sKKmT + (it_ * 16 + l15) * 72 : sX2 + ((it_ - 4) * 16 + l15) * 72;
            f32x4 acc = {0.f, 0.f, 0.f, 0.f};
#pragma unroll
            for (int ks = 0; ks < 2; ++ks) {
                const bf16x8 fa = *(const bf16x8*)(sTmT + (tt_ * 16 + l15) * 72 + ks * 32 + q4 * 8), fb = *(const bf16x8*)(rhs + ks * 32 + q4 * 8);
                acc = __builtin_amdgcn_mfma_f32_16x16x32_bf16(fa, fb, acc, 0, 0, 0);
            }
            bf16_t* dst = it_ < 4 ? sWn + (it_ * 16 + l15) * 72 : sU2n + ((it_ - 4) * 16 + l15) * 72;
            u32x2 wv; wv.x = pk2(-acc[0], -acc[1]); wv.y = pk2(-acc[2], -acc[3]); *(u32x2*)(dst + tt_ * 16 + q4 * 4) = wv;
        }
        __syncthreads();
        { const int un = u + (int)gridDim.x < RW_NUNIT ? u + (int)gridDim.x : u; RWP_LOAD(un); }
        asm volatile("" ::: "memory");
        {
            const int kind = w >> 1;
            bf16_t* GM = p.GMT + (size_t)u * 4096; bf16_t* QM = p.QMT + (size_t)u * 4096; bf16_t* HM = p.HMB + (size_t)u * 4096; bf16_t* OM = p.OMB + (size_t)u * 4096;
#pragma unroll 1
            for (int rep = 0; rep < 8; ++rep) {
                const int tile = (w & 1) * 8 + rep, rt_ = tile >> 2, ct_ = tile & 3;
                const bf16_t* bmat = (kind < 2) ? sBpT : sArT;
                const bf16_t* amat = (kind == 0 || kind == 2) ? sWn : sU2n;
                f32x4 acc = {0.f, 0.f, 0.f, 0.f};
                if (kind == 0 || kind == 2) {
#pragma unroll
                    for (int ks = 0; ks < 2; ++ks) {
                        const bf16x8 fa = *(const bf16x8*)(amat + (ct_ * 16 + l15) * 72 + ks * 32 + q4 * 8), fb = *(const bf16x8*)(bmat + (rt_ * 16 + l15) * 72 + ks * 32 + q4 * 8);
                        acc = __builtin_amdgcn_mfma_f32_16x16x32_bf16(fa, fb, acc, 0, 0, 0);
                    }
                    const int r = rt_ * 16 + l15, cc = ct_ * 16 + q4 * 4;
                    if (kind == 0) { const float g = gcv[r]; u32x2 wv; wv.x = pk2(g * ((cc == r ? 1.f : 0.f) + acc[0]), g * ((cc + 1 == r ? 1.f : 0.f) + acc[1])); wv.y = pk2(g * ((cc + 2 == r ? 1.f : 0.f) + acc[2]), g * ((cc + 3 == r ? 1.f : 0.f) + acc[3])); *(u32x2*)(GM + r * 64 + cc) = wv; }
                    else { const u32x2 rg = *(const u32x2*)(sRg + r * 72 + cc);
                        u32x2 wv; wv.x = pk2(acc[0] + __uint_as_float(rg.x << 16), acc[1] + __uint_as_float(rg.x & 0xffff0000u)); wv.y = pk2(acc[2] + __uint_as_float(rg.y << 16), acc[3] + __uint_as_float(rg.y & 0xffff0000u)); *(u32x2*)(QM + r * 64 + cc) = wv; }
                } else {
                    const bf16_t* b2 = (kind == 1) ? sKpT : sNrT;
#pragma unroll
                    for (int ks = 0; ks < 2; ++ks) {
                        const bf16x8 fa = *(const bf16x8*)(bmat + (rt_ * 16 + l15) * 72 + ks * 32 + q4 * 8), fb = *(const bf16x8*)(amat + (ct_ * 16 + l15) * 72 + ks * 32 + q4 * 8);
                        acc = __builtin_amdgcn_mfma_f32_16x16x32_bf16(fa, fb, acc, 0, 0, 0);
                        const bf16x8 fa2 = *(const bf16x8*)(b2 + (rt_ * 16 + l15) * 72 + ks * 32 + q4 * 8), fb2 = *(const bf16x8*)(sVT + (ct_ * 16 + l15) * 72 + ks * 32 + q4 * 8);
                        acc = __builtin_amdgcn_mfma_f32_16x16x32_bf16(fa2, fb2, acc, 0, 0, 0);
                    }
                    const int vv = ct_ * 16 + l15, r0 = rt_ * 16 + q4 * 4;
                    if (kind == 1) { const f32x4 g4 = *(const f32x4*)(gcv + r0); acc = acc * g4; }
                    u32x2 wv; wv.x = pk2(acc[0], acc[1]); wv.y = pk2(acc[2], acc[3]);
                    *(u32x2*)((kind == 1 ? HM : OM) + vv * 64 + r0) = wv;
                }
            }
        }
    }
}
#undef RWP_LOAD
__device__ __forceinline__ void phase_rwseq(const Params& p) {
    const int tid = threadIdx.x, lane = tid & 63, w = tid >> 6, q4 = lane >> 4, l15 = lane & 15;
    if (w >= 4) return;
    const int vs = w;
    for (int unit = blockIdx.x; unit < 128; unit += gridDim.x) {
        const int h = unit & 7, b = (unit >> 3) & 7, dir = unit >> 6;
        f32x4 Sacc[4];
#pragma unroll
        for (int t = 0; t < 4; ++t) Sacc[t] = (f32x4){0.f, 0.f, 0.f, 0.f};
        u32x2 gA[4][2][2], qA[4][2][2], gB[4][2][2], qB[4][2][2]; u32x2 hA[4], oA[4], hB[4], oB[4];
#define RWS_LOAD(cc, G_, Q_, H_, O_) do { const size_t cu = (size_t)unit * 68 + (cc); \
        const bf16_t* GM = p.GMT + cu * 4096; const bf16_t* HM = p.HMB + cu * 4096; \
        _Pragma("unroll") for (int kt_ = 0; kt_ < 4; ++kt_) { _Pragma("unroll") for (int ks = 0; ks < 2; ++ks) { \
            G_[kt_][ks][0] = *(const u32x2*)(GM + (kt_ * 16 + l15) * 64 + ks * 32 + q4 * 4); G_[kt_][ks][1] = *(const u32x2*)(GM + (kt_ * 16 + l15) * 64 + ks * 32 + 16 + q4 * 4); } \
            H_[kt_] = *(const u32x2*)(HM + (vs * 16 + l15) * 64 + kt_ * 16 + q4 * 4); } \
        if ((cc) >= 4) { const bf16_t* QM = p.QMT + cu * 4096; const bf16_t* OM = p.OMB + cu * 4096; \
        _Pragma("unroll") for (int kt_ = 0; kt_ < 4; ++kt_) { _Pragma("unroll") for (int ks = 0; ks < 2; ++ks) { \
            Q_[kt_][ks][0] = *(const u32x2*)(QM + (kt_ * 16 + l15) * 64 + ks * 32 + q4 * 4); Q_[kt_][ks][1] = *(const u32x2*)(QM + (kt_ * 16 + l15) * 64 + ks * 32 + 16 + q4 * 4); } \
            O_[kt_] = *(const u32x2*)(OM + (vs * 16 + l15) * 64 + kt_ * 16 + q4 * 4); } } } while (0)
#define RWS_COMP(cc, G_, Q_, H_, O_) do { bf16x8 sb[2]; \
        _Pragma("unroll") for (int ks = 0; ks < 2; ++ks) sb[ks] = pack8(Sacc[2 * ks], Sacc[2 * ks + 1]); \
        if ((cc) >= 4) { _Pragma("unroll") for (int tt_ = 0; tt_ < 4; ++tt_) { f32x4 acc = {__uint_as_float(O_[tt_].x << 16), __uint_as_float(O_[tt_].x & 0xffff0000u), __uint_as_float(O_[tt_].y << 16), __uint_as_float(O_[tt_].y & 0xffff0000u)}; \
            _Pragma("unroll") for (int ks = 0; ks < 2; ++ks) { u32x4 a4; a4.x = Q_[tt_][ks][0].x; a4.y = Q_[tt_][ks][0].y; a4.z = Q_[tt_][ks][1].x; a4.w = Q_[tt_][ks][1].y; \
                acc = __builtin_amdgcn_mfma_f32_16x16x32_bf16(__builtin_bit_cast(bf16x8, a4), sb[ks], acc, 0, 0, 0); } \
            _Pragma("unroll") for (int e = 0; e < 4; ++e) { const int row = row_of(dir, b, (cc) * 64 + tt_ * 16 + q4 * 4 + e); p.O[((size_t)dir * NT + row) * 512 + h * 64 + vs * 16 + l15] = f2bf(acc[e]); } } } \
        _Pragma("unroll") for (int kt_ = 0; kt_ < 4; ++kt_) { f32x4 acc = {__uint_as_float(H_[kt_].x << 16), __uint_as_float(H_[kt_].x & 0xffff0000u), __uint_as_float(H_[kt_].y << 16), __uint_as_float(H_[kt_].y & 0xffff0000u)}; \
            _Pragma("unroll") for (int ks = 0; ks < 2; ++ks) { u32x4 a4; a4.x = G_[kt_][ks][0].x; a4.y = G_[kt_][ks][0].y; a4.z = G_[kt_][ks][1].x; a4.w = G_[kt_][ks][1].y; \
                acc = __builtin_amdgcn_mfma_f32_16x16x32_bf16(__builtin_bit_cast(bf16x8, a4), sb[ks], acc, 0, 0, 0); } \
            Sacc[kt_] = acc; } } while (0)
        RWS_LOAD(0, gA, qA, hA, oA);
#pragma unroll 1
        for (int c = 0; c < 68; c += 2) {
            RWS_LOAD(c + 1, gB, qB, hB, oB);
            RWS_COMP(c, gA, qA, hA, oA);
            if (c + 2 < 68) RWS_LOAD(c + 2, gA, qA, hA, oA);
            RWS_COMP(c + 1, gB, qB, hB, oB);
        }
#undef RWS_LOAD
#undef RWS_COMP
    }
}
__device__ __forceinline__ void phase_readout1(const Params& p) {
    const int lane = threadIdx.x & 63, h = __builtin_amdgcn_readfirstlane(threadIdx.x >> 6);
    const float lg = p.rw_ln_g[h * 64 + lane], lb = p.rw_ln_b[h * 64 + lane], rk = p.rw_r_k[h * 64 + lane];
    float n0[4], n1[4]; bf16_t nr[4], nk[4], nvv[4], ngt[4];
#define RO1_LOAD(bi) do { _Pragma("unroll") for (int j = 0; j < 4; ++j) { const size_t o_ = (size_t)(NCTX + (bi) * 4 + j) * 512 + h * 64 + lane; \
        n0[j] = bf2f(p.O[o_]); n1[j] = bf2f(p.O[(size_t)NT * 512 + o_]); nr[j] = p.RR[o_]; nk[j] = p.KP[o_]; nvv[j] = p.VV[o_]; ngt[j] = p.GT[o_]; } } while (0)
    if ((int)blockIdx.x < NLAT / 4) RO1_LOAD((int)blockIdx.x);
    for (int bi = blockIdx.x; bi < NLAT / 4; bi += gridDim.x) {
        float c0[4], c1[4]; bf16_t cr[4], ck[4], cvv[4], cgt[4];
#pragma unroll
        for (int j = 0; j < 4; ++j) { c0[j] = n0[j]; c1[j] = n1[j]; cr[j] = nr[j]; ck[j] = nk[j]; cvv[j] = nvv[j]; cgt[j] = ngt[j]; }
        if (bi + (int)gridDim.x < NLAT / 4) RO1_LOAD(bi + (int)gridDim.x);
        asm volatile("" ::: "memory");
#pragma unroll
        for (int j = 0; j < 4; ++j) {
            const float ov = c0[j] + c1[j];
            const float mean = wave_sum(ov) * (1.f / 64.f); const float d = ov - mean;
            const float var = wave_sum(d * d) * (1.f / 64.f);
            const float on = d * rsqrtf(var + 64e-5f) * lg + lb;
            const float bonus = wave_sum(bf2f(cr[j]) * bf2f(ck[j]) * rk) * bf2f(cvv[j]);
            p.Y[(size_t)(NCTX + bi * 4 + j) * DM + 512 + h * 64 + lane] = f2bf((on + bonus) * bf2f(cgt[j]));
        }
        asm volatile("" ::: "memory");
    }
#undef RO1_LOAD
}

#ifdef PROBE_BUF
__global__ void __launch_bounds__(NTHR) k_probe(Params p) { for (size_t i = (size_t)blockIdx.x * NTHR + threadIdx.x; i < (size_t)NLAT * DM; i += (size_t)gridDim.x * NTHR) {
        float z;
#if PROBE_KIND == 1
        const unsigned q = ((unsigned)i >> 1); z = 0.f; if (q < (unsigned)(NT * 8)) z = (i & 1) ? p.GATE[q] : (float)p.EIDX[q];
#elif PROBE_KIND == 2
        const unsigned q = (unsigned)i; const unsigned ts = q >> 8; z = bf2f(p.ACT[(size_t)p.TOKSLOT[ts] * 256 + (q & 255)]);
#elif PROBE_KIND == 4
        const unsigned q = (unsigned)i; const unsigned ts = q >> 10; z = bf2f(p.YS[((size_t)p.META[0] * 256 + ts) * 1024 + (q & 1023)]);
#elif PROBE_KIND == 6
        const unsigned q = (unsigned)i; const unsigned ts = q >> 8; z = 0.f; if (ts < NT) z = bf2f(p.ACT[((size_t)p.META[0] * 256 + ts) * 256 + (q & 255)]);
#elif PROBE_KIND == 7
        const unsigned q = (unsigned)i; z = 0.f; if (q < 2u * 256u * 1024u) z = p.sh_w2[q]; else if (q < 2u * 256u * 1024u + 2u * 1024u * 512u) z = p.sh_w13[q - 2u * 256u * 1024u];
#elif PROBE_KIND == 5
        const unsigned q = (unsigned)i; const unsigned ts = (q >> 10) * 8 + 3; z = bf2f(p.YS[(size_t)p.TOKSLOT[ts] * 1024 + (q & 1023)]);
#elif PROBE_KIND == 3
        const unsigned q = (unsigned)i; const unsigned ts = q >> 8; z = bf2f(p.YS[(size_t)p.TOKSLOT[ts] * 1024 + (q & 255)]);
#else
        const float* src = (const float*)p.PROBE_BUF; z = src[i + PROBE_OFF];
#endif
        if (!(fabsf(z) < 1e4f)) z = 100.f; p.out[i] = z; } }
#endif

#define XB_TMO      128
#define XB_XCNT(j)  (256  + 64 * (j))
#define XB_XSUB(j)  (1280 + 64 * (j))
#define XB_XGEN(j)  (2304 + 64 * (j))
#define XB_TOP      3328
#define XB_TOPGEN   3392
#define XCD_BAR_WORDS 3456
#define XB_SPIN_CAP (1u << 18)
#define LAS __attribute__((address_space(3)))

__device__ __forceinline__ unsigned xb_ld(unsigned* p)              { return __hip_atomic_load(p, __ATOMIC_RELAXED, __HIP_MEMORY_SCOPE_AGENT); }
__device__ __forceinline__ unsigned xb_add(unsigned* p, unsigned v) { return __hip_atomic_fetch_add(p, v, __ATOMIC_RELAXED, __HIP_MEMORY_SCOPE_AGENT); }
__device__ __forceinline__ unsigned xb_xcc_id() { return (unsigned)__builtin_amdgcn_s_getreg((3 << 11) | 20) & 0xFu; }
#define XB_SPIN(cond, bar) do { unsigned _sp = 0; while (cond) { __builtin_amdgcn_s_sleep(1); \
    if ((++_sp & 255u) == 0u) { if (xb_ld(&(bar)[XB_TMO])) break; if (_sp > XB_SPIN_CAP) { atomicAdd(&(bar)[XB_TMO], 1u); break; } } } } while (0)

struct XcdBarrier {
    unsigned* bar; unsigned x;
    volatile LAS unsigned* st;
};

__device__ __forceinline__ XcdBarrier xcd_barrier_post(unsigned* bar, volatile LAS unsigned* st) {
    XcdBarrier b; b.bar = bar; b.x = xb_xcc_id(); b.st = st;
    if (threadIdx.x == 0) (void)xb_add(&bar[XB_XCNT(b.x)], 1u);
    return b;
}
__device__ __forceinline__ void xcd_barrier_complete(unsigned* bar, unsigned x, unsigned& nloc, unsigned& nx) {
    const unsigned G = gridDim.x * gridDim.y * gridDim.z;
    unsigned sum, cnt, mine, sp = 0u;
    for (;;) {
        sum = 0u; cnt = 0u; mine = 0u;
#pragma unroll
        for (unsigned j = 0; j < 16; ++j) { const unsigned c = xb_ld(&bar[XB_XCNT(j)]); sum += c; cnt += (c > 0u) ? 1u : 0u; mine = (j == x) ? c : mine; }
        if (sum == G) break;
        __builtin_amdgcn_s_sleep(1);
        if ((++sp & 255u) == 0u) { if (xb_ld(&bar[XB_TMO])) break; if (sp > XB_SPIN_CAP) { atomicAdd(&bar[XB_TMO], 1u); break; } }
    }
    nloc = mine > 0u ? mine : 1u; nx = cnt > 0u ? cnt : 1u;
}

__device__ __forceinline__ void xcd_barrier(const XcdBarrier& b) {
    asm volatile("s_waitcnt vmcnt(0)" ::: "memory");
    __syncthreads();
    if (threadIdx.x == 0) {
        unsigned* bar = b.bar;
        __builtin_amdgcn_s_waitcnt(0);
        unsigned nloc = b.st[0], nx = b.st[1];
        if (nloc == 0u) { xcd_barrier_complete(bar, b.x, nloc, nx); b.st[0] = nloc; b.st[1] = nx; }
        const unsigned old = xb_add(&bar[XB_XSUB(b.x)], 1u);
        const unsigned gen = old / nloc;
        if (old + 1u == (gen + 1u) * nloc) {
            __builtin_amdgcn_fence(__ATOMIC_RELEASE, "agent");
            asm volatile("s_waitcnt vmcnt(0)" ::: "memory");
            const unsigned og = xb_add(&bar[XB_TOP], 1u);
            const unsigned tg = og / nx;
            if (og + 1u == (tg + 1u) * nx) xb_add(&bar[XB_TOPGEN], 1u);
            else XB_SPIN(xb_ld(&bar[XB_TOPGEN]) == tg, bar);
            __builtin_amdgcn_fence(__ATOMIC_ACQUIRE, "agent");
            xb_add(&bar[XB_XGEN(b.x)], 1u);
            asm volatile("s_waitcnt vmcnt(0)" ::: "memory");
        } else {
            XB_SPIN(xb_ld(&bar[XB_XGEN(b.x)]) == gen, bar);
            __builtin_amdgcn_fence(__ATOMIC_ACQUIRE, "agent");
            asm volatile("s_waitcnt vmcnt(0)" ::: "memory");
        }
    }
    __syncthreads();
}


__global__ void __launch_bounds__(NTHR, 2) k_fwd(Params p_, int lo, int hi) {
#if defined(__HIP_DEVICE_COMPILE__)
    typedef const __attribute__((address_space(4))) Params* KP;
    const KP kp0 = (KP)__builtin_amdgcn_kernarg_segment_ptr();
#define LOADP KP kq = kp0; asm volatile("" : "+s"(kq)); Params p; __builtin_memcpy(&p, kq, sizeof(Params));
#else
#define LOADP const Params& p = p_;
#endif
    extern __shared__ __attribute__((aligned(16))) unsigned char lds[];
    if (threadIdx.x < 4) ((unsigned*)(lds + 147456))[threadIdx.x] = 0u;
    __syncthreads();
    XcdBarrier bar; bar.bar = nullptr; bar.x = 0; bar.st = nullptr;
#if defined(__HIP_DEVICE_COMPILE__)
    if (hi - lo > 1) bar = xcd_barrier_post((unsigned*)kp0->BAR, (volatile LAS unsigned*)(lds + 147456));
#endif
#define SEAM(k) if (lo <= (k) && (k) + 1 < hi) xcd_barrier(bar);
#ifndef ONLY
#define ONLY -1
#endif
#define IN(k) ((ONLY < 0 || ONLY == (k)) && lo <= (k) && (k) < hi)
#ifndef DUPMASK
#define DUPMASK 0u
#endif
#define PH(k, ...) if (IN(k)) { LOADP __VA_ARGS__ } SEAM(k) if ((DUPMASK >> (k)) & 1u) { xcd_barrier(bar); if (IN(k)) { LOADP __VA_ARGS__ } xcd_barrier(bar); }
    PH(0, if (blockIdx.x == 0) { for (int e = threadIdx.x; e < 512; e += NTHR) p.CNT[e] = 0; if (threadIdx.x < 128) p.META[threadIdx.x] = 0; } phase_mod(p, lds); phase_filt(p, lds); phase_convw(p, lds, 0, blockIdx.x, gridDim.x);)
    PH(2, phase_filtfft(p, lds); phase_hin0(p);)
    PH(1, phase_inproj(p, lds, 0);)
    PH(3, phase_rec0(p, lds);)
    PH(4, phase_readout0(p);)
    PH(5, phase_outproj(p, lds, 0);)
    PH(6, phase_ln1(p, 0);)
    PH(7, phase_router(p, lds, 0);)
    PH(8, phase_select(p, 0);)
    PH(9, phase_offsets(p, lds, 0);)
    PH(10, phase_moe1(p, lds, 0);)
    PH(11, phase_moe2(p, lds, 0);)
    PH(12, phase_combine(p, 0);)
    PH(13, phase_inproj(p, lds, 1);)
    PH(14, phase_shortconv(p, lds); phase_rwstreams(p, lds);)
    PH(15, phase_hyena(p, lds);)
    PH(16, phase_rwprep(p, lds);)
    PH(17, if (blockIdx.x >= 128 && gridDim.x > 128) phase_convw(p, lds, 1, blockIdx.x - 128, gridDim.x - 128); else { phase_rwseq(p); if (gridDim.x <= 128) phase_convw(p, lds, 1, blockIdx.x, gridDim.x); })
    PH(18, phase_readout1(p); phase_zt2y(p, lds);)
    PH(19, phase_outproj(p, lds, 1);)
    PH(20, phase_ln1(p, 1);)
    PH(21, phase_router(p, lds, 1);)
    PH(22, phase_select(p, 1);)
    PH(23, phase_offsets(p, lds, 1);)
    PH(24, phase_moe1(p, lds, 1);)
    PH(25, phase_moe2(p, lds, 1);)
    PH(26, phase_combine(p, 1);)
#undef IN
}
#define N_PHASES 28
#define LDS_BYTES (147456 + 64)

extern "C" void kernel_launch(void* const* d_in, const int* in_sizes, int n_in, void* d_out, int out_size, void* d_ws, size_t ws_size, hipStream_t stream) {
    Params p;
    memset(&p, 0, sizeof(p));
    if (n_in != 45) { fprintf(stderr, "kernel_launch: expected 45 inputs, got %d\n", n_in); return; }
    const float** pin = (const float**)&p;
    for (int i = 0; i < 45; ++i) pin[i] = (const float*)d_in[i];
    p.out = (float*)d_out;
    size_t off = 0;
    unsigned char* ws = (unsigned char*)d_ws;
    auto take = [&](size_t bytes) { void* r = ws + off; off += (bytes + 255) & ~(size_t)255; return r; };
    p.BAR = (unsigned*)take(16384);
    p.CNT = (int*)take(2 * 256 * 4);
    p.META = (int*)take(2 * 64 * 4);
    const size_t zero_bytes = off;
    p.MOD = (float*)take((size_t)2 * 9 * 6144 * 4);
    p.G = (float*)take((size_t)2 * 8192 * 512 * 4);
    p.P = (bf16_t*)take((size_t)NT * EVW * 4);
    p.LA = nullptr;
    p.O = (bf16_t*)take((size_t)2 * NT * 1024 * 2);
    p.Y = (bf16_t*)take((size_t)NT * 1024 * 2);
    p.PRE = (bf16_t*)take((size_t)NT * 1024 * 2);
    p.X1 = (bf16_t*)take((size_t)NT * 1024 * 2);
    p.U = (bf16_t*)take((size_t)NT * 1024 * 2);
    p.LOGITS = (float*)take((size_t)NT * 256 * 4);
    p.EIDX = (int*)take((size_t)NT * 8 * 4); p.GATE = (float*)take((size_t)NT * 8 * 4); p.POS = (int*)take((size_t)NT * 8 * 4); p.TOKSLOT = (int*)take((size_t)NT * 8 * 4);
    p.TILE_E = (int*)take(2048 * 4);
    p.SLOT_TOK = (int*)take((size_t)MAXSLOT * 4); p.SLOT_GATE = (float*)take((size_t)MAXSLOT * 4);
    unsigned char* regA = (unsigned char*)take((size_t)MAXSLOT * 1024 * 2 + (size_t)MAXSLOT * 256 * 2);
    p.YS = (bf16_t*)regA; p.ACT = (bf16_t*)(regA + (size_t)MAXSLOT * 1024 * 2);
    { size_t o2 = 0; auto sub = [&](size_t bytes) { void* r = regA + o2; o2 += (bytes + 255) & ~(size_t)255; return r; };
      p.UH = (bf16_t*)sub((size_t)NLAT * 1536 * 2); p.Z1 = (bf16_t*)sub((size_t)NLAT * 512 * 2);
      p.RR = (bf16_t*)sub((size_t)NT * 512 * 2); p.KP = (bf16_t*)sub((size_t)NT * 512 * 2); p.VV = (bf16_t*)sub((size_t)NT * 512 * 2);
      p.KK = (bf16_t*)sub((size_t)NT * 512 * 2); p.BV = (bf16_t*)sub((size_t)NT * 512 * 2); p.GT = (bf16_t*)sub((size_t)NT * 512 * 2);
      p.DEC = (bf16_t*)sub((size_t)2 * NT * 512 * 2);
      if (o2 > (size_t)MAXSLOT * 1024 * 2 + (size_t)MAXSLOT * 256 * 2) { fprintf(stderr, "kernel_launch: region A overflow\n"); return; } }
    { unsigned char* rp = (unsigned char*)p.P; p.GMT = (bf16_t*)rp; p.QMT = (bf16_t*)(rp + (size_t)RW_NUNIT * 4096 * 2); p.HMB = (bf16_t*)(rp + (size_t)RW_NUNIT * 4096 * 4); p.OMB = (bf16_t*)(rp + (size_t)RW_NUNIT * 4096 * 6); }
    p.X2 = (bf16_t*)take((size_t)NT * 1024 * 2);
    p.FF = (f32x2_p)take((size_t)2 * 512 * 8192 * 8);
    p.HIN = (bf16_t*)take((size_t)NT * 1024 * 2);
    p.WT_EVIN = (bf16_t*)take((size_t)4352 * 1024 * 2); p.WT_EVOUT = (bf16_t*)take((size_t)1024 * 1024 * 2);
    p.WT_ODIN = (bf16_t*)take((size_t)3584 * 1024 * 2); p.WT_ODOUT = (bf16_t*)take((size_t)1024 * 1024 * 2);
    p.WT_ROUT = (bf16_t*)take((size_t)2 * 256 * 1024 * 2); p.WT_SH13 = (bf16_t*)take((size_t)2 * 512 * 1024 * 2); p.WT_SH2 = (bf16_t*)take((size_t)2 * 1024 * 256 * 2);
    p.WT_RWF = (bf16_t*)take(512 * 64 * 2); p.WT_RWB = (bf16_t*)take(512 * 64 * 2); p.WT_RWA = (bf16_t*)take(512 * 64 * 2); p.WT_RWG = (bf16_t*)take(512 * 128 * 2);
    p.WT_W13 = (bf16_t*)take((size_t)2 * 256 * 512 * 1024 * 2); p.WT_W2 = (bf16_t*)take((size_t)2 * 256 * 1024 * 256 * 2);
    if (off > ws_size) { fprintf(stderr, "kernel_launch: workspace too small: need %zu, have %zu\n", off, ws_size); return; }
    static bool attr_done = false;
    if (!attr_done) { (void)hipFuncSetAttribute((const void*)k_fwd, hipFuncAttributeMaxDynamicSharedMemorySize, LDS_BYTES); attr_done = true; }
    (void)hipMemsetAsync(d_ws, 0, zero_bytes, stream);
#ifdef PROBE_BUF
    for (int ph = 0; ph <= PROBE_UPTO; ++ph) hipLaunchKernelGGL(k_fwd, dim3(256), dim3(NTHR), LDS_BYTES, stream, p, ph, ph + 1);
    hipLaunchKernelGGL(k_fwd, dim3(256), dim3(NTHR), LDS_BYTES, stream, p, 98, 99);
    hipLaunchKernelGGL(k_fwd, dim3(256), dim3(NTHR), LDS_BYTES, stream, p, 98, 99);
    hipLaunchKernelGGL(k_probe, dim3(1024), dim3(NTHR), 0, stream, p);
#else
#ifdef MULTI_LAUNCH
    for (int ph = 0; ph < N_PHASES; ++ph) {
        hipLaunchKernelGGL(k_fwd, dim3(256), dim3(NTHR), LDS_BYTES, stream, p, ph, ph + 1);
    }
#else
    static int grid = 0;
    if (grid == 0) {
        int dev = 0, cus = 0, per_cu = 0;
        (void)hipGetDevice(&dev); (void)hipDeviceGetAttribute(&cus, hipDeviceAttributeMultiprocessorCount, dev);
        if (hipOccupancyMaxActiveBlocksPerMultiprocessor(&per_cu, (const void*)k_fwd, NTHR, LDS_BYTES) != hipSuccess || per_cu < 1) { fprintf(stderr, "kernel_launch: occupancy query says %d blocks per CU\n", per_cu); per_cu = 1; }
        (void)hipGetLastError();
        grid = cus > 0 ? cus : 256;
    }
    hipLaunchKernelGGL(k_fwd, dim3(grid), dim3(NTHR), LDS_BYTES, stream, p, 0, N_PHASES);
#endif
#endif
}
```

```cpp
#include <hip/hip_runtime.h>
#include <stdint.h>
#include <stdio.h>
#include <string.h>

typedef unsigned short bf16_t;
typedef short bf16x8 __attribute__((ext_vector_type(8)));
typedef float f32x4 __attribute__((ext_vector_type(4)));
typedef unsigned u32x4 __attribute__((ext_vector_type(4)));
typedef unsigned u32x2 __attribute__((ext_vector_type(2)));

#define NTHR 512
#define DM 1024
#define NB 8
#define SEQ 4096
#define CTXL 256
#define NCTX (NB * CTXL)
#define NLAT (NB * SEQ)
#define NT (NCTX + NLAT)
#define EVW 4128
#define ODW 3392
#define MAXSLOT 378880
#define DN_ALPHA 1.41421356237f
#define NPHASE 40

typedef float __attribute__((ext_vector_type(2)))* f32x2_p;
struct Params {
    const float *x, *c, *ctx, *c_ctx, *mod_w, *mod_b, *ln1_g, *ln1_b, *ln2_g, *ln2_b;
    const float *ev_w_in, *ev_w_out, *gla_gate_w2, *gla_gate_b, *gla_norm_g, *hg_lb_logits, *hg_norm_g;
    const float *od_w_in, *od_w_out, *hy_conv_w, *hy_conv_b, *hy_ffn_w1, *hy_ffn_b1, *hy_ffn_w2, *hy_ffn_b2, *hy_ffn_w3, *hy_sin_freq, *hy_bias;
    const float *rw_mu, *rw_w0, *rw_w2, *rw_a0, *rw_a2, *rw_g2, *rw_k_k, *rw_k_a, *rw_r_k, *rw_ln_g, *rw_ln_b;
    const float *router_w, *router_bias, *exp_w13, *exp_w2, *sh_w13, *sh_w2;
    float* out;
    float* MOD;
    float* G;
    bf16_t* P;
    float* LA;
    bf16_t* O;
    bf16_t* Y;
    bf16_t* PRE;
    bf16_t* X1;
    bf16_t* U;
    float* LOGITS;
    int* EIDX; float* GATE; int* POS; int* TOKSLOT;
    int* CNT;
    int* META;
    int* TILE_E;
    int* SLOT_TOK; float* SLOT_GATE;
    bf16_t* ACT;
    bf16_t* ACT_SH;
    bf16_t* YS;
    bf16_t* X2;
    f32x2_p FF;
    bf16_t* UH;
    bf16_t* Z1;
    bf16_t *RR, *KP, *VV, *KK, *BV, *GT;
    bf16_t* DEC;
    bf16_t *GMT, *QMT, *HMB, *OMB;
    bf16_t* HIN;
    bf16_t *WT_RWF, *WT_RWB, *WT_RWA, *WT_RWG;
    bf16_t *WT_EVIN, *WT_EVOUT, *WT_ODIN, *WT_ODOUT, *WT_ROUT, *WT_SH13, *WT_SH2, *WT_W13, *WT_W2;
    unsigned* BAR;
};

typedef float f32x2_t __attribute__((ext_vector_type(2)));
typedef __bf16 bf16x2_t __attribute__((ext_vector_type(2)));
__device__ __forceinline__ unsigned pk2(float lo, float hi) { const f32x2_t v = {lo, hi}; return __builtin_bit_cast(unsigned, __builtin_convertvector(v, bf16x2_t)); }
__device__ __forceinline__ bf16x8 pack8(f32x4 a, f32x4 b) { u32x4 w; w.x = pk2(a[0], a[1]); w.y = pk2(a[2], a[3]); w.z = pk2(b[0], b[1]); w.w = pk2(b[2], b[3]); return __builtin_bit_cast(bf16x8, w); }
__device__ __forceinline__ float bf2f(bf16_t h) { return __uint_as_float((unsigned)h << 16); }
__device__ __forceinline__ f32x4 bf4_to_f32(u32x2 w) { return (f32x4){__uint_as_float(w.x << 16), __uint_as_float(w.x & 0xffff0000u), __uint_as_float(w.y << 16), __uint_as_float(w.y & 0xffff0000u)}; }
__device__ __forceinline__ u32x2 f32_to_bf4(f32x4 v) { u32x2 w; w.x = pk2(v[0], v[1]); w.y = pk2(v[2], v[3]); return w; }
__device__ __forceinline__ bf16_t f2bf(float f) { return (bf16_t)(pk2(f, 0.f) & 0xffffu); }
__device__ __forceinline__ float sigmoid_f(float x) { return 1.f / (1.f + expf(-x)); }
__device__ __forceinline__ float silu_f(float x) { return x / (1.f + expf(-x)); }
__device__ __forceinline__ float logsigmoid_f(float x) { return x >= 0.f ? -log1pf(expf(-x)) : x - log1pf(expf(x)); }
#define DPPF(v, ctrl, rmask) __int_as_float(__builtin_amdgcn_update_dpp(0, __float_as_int(v), (ctrl), (rmask), 0xF, false))
__device__ __forceinline__ float wave_sum(float v) {
    v += DPPF(v, 0xB1, 0xF); v += DPPF(v, 0x4E, 0xF); v += DPPF(v, 0x141, 0xF); v += DPPF(v, 0x140, 0xF);
    v += DPPF(v, 0x142, 0xA); v += DPPF(v, 0x143, 0xC);
    return __int_as_float(__builtin_amdgcn_readlane(__float_as_int(v), 63));
}
__device__ __forceinline__ float wave_max(float v) {
    const float NEGI = -__builtin_inff();
#define DPPM(v, ctrl, rmask) __int_as_float(__builtin_amdgcn_update_dpp(__float_as_int(NEGI), __float_as_int(v), (ctrl), (rmask), 0xF, false))
    v = fmaxf(v, DPPM(v, 0xB1, 0xF)); v = fmaxf(v, DPPM(v, 0x4E, 0xF)); v = fmaxf(v, DPPM(v, 0x141, 0xF)); v = fmaxf(v, DPPM(v, 0x140, 0xF));
    v = fmaxf(v, DPPM(v, 0x142, 0xA)); v = fmaxf(v, DPPM(v, 0x143, 0xC));
#undef DPPM
    return __int_as_float(__builtin_amdgcn_readlane(__float_as_int(v), 63));
}
__device__ __forceinline__ int row_of(int dir, int b, int s) {
    if (s < CTXL) { const int pos = dir ? (CTXL - 1 - s) : s; return b * CTXL + pos; }
    const int q = s - CTXL; const int pos = dir ? (SEQ - 1 - q) : q; return NCTX + b * SEQ + pos;
}
__device__ __forceinline__ int row_mod(int r) { return r < NCTX ? 8 : ((r - NCTX) >> 12); }
__device__ __forceinline__ const float* xin_row(const Params& p, int layer, int r) {
    return r < NCTX ? p.ctx + (size_t)r * DM : p.x + (size_t)(r - NCTX) * DM;
}

namespace mg8 {
#define MG_LAS __attribute__((address_space(3)))
constexpr int BM = 256, BK = 64, HALF = 128, HTB = HALF * BK * 2, STAGE_BYTES = 8 * HTB, NXCD = 8, WGM = 8;
__host__ __device__ __forceinline__ int lds_byte(int r, int c) { const int st = (r >> 4) * 2 + (c >> 5), rr = r & 15, cc = c & 31, ob = rr * 64 + cc * 2; return st * 1024 + (ob ^ (((ob >> 9) & 1) << 5)); }
__host__ __device__ __forceinline__ void stage_rc(int b, int& R, int& C) { const int st = b / 1024, sb = b % 1024, swz = sb ^ (((sb >> 9) & 1) << 5); R = (st >> 1) * 16 + swz / 64; C = (st & 1) * 32 + (swz % 64) / 2; }
__host__ __device__ __forceinline__ int perm32(int rho) { const int n = rho >> 4, i = rho & 15; return 8 * (i >> 2) + 4 * n + (i & 3); }
struct Unit { int pm, pn; const char* A; const char* B; const int* gidx; };
__device__ __forceinline__ int xcd_remap(int wgid, int nwg) { const int q = nwg / NXCD, r = nwg % NXCD, xcd = wgid % NXCD, off = wgid / NXCD; return (xcd < r ? xcd * (q + 1) : r * (q + 1) + (xcd - r) * q) + off; }
struct DenseOrder {
    int nM, nN, nwg, G, c; const char* A; const char* Bt; size_t tstep;
    __device__ void init(const bf16_t* A_, const bf16_t* Bt_, int M, int N, int K, int G_, int c_) { nM = M / BM; nN = N / BM; nwg = nM * nN; G = G_; c = c_; A = (const char*)A_; Bt = (const char*)Bt_; tstep = (size_t)BM * K * 2; }
    __device__ bool next(int i, Unit& u) const {
        const long L = (long)i * G + c; if (L >= nwg) return false;
        const int wgid = xcd_remap((int)L, nwg);
        const int nig = WGM * nN, gid = wgid / nig, fm = gid * WGM, gsz = (nM - fm) < WGM ? (nM - fm) : WGM;
        u.pm = fm + ((wgid % nig) % gsz); u.pn = (wgid % nig) / gsz; u.A = A + (size_t)u.pm * tstep; u.B = Bt + (size_t)u.pn * tstep; u.gidx = nullptr; return true;
    }
};
struct MoeOrder {
    int ntr, npn, nwg, G, c, K, rbase; bool gather; const char* A; const char* Ash; const char* Wexp; size_t wstride; const char* Wsh; const int* tile_e; const int* slot_tok;
    __device__ bool next(int i, Unit& u) const {
        const long L = (long)i * G + c; if (L >= nwg) return false;
        const int wv = xcd_remap((int)L, nwg); const int tile = wv / npn, pn = wv % npn; const size_t tstep = (size_t)BM * K * 2;
        u.pm = tile; u.pn = pn; u.gidx = nullptr;
        if (tile < ntr) { const int e = tile_e[tile]; u.B = Wexp + (size_t)e * wstride + (size_t)pn * tstep; if (gather) { u.A = A; u.gidx = slot_tok + tile * 256; } else u.A = A + (size_t)tile * tstep; }
        else { u.B = Wsh + (size_t)pn * tstep; u.A = gather ? A + (size_t)(rbase + (tile - ntr) * 256) * K * 2 : Ash + (size_t)(tile - ntr) * tstep; }
        return true;
    }
};
template <class Epi, class Sched, bool GATHER>
__device__ __forceinline__ void gemm_phase(MG_LAS unsigned char* lds, const int K, const Sched& S, const Epi& E) {
    const int tid = threadIdx.x, wid = __builtin_amdgcn_readfirstlane(tid >> 6), lane = tid & 63, wr = wid >> 2, wc = wid & 3, fr = lane & 15, fq = lane >> 4;
    const int nt = K / BK;
    int RR[2], CC[2]; unsigned voffB[2], vA[2][2], vN[2][2];
#pragma unroll
    for (int i = 0; i < 2; ++i) { int R, C; stage_rc(tid * 16 + i * 8192, R, C); RR[i] = R; CC[i] = C; const int Rb = Epi::PERM ? ((R & ~31) + perm32(R & 31)) : R; voffB[i] = (unsigned)(Rb * K + C) * 2u; }
#define MG_MKV(v, u) do { _Pragma("unroll") for (int _h = 0; _h < 2; ++_h) _Pragma("unroll") for (int _i = 0; _i < 2; ++_i) { const int _row = _h * HALF + RR[_i]; \
        const int _src = (GATHER && (u).gidx) ? (u).gidx[_row] : _row; v[_h][_i] = (unsigned)(_src * K + CC[_i]) * 2u; } } while (0)
    const size_t kstep = (size_t)(BK * 2);
    const size_t hstep = (size_t)HALF * K * 2;
    const unsigned ldsw = (unsigned)wid * 1024u;
    const int aoff = lds_byte(wr * 64 + fr, fq * 8), boff = lds_byte(wc * 32 + fr, fq * 8);
#define MG_SA(b, h) (((b) * 2 + (h)) * HTB)
#define MG_SB(b, h) ((4 + (b) * 2 + (h)) * HTB)
#define MG_STAGE(bufoff, gbase, voff) do { _Pragma("unroll") for (int _i = 0; _i < 2; ++_i) \
        __builtin_amdgcn_global_load_lds((const unsigned*)((const char*)(gbase) + (voff)[_i]), (MG_LAS unsigned*)(lds + (bufoff) + ldsw + _i * 8192), 16, 0, 0); } while (0)
#define MG_LDA(dst, b, h) do { _Pragma("unroll") for (int m = 0; m < 4; ++m) _Pragma("unroll") for (int k = 0; k < 2; ++k) dst[m][k] = *(const MG_LAS bf16x8*)(lds + MG_SA(b, h) + aoff + m * 2048 + k * 1024); } while (0)
#define MG_LDB(dst, b, h) do { _Pragma("unroll") for (int n = 0; n < 2; ++n) _Pragma("unroll") for (int k = 0; k < 2; ++k) dst[n][k] = *(const MG_LAS bf16x8*)(lds + MG_SB(b, h) + boff + n * 2048 + k * 1024); } while (0)
#define MG_MMA(ai, bj, At, Bt) do { __builtin_amdgcn_s_setprio(1); _Pragma("unroll") for (int m = 0; m < 4; ++m) _Pragma("unroll") for (int n = 0; n < 2; ++n) _Pragma("unroll") for (int k = 0; k < 2; ++k) \
        acc[ai][bj][m][n] = __builtin_amdgcn_mfma_f32_16x16x32_bf16(Bt[n][k], At[m][k], acc[ai][bj][m][n], 0, 0, 0); __builtin_amdgcn_s_setprio(0); } while (0)
#define MG_WAIT_V(n) asm volatile("s_waitcnt vmcnt(" #n ")" ::: "memory")
#define MG_WAIT_L(n) asm volatile("s_waitcnt lgkmcnt(" #n ")" ::: "memory")
#define MG_BAR __builtin_amdgcn_s_barrier()
#define MG_SCHED __builtin_amdgcn_sched_barrier(0)
    Unit cur, nxt; int ui = 0;
    if (!S.next(0, cur)) return;
    f32x4 acc[2][2][4][2];
#pragma unroll
    for (int a = 0; a < 2; ++a)
#pragma unroll
        for (int b = 0; b < 2; ++b)
#pragma unroll
            for (int m = 0; m < 4; ++m)
#pragma unroll
                for (int n = 0; n < 2; ++n) acc[a][b][m][n] = (f32x4){0.f, 0.f, 0.f, 0.f};
    bf16x8 At[4][2], B0[2][2], B1[2][2];
    const char* cA = cur.A; const char* cB = cur.B;
    MG_MKV(vA, cur);
    MG_STAGE(MG_SB(0, 0), cB, voffB); MG_STAGE(MG_SB(0, 1), cB + hstep, voffB); MG_STAGE(MG_SA(0, 0), cA, vA[0]); MG_STAGE(MG_SA(0, 1), cA, vA[1]);
    if (wr == 1) MG_BAR;
    MG_WAIT_V(2); MG_BAR;
    MG_STAGE(MG_SB(1, 0), cB + kstep, voffB); MG_STAGE(MG_SA(1, 0), cA + kstep, vA[0]); MG_STAGE(MG_SB(1, 1), cB + hstep + kstep, voffB);
    MG_WAIT_V(6); MG_BAR;
    for (;;) {
        const bool has_next = S.next(ui + 1, nxt);
        const char* nA = has_next ? nxt.A : cA; const char* nB = has_next ? nxt.B : cB;
#pragma unroll 1
        for (int t = 0; t < nt; t += 2) {
            const bool last = (t == nt - 2);
            const char* a1 = cA + (size_t)(t + 1) * kstep;
            const char* a2 = last ? nA : cA + (size_t)(t + 2) * kstep; const char* b2 = last ? nB : cB + (size_t)(t + 2) * kstep;
            const char* a3 = a2 + kstep; const char* b3 = b2 + kstep;
            unsigned x0[2], x1[2];
            if constexpr (GATHER) {
                if (last) { if (has_next) { MG_MKV(vN, nxt); } else {
#pragma unroll
                    for (int h = 0; h < 2; ++h)
#pragma unroll
                        for (int i = 0; i < 2; ++i) vN[h][i] = vA[h][i]; } }
#pragma unroll
                for (int i = 0; i < 2; ++i) { x0[i] = last ? vN[0][i] : vA[0][i]; x1[i] = last ? vN[1][i] : vA[1][i]; }
            } else {
#pragma unroll
                for (int i = 0; i < 2; ++i) { x0[i] = vA[0][i]; x1[i] = vA[1][i]; }
            }
            MG_LDB(B0, 0, 0); MG_LDB(B1, 0, 1); MG_SCHED; MG_LDA(At, 0, 0); MG_STAGE(MG_SA(1, 1), a1, vA[1]);
            MG_WAIT_V(8); MG_WAIT_L(0); MG_BAR; MG_MMA(0, 0, At, B0); MG_MMA(0, 1, At, B1); MG_BAR; MG_SCHED;
            MG_LDA(At, 0, 1); MG_STAGE(MG_SB(0, 0), b2, voffB); MG_STAGE(MG_SB(0, 1), b2 + hstep, voffB); MG_STAGE(MG_SA(0, 0), a2, x0);
            MG_WAIT_V(8); MG_WAIT_L(0); MG_BAR; MG_MMA(1, 0, At, B0); MG_MMA(1, 1, At, B1); MG_BAR; MG_SCHED;
            MG_LDB(B0, 1, 0); MG_LDB(B1, 1, 1); MG_SCHED; MG_LDA(At, 1, 0); MG_STAGE(MG_SA(0, 1), a2, x1);
            MG_WAIT_V(8); MG_WAIT_L(0); MG_BAR; MG_MMA(0, 0, At, B0); MG_MMA(0, 1, At, B1); MG_BAR; MG_SCHED;
            MG_LDA(At, 1, 1); MG_STAGE(MG_SB(1, 0), b3, voffB); MG_STAGE(MG_SB(1, 1), b3 + hstep, voffB); MG_STAGE(MG_SA(1, 0), a3, x0);
            MG_WAIT_V(8); MG_WAIT_L(0); MG_BAR; MG_MMA(1, 0, At, B0); MG_MMA(1, 1, At, B1); MG_BAR; MG_SCHED;
        }
        if (wr == 0) MG_BAR;
        E(acc, cur, wr, wc, fr, fq);
        if (!has_next) break;
#pragma unroll
        for (int a = 0; a < 2; ++a)
#pragma unroll
            for (int b = 0; b < 2; ++b)
#pragma unroll
                for (int m = 0; m < 4; ++m)
#pragma unroll
                    for (int n = 0; n < 2; ++n) acc[a][b][m][n] = (f32x4){0.f, 0.f, 0.f, 0.f};
        cur = nxt; cA = nA; cB = nB; ++ui;
        if constexpr (GATHER) {
#pragma unroll
            for (int h = 0; h < 2; ++h)
#pragma unroll
                for (int i = 0; i < 2; ++i) vA[h][i] = vN[h][i];
        }
        if (wr == 1) MG_BAR;
    }
    MG_WAIT_V(0);
    MG_BAR;
#undef MG_MKV
#undef MG_SA
#undef MG_SB
#undef MG_STAGE
#undef MG_LDA
#undef MG_LDB
#undef MG_MMA
#undef MG_WAIT_V
#undef MG_WAIT_L
#undef MG_BAR
#undef MG_SCHED
}
struct EpiF32 {
    static constexpr bool PERM = false;
    float* C; int ldc; int row0; int nvalid;
    __device__ __forceinline__ void operator()(const f32x4 (&acc)[2][2][4][2], const Unit& u, int wr, int wc, int fr, int fq) const {
        const int rb = row0 + u.pm * BM + wr * 64 + fr, cb = u.pn * BM + wc * 32 + 4 * fq;
#pragma unroll
        for (int ai = 0; ai < 2; ++ai)
#pragma unroll
            for (int m = 0; m < 4; ++m) { float* rowp = C + (size_t)(rb + ai * HALF + m * 16) * ldc;
#pragma unroll
                for (int bj = 0; bj < 2; ++bj)
#pragma unroll
                    for (int n = 0; n < 2; ++n) { const int col = cb + bj * HALF + n * 16; if (col < nvalid) *(f32x4*)(rowp + col) = acc[ai][bj][m][n]; } }
    }
};
struct EpiBf16 {
    static constexpr bool PERM = true;
    bf16_t* C; int ldc; int row0; int nvalid;
    __device__ __forceinline__ void operator()(const f32x4 (&acc)[2][2][4][2], const Unit& u, int wr, int wc, int fr, int fq) const {
        const int rb = row0 + u.pm * BM + wr * 64 + fr, cb = u.pn * BM + wc * 32 + 8 * fq;
#pragma unroll
        for (int ai = 0; ai < 2; ++ai)
#pragma unroll
            for (int m = 0; m < 4; ++m) { bf16_t* rowp = C + (size_t)(rb + ai * HALF + m * 16) * ldc;
#pragma unroll
                for (int bj = 0; bj < 2; ++bj) { const int col = cb + bj * HALF; if (col < nvalid) *(bf16x8*)(rowp + col) = pack8(acc[ai][bj][m][0] + 0.f, acc[ai][bj][m][1] + 0.f); } }
    }
};
struct EpiPre {
    static constexpr bool PERM = true;
    const Params* p; int layer; int row0;
    __device__ __forceinline__ void operator()(const f32x4 (&acc)[2][2][4][2], const Unit& u, int wr, int wc, int fr, int fq) const {
        const int rb = row0 + u.pm * BM + wr * 64 + fr, cb = u.pn * BM + wc * 32 + 8 * fq;
#pragma unroll
        for (int ai = 0; ai < 2; ++ai)
#pragma unroll
            for (int m = 0; m < 4; ++m) { const int row = rb + ai * HALF + m * 16; const float* g1 = p->MOD + ((size_t)layer * 9 + row_mod(row)) * 6144 + 2048;
#pragma unroll
                for (int bj = 0; bj < 2; ++bj) { const int col = cb + bj * HALF;
                    f32x4 x0, x1;
                    if (layer == 0) { const float* xr = xin_row(*p, 0, row) + col; x0 = *(const f32x4*)xr; x1 = *(const f32x4*)(xr + 4); }
                    else { const u32x4 xw = *(const u32x4*)(p->X2 + (size_t)row * DM + col); x0 = bf4_to_f32((u32x2){xw.x, xw.y}); x1 = bf4_to_f32((u32x2){xw.z, xw.w}); }
                    *(bf16x8*)(p->PRE + (size_t)row * DM + col) = pack8(x0 * DN_ALPHA + *(const f32x4*)(g1 + col) * acc[ai][bj][m][0], x1 * DN_ALPHA + *(const f32x4*)(g1 + col + 4) * acc[ai][bj][m][1]); } }
    }
};
struct EpiAct {
    static constexpr bool PERM = true;
    bf16_t* ACT;
    __device__ __forceinline__ void operator()(const f32x4 (&acc)[2][2][4][2], const Unit& u, int wr, int wc, int fr, int fq) const {
        const int rb = u.pm * BM + wr * 64 + fr, cb = u.pn * HALF + wc * 32 + 8 * fq;
#pragma unroll
        for (int ai = 0; ai < 2; ++ai)
#pragma unroll
            for (int m = 0; m < 4; ++m) {
                const f32x4 a0 = acc[ai][0][m][0], a1 = acc[ai][0][m][1], b0 = acc[ai][1][m][0], b1 = acc[ai][1][m][1];
                f32x4 o0, o1;
#pragma unroll
                for (int e = 0; e < 4; ++e) { o0[e] = a0[e] * __builtin_amdgcn_rcpf(1.f + __expf(-a0[e])) * b0[e]; o1[e] = a1[e] * __builtin_amdgcn_rcpf(1.f + __expf(-a1[e])) * b1[e]; }
                *(bf16x8*)(ACT + (size_t)(rb + ai * HALF + m * 16) * 256 + cb) = pack8(o0, o1);
            }
    }
};
struct EpiYs {
    static constexpr bool PERM = true;
    bf16_t* YS; const float* gate; int ntr;
    __device__ __forceinline__ void operator()(const f32x4 (&acc)[2][2][4][2], const Unit& u, int wr, int wc, int fr, int fq) const {
        const int rb = u.pm * BM + wr * 64 + fr, cb = u.pn * BM + wc * 64 + 16 * fq;
#pragma unroll
        for (int ai = 0; ai < 2; ++ai)
#pragma unroll
            for (int m = 0; m < 4; ++m) { const int row = rb + ai * HALF + m * 16; const float g = gate[row] * 64.f;
                u32x4 wv;
#pragma unroll
                for (int bj = 0; bj < 2; ++bj) { const f32x4 v0 = acc[ai][bj][m][0] * g, v1 = acc[ai][bj][m][1] * g; int w0 = 0, w1 = 0;
                    w0 = __builtin_amdgcn_cvt_pk_fp8_f32(v0[0], v0[1], w0, false); w0 = __builtin_amdgcn_cvt_pk_fp8_f32(v0[2], v0[3], w0, true);
                    w1 = __builtin_amdgcn_cvt_pk_fp8_f32(v1[0], v1[1], w1, false); w1 = __builtin_amdgcn_cvt_pk_fp8_f32(v1[2], v1[3], w1, true);
                    if (bj == 0) { wv.x = (unsigned)w0; wv.y = (unsigned)w1; } else { wv.z = (unsigned)w0; wv.w = (unsigned)w1; } }
                *(u32x4*)((unsigned char*)YS + (size_t)row * DM + cb) = wv; }
    }
};
}

__device__ __forceinline__ void phase_mod(const Params& p, unsigned char* lds) {
    float* sv = (float*)lds;
    float* red = sv + 9 * 1024;
    const int tid = threadIdx.x;
    for (int e = tid; e < 9 * 1024; e += NTHR) { const int j = e >> 10, k = e & 1023; const float v = j < 8 ? p.c[j * 1024 + k] : p.c_ctx[k]; sv[e] = silu_f(v); }
    __syncthreads();
    const int kg = tid >> 6, nl = tid & 63;
    for (int u = blockIdx.x; u < 192; u += gridDim.x) {
        const int l = u / 96, n0 = (u % 96) * 64;
        const float* W = p.mod_w + (size_t)l * 1024 * 6144 + n0 + nl;
        float acc[9];
#pragma unroll
        for (int j = 0; j < 9; ++j) acc[j] = 0.f;
#pragma unroll 8
        for (int k = kg; k < 1024; k += 8) {
            const float wv = W[(size_t)k * 6144];
#pragma unroll
            for (int j = 0; j < 9; ++j) acc[j] += sv[j * 1024 + k] * wv;
        }
#pragma unroll
        for (int j = 0; j < 9; ++j) red[(kg * 9 + j) * 64 + nl] = acc[j];
        __syncthreads();
        for (int e = tid; e < 576; e += NTHR) {
            const int j = e >> 6, n = e & 63; float s = 0.f;
#pragma unroll
            for (int g = 0; g < 8; ++g) s += red[(g * 9 + j) * 64 + n];
            p.MOD[((size_t)l * 9 + j) * 6144 + n0 + n] = s + p.mod_b[l * 6144 + n0 + n];
        }
        __syncthreads();
    }
}

__device__ __forceinline__ void phase_filt(const Params& p, unsigned char* lds) {
    float* zs = (float*)lds;
    float* h1 = zs + 40 * 33;
    float* h2a = h1 + 40 * 64;
    float* h2b = h2a + 64 * 32;
    float* tile = h2b + 64 * 32;
    const int tid = threadIdx.x;
    const float min_decay = logf(1e-2f) / 1.5f, max_decay = logf(1e-2f) / 0.3f;
    for (int u = blockIdx.x; u < 256; u += gridDim.x) {
        const int t0 = (u >> 1) * 32, n = u & 1;
        __syncthreads();
        for (int e = tid; e < 33 * 33; e += NTHR) {
            const int tt = e / 33, i = e % 33; const int t = t0 + tt;
            float v;
            if (i == 0) v = (float)t / 4095.f;
            else {
                const int bi = (i - 1) & 15; const float fr = 1e-4f + (float)bi * ((15.f - 1e-4f) / 15.f);
                const float wpos = 6.283185307179586f * (float)t / 4096.f;
                v = (i <= 16) ? cosf(fr * wpos) : -sinf(fr * wpos);
            }
            zs[e] = v;
        }
        for (int e = 33 * 33 + tid; e < 40 * 33; e += NTHR) zs[e] = 0.f;
        __syncthreads();
        const int ttg = tid >> 6, j = tid & 63;
        {
            float sa[5];
#pragma unroll
            for (int r = 0; r < 5; ++r) sa[r] = p.hy_ffn_b1[j];
#pragma unroll 3
            for (int i = 0; i < 33; ++i) { const float wv = p.hy_ffn_w1[i * 64 + j];
#pragma unroll
                for (int r = 0; r < 5; ++r) sa[r] += zs[(ttg + 8 * r) * 33 + i] * wv; }
            const float fq = p.hy_sin_freq[j];
#pragma unroll
            for (int r = 0; r < 5; ++r) h1[(ttg + 8 * r) * 64 + j] = sinf(fq * sa[r]);
        }
        __syncthreads();
        {
            float sa[5];
#pragma unroll
            for (int r = 0; r < 5; ++r) sa[r] = p.hy_ffn_b2[j];
#pragma unroll 4
            for (int i = 0; i < 64; ++i) { const float wv = p.hy_ffn_w2[i * 64 + j];
#pragma unroll
                for (int r = 0; r < 5; ++r) sa[r] += h1[(ttg + 8 * r) * 64 + i] * wv; }
            const float fq = p.hy_sin_freq[64 + j];
#pragma unroll
            for (int r = 0; r < 5; ++r) { const int tt = ttg + 8 * r; const float v = sinf(fq * sa[r]);
                if (tt < 32) h2a[j * 32 + tt] = v;
                if (tt >= 1 && tt < 33) h2b[j * 32 + tt - 1] = v; }
        }
        __syncthreads();
#pragma unroll
        for (int side = 0; side < 2; ++side) {
            const int c = tid; const int m = n * 1024 + side * 512 + c;
            const float* hb = side ? h2b : h2a;
            float acc[32];
#pragma unroll
            for (int t2 = 0; t2 < 32; ++t2) acc[t2] = 0.f;
#pragma unroll 4
            for (int jj = 0; jj < 64; ++jj) {
                const float wv = p.hy_ffn_w3[jj * 2048 + m];
#pragma unroll
                for (int q = 0; q < 8; ++q) { const f32x4 hv = *(const f32x4*)(hb + jj * 32 + q * 4);
#pragma unroll
                    for (int e = 0; e < 4; ++e) acc[q * 4 + e] += hv[e] * wv; }
            }
            const float delta = min_decay + (float)c * ((max_decay - min_decay) / 511.f);
#pragma unroll
            for (int q = 0; q < 8; ++q) { f32x4 o;
#pragma unroll
                for (int e = 0; e < 4; ++e) { const int pos = q * 4 + e; const int t2 = side ? 31 - pos : pos; const int t = t0 + t2 + side;
                    const float win = expf(-((float)t / 4095.f) * fabsf(delta));
                    o[e] = t >= 4096 ? 0.f : (side ? acc[31 - pos] : acc[pos]) * win; }
                *(f32x4*)(tile + c * 36 + q * 4) = o; }
            __syncthreads();
            float* gb = p.G + (size_t)n * 512 * 8192 + (side ? 4096 - t0 - 32 : 4096 + t0);
#pragma unroll
            for (int k = 0; k < 8; ++k) { const int idx = tid + 512 * k; const int row = idx >> 3, seg = idx & 7;
                *(f32x4*)(gb + (size_t)row * 8192 + seg * 4) = *(const f32x4*)(tile + row * 36 + seg * 4); }
            __syncthreads();
        }
    }
}

struct ConvJob { const float* src; bf16_t* dst; int ld, ncols, col0, k0, K, cmap; };
__device__ __forceinline__ int w2_col(int nrow) { const int pn = nrow >> 8, rho = nrow & 255; return pn * 256 + ((rho >> 5) & 3) * 64 + ((rho >> 3) & 3) * 16 + (rho >> 7) * 8 + (rho & 7); }
__device__ __forceinline__ int w13_col(int nrow) { const int pn = nrow >> 8, within = nrow & 255; return (within >> 7) * 256 + pn * 128 + (within & 127); }
#define CONV_TOTAL (3008 + 65536 + 32768 + 40)
__device__ __forceinline__ ConvJob conv_job(const Params& p, int g) {
    ConvJob j;
    if (g < 1088) { const int rt = g >> 4, kt = g & 15; j = {p.ev_w_in, p.WT_EVIN + (size_t)rt * 64 * 1024, EVW, EVW, rt * 64, kt * 64, 1024, 0}; }
    else if (g < 1344) { const int t = g - 1088, rt = t >> 4, kt = t & 15; j = {p.ev_w_out, p.WT_EVOUT + (size_t)rt * 64 * 1024, 1024, 1024, rt * 64, kt * 64, 1024, 0}; }
    else if (g < 2240) { const int t = g - 1344, rt = t >> 4, kt = t & 15; j = {p.od_w_in, p.WT_ODIN + (size_t)rt * 64 * 1024, ODW, ODW, rt * 64, kt * 64, 1024, 0}; }
    else if (g < 2496) { const int t = g - 2240, rt = t >> 4, kt = t & 15; j = {p.od_w_out, p.WT_ODOUT + (size_t)rt * 64 * 1024, 1024, 1024, rt * 64, kt * 64, 1024, 0}; }
    else if (g < 2624) { const int t = g - 2496, l = t >> 6, rt = (t >> 4) & 3, kt = t & 15; j = {p.router_w + (size_t)l * 1024 * 256, p.WT_ROUT + ((size_t)l * 256 + rt * 64) * 1024, 256, 256, rt * 64, kt * 64, 1024, 0}; }
    else if (g < 2880) { const int t = g - 2624, l = t >> 7, rt = (t >> 4) & 7, kt = t & 15; j = {p.sh_w13 + (size_t)l * 1024 * 512, p.WT_SH13 + ((size_t)l * 512 + rt * 64) * 1024, 512, 512, w13_col(rt * 64), kt * 64, 1024, 0}; }
    else if (g < 3008) { const int t = g - 2880, l = t >> 6, rt = (t >> 2) & 15, kt = t & 3; j = {p.sh_w2 + (size_t)l * 256 * 1024, p.WT_SH2 + ((size_t)l * 1024 + rt * 64) * 256, 1024, 1024, rt * 64, kt * 64, 256, 1}; }
    else if (g < 3008 + 65536) { const int t = g - 3008, le = t >> 7, rt = (t >> 4) & 7, kt = t & 15; j = {p.exp_w13 + (size_t)le * 1024 * 512, p.WT_W13 + ((size_t)le * 512 + rt * 64) * 1024, 512, 512, w13_col(rt * 64), kt * 64, 1024, 0}; }
    else if (g < 3008 + 65536 + 32768) { const int t = g - 3008 - 65536, le = t >> 6, rt = (t >> 2) & 15, kt = t & 3; j = {p.exp_w2 + (size_t)le * 256 * 1024, p.WT_W2 + ((size_t)le * 1024 + rt * 64) * 256, 1024, 1024, rt * 64, kt * 64, 256, 1}; }
    else { const int t = g - 3008 - 65536 - 32768;
        if (t < 8) j = {p.rw_w2, p.WT_RWF + (size_t)t * 64 * 64, 512, 512, t * 64, 0, 64, 0};
        else if (t < 16) j = {p.rw_w2 + 64 * 512, p.WT_RWB + (size_t)(t - 8) * 64 * 64, 512, 512, (t - 8) * 64, 0, 64, 0};
        else if (t < 24) j = {p.rw_a2, p.WT_RWA + (size_t)(t - 16) * 64 * 64, 512, 512, (t - 16) * 64, 0, 64, 0};
        else { const int t2 = t - 24; j = {p.rw_g2, p.WT_RWG + (size_t)(t2 >> 1) * 64 * 128, 512, 512, (t2 >> 1) * 64, (t2 & 1) * 64, 128, 0}; } }
    return j;
}
#define RWSEQ_CONV 16384
#define W13L0_HOSTED 6000
__device__ __forceinline__ int conv_count(int part) { return part == 0 ? (3008 + 32768 - W13L0_HOSTED + 40) : (part == 1 ? 32768 + 16384 : 16384 + W13L0_HOSTED); }
__device__ __forceinline__ int conv_index(int part, int i) {
    if (part == 0) return i < 3008 + 32768 - W13L0_HOSTED ? i : i + W13L0_HOSTED + 32768 + 32768;
    if (part == 1) return i < 32768 ? 3008 + 32768 + i : 3008 + 65536 + 16384 + (i - 32768);
    return i < 16384 ? 3008 + 65536 + i : 3008 + 32768 - W13L0_HOSTED + (i - 16384);
}
__device__ __forceinline__ void phase_convw_r(const Params& p, unsigned char* lds, const int part, const int first, const int count, const int blk, const int nblk) {
    constexpr int CD = 3;
    bf16_t* T = (bf16_t*)lds;
    const int tid = threadIdx.x, kk = tid >> 4, nq = tid & 15;
    f32x4 q0[CD], q1[CD]; ConvJob jq[CD];
#define CONV_LOAD(d, gi) do { jq[d] = conv_job(p, conv_index(part, (gi))); const int col_ = jq[d].cmap ? w2_col(jq[d].col0 + nq * 4) : jq[d].col0 + nq * 4; const bool ok_ = col_ < jq[d].ncols; \
        const float* sp_ = jq[d].src + (size_t)(jq[d].k0 + kk) * jq[d].ld + (ok_ ? col_ : 0); \
        q0[d] = *(const f32x4*)sp_; q1[d] = *(const f32x4*)(sp_ + (size_t)32 * jq[d].ld); if (!ok_) { q0[d] = (f32x4){0.f, 0.f, 0.f, 0.f}; q1[d] = q0[d]; } } while (0)
    const int total = first + count;
    if (blk >= count) return;
#pragma unroll
    for (int d = 0; d < CD; ++d) { const int gi = first + blk + d * nblk; CONV_LOAD(d, gi < total ? gi : first + blk); }
    for (int g0 = first + blk; g0 < total; g0 += CD * nblk) {
#pragma unroll
        for (int d = 0; d < CD; ++d) {
            const int g = g0 + d * nblk;
            if (g < total) {
                const f32x4 v0 = q0[d], v1 = q1[d]; const ConvJob job = jq[d];
                { const int gn = g + CD * nblk; CONV_LOAD(d, gn < total ? gn : g); }
                asm volatile("" ::: "memory");
                __syncthreads();
#pragma unroll
                for (int e = 0; e < 4; ++e) { T[(nq * 4 + e) * 66 + kk] = f2bf(v0[e]); T[(nq * 4 + e) * 66 + kk + 32] = f2bf(v1[e]); }
                __syncthreads();
                const int n = tid >> 3, seg = tid & 7;
                const unsigned* tp = (const unsigned*)(T + n * 66 + seg * 8);
                u32x4 o; o.x = tp[0]; o.y = tp[1]; o.z = tp[2]; o.w = tp[3];
                *(u32x4*)(job.dst + (size_t)n * job.K + job.k0 + seg * 8) = o;
            }
        }
    }
#undef CONV_LOAD
}
__device__ __forceinline__ void phase_convw(const Params& p, unsigned char* lds, const int part, const int blk, const int nblk) { phase_convw_r(p, lds, part, 0, conv_count(part), blk, nblk); }
__device__ __forceinline__ void phase_hin0(const Params& p) {
    const int NI = NT * 128, step = gridDim.x * NTHR;
    f32x4 nx0, nx1, nh0, nh1, ns0, ns1;
#define HIN_LOAD(ii) do { const int r_ = (ii) >> 7, k_ = ((ii) & 127) * 8; const float* xr_ = xin_row(p, 0, r_) + k_; const float* md_ = p.MOD + (size_t)row_mod(r_) * 6144 + k_; \
        nx0 = *(const f32x4*)xr_; nx1 = *(const f32x4*)(xr_ + 4); nh0 = *(const f32x4*)md_; nh1 = *(const f32x4*)(md_ + 4); ns0 = *(const f32x4*)(md_ + 1024); ns1 = *(const f32x4*)(md_ + 1028); } while (0)
    int i = blockIdx.x * NTHR + threadIdx.x;
    HIN_LOAD(i < NI ? i : 0);
    for (; i < NI; i += step) {
        const f32x4 x0 = nx0, x1 = nx1, h0 = nh0, h1 = nh1, s0 = ns0, s1 = ns1;
        { const int in = i + step < NI ? i + step : i; HIN_LOAD(in); }
        asm volatile("" ::: "memory");
        const int r = i >> 7, k = (i & 127) * 8;
        *(bf16x8*)(p.HIN + (size_t)r * 1024 + k) = pack8(x0 * (s0 + 1.f) + h0, x1 * (s1 + 1.f) + h1);
    }
#undef HIN_LOAD
}
__device__ __forceinline__ void phase_inproj(const Params& p, unsigned char* lds, int layer) {
    mg8::DenseOrder S; S.init(p.HIN, layer == 0 ? p.WT_EVIN : p.WT_ODIN, NT, layer == 0 ? 4352 : 3584, 1024, gridDim.x, blockIdx.x);
    const int N = layer == 0 ? EVW : ODW;
    mg8::EpiBf16 E{p.P, N, 0, N};
    mg8::gemm_phase<mg8::EpiBf16, mg8::DenseOrder, false>((MG_LAS unsigned char*)lds, 1024, S, E);
}

template <int DK, int TYPE>
__device__ __forceinline__ void rec0_chunked(const Params& p, unsigned char* lds, int blk, int nblk) {
    constexpr int DKP = DK + 8, TPT = DK / 8, NPART = 512 / DK, NT16 = DK / 16;
    bf16_t* Qs = (bf16_t*)lds;
    bf16_t* Ks = Qs + 64 * DKP;
    bf16_t* KsT = Ks + 64 * DKP;
    bf16_t* Vt = KsT + DK * 72;
    bf16_t* Ps = Vt + 64 * 72;
    float* ptot = (float*)(Ps + 64 * 72);
    float* lref = ptot + 8 * 128;
    float* decv = lref + 128; float* elv = decv + 128; float* erv = elv + 128;
    const int tid = threadIdx.x, lane = tid & 63, w = tid >> 6, cw = w & 3, mh = w >> 2, q4 = lane >> 4, l15 = lane & 15;
    const int d = tid % DK, part = tid / DK;
    for (int e = tid; e < 64 * 72; e += NTHR) Ps[e] = 0;
    for (int unit = blk; unit < 128; unit += nblk) {
        const int half = unit & 1, h = (unit >> 1) & 3, b = (unit >> 3) & 7, dir = unit >> 6;
        float wg[16]; float gbias = 0.f, lbv = 0.f;
        if (TYPE == 0) {
#pragma unroll
            for (int i = 0; i < 16; ++i) wg[i] = p.gla_gate_w2[(dir * 16 + i) * 256 + h * 64 + d];
            gbias = p.gla_gate_b[dir * 256 + h * 64 + d];
        } else {
            const float l0 = p.hg_lb_logits[dir * 512 + h * 128 + d], l1 = p.hg_lb_logits[1024 + dir * 512 + h * 128 + d];
            lbv = 1.f / (1.f + expf(l1 - l0));
        }
        f32x4 Sacc[NT16];
#pragma unroll
        for (int t = 0; t < NT16; ++t) Sacc[t] = (f32x4){0.f, 0.f, 0.f, 0.f};
        const int vcol0 = (TYPE == 0 ? 512 : 3104) + h * 128 + half * 64;
        const int colA = TYPE == 0 ? h * 64 : 1568 + h * 128, colB = TYPE == 0 ? 256 + h * 64 : 2080 + dir * 512 + h * 128;
        float* sga = erv + 128;
        bf16_t* SA = (bf16_t*)(sga + 64 * 16);
        bf16_t* SB = SA + 64 * DK;
        bf16_t* SV = SB + 64 * DK;
        constexpr int NL = DK / 64, SEGS = DK / 8;
        u32x4 sa[NL], sb[NL], sv; u32x2 rgr = {0u, 0u};
#define REC_LOAD(cc) do { _Pragma("unroll") for (int i = 0; i < NL; ++i) { const int idx = tid + NTHR * i; const bf16_t* pr = p.P + (size_t)row_of(dir, b, (cc) * 64 + idx / SEGS) * EVW + (idx % SEGS) * 8; \
            sa[i] = *(const u32x4*)(pr + colA); sb[i] = *(const u32x4*)(pr + colB); } \
        sv = *(const u32x4*)(p.P + (size_t)row_of(dir, b, (cc) * 64 + (tid >> 3)) * EVW + vcol0 + (tid & 7) * 8); \
        if (TYPE == 0 && tid < 256) rgr = *(const u32x2*)(p.P + (size_t)row_of(dir, b, (cc) * 64 + (tid >> 2)) * EVW + 1536 + dir * 16 + (tid & 3) * 4); } while (0)
#define REC_PARK() do { _Pragma("unroll") for (int i = 0; i < NL; ++i) { const int idx = tid + NTHR * i; *(u32x4*)(SA + idx * 8) = sa[i]; *(u32x4*)(SB + idx * 8) = sb[i]; } \
        *(u32x4*)(SV + tid * 8) = sv; if (TYPE == 0 && tid < 256) *(f32x4*)(sga + tid * 4) = bf4_to_f32(rgr); } while (0)
        constexpr int NCH = (CTXL + SEQ) / 64;
        REC_LOAD(0);
        REC_PARK();
        REC_LOAD(1);
        for (int c = 0; c < NCH; ++c) {
            __syncthreads();
            float qv[TPT], kv[TPT], lcv[TPT]; float lc = 0.f;
#pragma unroll
            for (int tt = 0; tt < TPT; ++tt) {
                float la;
                if (TYPE == 0) {
                    qv[tt] = bf2f(SA[(part * TPT + tt) * DK + d]) * 0.125f; kv[tt] = bf2f(SB[(part * TPT + tt) * DK + d]);
                    const float* ap = sga + (part * TPT + tt) * 16; float sg = gbias;
#pragma unroll
                    for (int i = 0; i < 16; i += 4) { const f32x4 a4 = *(const f32x4*)(ap + i); sg += a4[0] * wg[i] + a4[1] * wg[i + 1] + a4[2] * wg[i + 2] + a4[3] * wg[i + 3]; }
                    const float ex = __expf(-fabsf(sg)); la = (fminf(sg, 0.f) - __logf(1.f + ex)) * (1.f / 16.f);
                } else {
                    const float rat = bf2f(SA[(part * TPT + tt) * DK + d]), rbt = bf2f(SB[(part * TPT + tt) * DK + d]);
                    qv[tt] = rat * __builtin_amdgcn_rcpf(1.f + __expf(-rat));
                    const float f = lbv + (1.f - lbv) * __builtin_amdgcn_rcpf(1.f + __expf(-rbt));
                    kv[tt] = 1.f - f; la = __logf(f);
                }
                lc += la; lcv[tt] = lc;
            }
            ptot[part * 128 + d] = lc;
            if (part == 32 / TPT) lref[d] = lcv[32 % TPT];
            { u32x4 vt4; unsigned short ve[8];
#pragma unroll
              for (int e = 0; e < 8; ++e) ve[e] = *(const unsigned short*)(SV + ((tid >> 6) * 8 + e) * 64 + (tid & 63));
              vt4.x = ve[0] | ((unsigned)ve[1] << 16); vt4.y = ve[2] | ((unsigned)ve[3] << 16); vt4.z = ve[4] | ((unsigned)ve[5] << 16); vt4.w = ve[6] | ((unsigned)ve[7] << 16);
              *(u32x4*)(Vt + (tid & 63) * 72 + (tid >> 6) * 8) = vt4; }
            __syncthreads();
            float off = 0.f, bref = lref[d], blast = 0.f;
#pragma unroll
            for (int pp = 0; pp < NPART; ++pp) { const float tv = ptot[pp * 128 + d]; if (pp < part) off += tv; if (pp < 32 / TPT) bref += tv; blast += tv; }
            if (part == 0) { decv[d] = __expf(blast); elv[d] = __expf(blast - bref); erv[d] = __expf(bref); }
            {
                float ksv[TPT];
#pragma unroll
                for (int tt = 0; tt < TPT; ++tt) {
                    const int j = part * TPT + tt; const float bj = lcv[tt] + off;
                    const float e1 = __expf(bj - bref), e2 = __expf(bref - bj);
                    Qs[j * DKP + d] = f2bf(qv[tt] * e1); ksv[tt] = kv[tt] * e2; Ks[j * DKP + d] = f2bf(ksv[tt]);
                }
#pragma unroll
                for (int g = 0; g < TPT / 8; ++g) {
                    f32x4 a0 = {ksv[g * 8], ksv[g * 8 + 1], ksv[g * 8 + 2], ksv[g * 8 + 3]}, a1 = {ksv[g * 8 + 4], ksv[g * 8 + 5], ksv[g * 8 + 6], ksv[g * 8 + 7]};
                    *(bf16x8*)(KsT + d * 72 + part * TPT + g * 8) = pack8(a0, a1);
                }
            }
            __syncthreads();
            if (c + 1 < NCH) { REC_PARK(); const int c2 = c + 2 < NCH ? c + 2 : NCH - 1; REC_LOAD(c2); }
#pragma unroll
            for (int rep = 0; rep < 2; ++rep) {
                const int t = w + rep * 8;
                if (t < 10) {
                    const int it = t < 1 ? 0 : (t < 3 ? 1 : (t < 6 ? 2 : 3)); const int jt = t - (it * (it + 1)) / 2;
                    f32x4 acc = {0.f, 0.f, 0.f, 0.f};
#pragma unroll
                    for (int ks = 0; ks < DK / 32; ++ks) {
                        const bf16x8 ka = *(const bf16x8*)(Ks + (jt * 16 + l15) * DKP + ks * 32 + q4 * 8);
                        const bf16x8 qb = *(const bf16x8*)(Qs + (it * 16 + l15) * DKP + ks * 32 + q4 * 8);
                        acc = __builtin_amdgcn_mfma_f32_16x16x32_bf16(ka, qb, acc, 0, 0, 0);
                    }
                    const int i = it * 16 + l15, j0 = jt * 16 + q4 * 4;
                    u32x2 wv; wv.x = pk2(i >= j0 ? acc[0] : 0.f, i >= j0 + 1 ? acc[1] : 0.f); wv.y = pk2(i >= j0 + 2 ? acc[2] : 0.f, i >= j0 + 3 ? acc[3] : 0.f);
                    *(u32x2*)(Ps + i * 72 + j0) = wv;
                }
            }
            __syncthreads();
            bf16x8 vb[2];
#pragma unroll
            for (int ks = 0; ks < 2; ++ks) vb[ks] = *(const bf16x8*)(Vt + (cw * 16 + l15) * 72 + ks * 32 + q4 * 8);
            bf16x8 sb[DK / 32];
#pragma unroll
            for (int ks = 0; ks < DK / 32; ++ks) {
                const f32x4 e0 = *(const f32x4*)(erv + ks * 32 + q4 * 4), e1 = *(const f32x4*)(erv + ks * 32 + 16 + q4 * 4);
                sb[ks] = pack8(Sacc[2 * ks] * e0, Sacc[2 * ks + 1] * e1);
            }
#pragma unroll
            for (int r2 = 0; r2 < 2; ++r2) {
                const int it = mh * 2 + r2;
                f32x4 acc = {0.f, 0.f, 0.f, 0.f};
#pragma unroll
                for (int ks = 0; ks < 2; ++ks) {
                    if (ks == 0 || it >= 2) {
                        const bf16x8 pa = *(const bf16x8*)(Ps + (it * 16 + l15) * 72 + ks * 32 + q4 * 8);
                        acc = __builtin_amdgcn_mfma_f32_16x16x32_bf16(pa, vb[ks], acc, 0, 0, 0);
                    }
                }
#pragma unroll
                for (int ks = 0; ks < DK / 32; ++ks) {
                    const u32x2 lo2 = *(const u32x2*)(Qs + (it * 16 + l15) * DKP + ks * 32 + q4 * 4), hi2 = *(const u32x2*)(Qs + (it * 16 + l15) * DKP + ks * 32 + 16 + q4 * 4);
                    u32x4 qa4; qa4.x = lo2.x; qa4.y = lo2.y; qa4.z = hi2.x; qa4.w = hi2.y;
                    acc = __builtin_amdgcn_mfma_f32_16x16x32_bf16(__builtin_bit_cast(bf16x8, qa4), sb[ks], acc, 0, 0, 0);
                }
#pragma unroll
                for (int e = 0; e < 4; ++e) {
                    const int row = row_of(dir, b, c * 64 + it * 16 + q4 * 4 + e);
                    p.O[((size_t)dir * NT + row) * 1024 + TYPE * 512 + h * 128 + half * 64 + cw * 16 + l15] = f2bf(acc[e]);
                }
            }
#pragma unroll
            for (int t = 0; t < NT16; ++t) {
                f32x4 acc = {0.f, 0.f, 0.f, 0.f};
#pragma unroll
                for (int ks = 0; ks < 2; ++ks) {
                    const bf16x8 ka = *(const bf16x8*)(KsT + (t * 16 + l15) * 72 + ks * 32 + q4 * 8);
                    acc = __builtin_amdgcn_mfma_f32_16x16x32_bf16(ka, vb[ks], acc, 0, 0, 0);
                }
                const f32x4 dv = *(const f32x4*)(decv + t * 16 + q4 * 4), ev = *(const f32x4*)(elv + t * 16 + q4 * 4);
                Sacc[t] = Sacc[t] * dv + ev * acc;
            }
        }
#undef REC_LOAD
#undef REC_PARK
    }
}
__device__ __forceinline__ void phase_rec0(const Params& p, unsigned char* lds) {
    const int nb = gridDim.x, b = blockIdx.x;
    if (nb >= 256) { if (b < 128) rec0_chunked<128, 1>(p, lds, b, 128); else { rec0_chunked<64, 0>(p, lds, b - 128, nb - 128); __syncthreads(); phase_convw(p, lds, 2, b - 128, nb - 128); } }
    else { rec0_chunked<128, 1>(p, lds, b, nb); rec0_chunked<64, 0>(p, lds, b, nb); __syncthreads(); phase_convw(p, lds, 2, b, nb); }
}

__device__ __forceinline__ float red8(float x);
__device__ __forceinline__ float red16(float x);
__device__ __forceinline__ float sum4(f32x4 v);
__device__ __forceinline__ void phase_readout0(const Params& p) {
    const int lane = threadIdx.x & 63, w = __builtin_amdgcn_readfirstlane(threadIdx.x >> 6);
    const int sub = lane >> 4, c = w * 128 + (lane & 15) * 8;
    const float* gn = (w < 4 ? p.gla_norm_g : p.hg_norm_g) + (lane & 15) * 8;
    const f32x4 g0 = *(const f32x4*)gn, g1 = *(const f32x4*)(gn + 4);
    const int goff = w < 4 ? (1024 + c) : (3616 + (c - 512));
    u32x4 q[2][3];
#define RO0_LOAD(bi) do { _Pragma("unroll") for (int g = 0; g < 2; ++g) { const unsigned r_ = (unsigned)((bi) * 8 + g * 4 + sub); const unsigned o_ = (r_ * 1024u + (unsigned)c) * 2u; \
        q[g][0] = *(const u32x4*)((const char*)p.O + o_); q[g][1] = *(const u32x4*)((const char*)(p.O + (size_t)NT * 1024) + o_); q[g][2] = *(const u32x4*)((const char*)p.P + (r_ * (unsigned)EVW + (unsigned)goff) * 2u); } } while (0)
    constexpr int NITR = NT / 8;
    if ((int)blockIdx.x < NITR) RO0_LOAD((int)blockIdx.x);
    for (int bi = blockIdx.x; bi < NITR; bi += gridDim.x) {
        bf16x8 outv[2];
#pragma unroll
        for (int g = 0; g < 2; ++g) {
            const f32x4 a0 = bf4_to_f32((u32x2){q[g][0].x, q[g][0].y}) + bf4_to_f32((u32x2){q[g][1].x, q[g][1].y}), a1 = bf4_to_f32((u32x2){q[g][0].z, q[g][0].w}) + bf4_to_f32((u32x2){q[g][1].z, q[g][1].w});
            const float ss = red16(sum4(a0 * a0) + sum4(a1 * a1));
            const float rs = rsqrtf(ss * (1.f / 128.f) + 1e-6f);
            const f32x4 t0 = bf4_to_f32((u32x2){q[g][2].x, q[g][2].y}), t1 = bf4_to_f32((u32x2){q[g][2].z, q[g][2].w});
            f32x4 s0, s1;
#pragma unroll
            for (int e = 0; e < 4; ++e) { s0[e] = t0[e] * __builtin_amdgcn_rcpf(1.f + __expf(-t0[e])); s1[e] = t1[e] * __builtin_amdgcn_rcpf(1.f + __expf(-t1[e])); }
            outv[g] = pack8(a0 * rs * g0 * s0, a1 * rs * g1 * s1);
        }
        asm volatile("" ::: "memory");
        { const int bn = bi + (int)gridDim.x < NITR ? bi + (int)gridDim.x : bi; RO0_LOAD(bn); }
        asm volatile("" ::: "memory");
#pragma unroll
        for (int g = 0; g < 2; ++g) *(bf16x8*)((char*)p.Y + ((unsigned)(bi * 8 + g * 4 + sub) * 1024u + (unsigned)c) * 2u) = outv[g];
    }
#undef RO0_LOAD
}

__device__ __forceinline__ void phase_outproj(const Params& p, unsigned char* lds, int layer) {
    const int rbase = layer == 0 ? 0 : NCTX;
    mg8::DenseOrder S; S.init(p.Y + (size_t)rbase * DM, layer == 0 ? p.WT_EVOUT : p.WT_ODOUT, NT - rbase, 1024, 1024, gridDim.x, blockIdx.x);
    mg8::EpiPre E{&p, layer, rbase};
    mg8::gemm_phase<mg8::EpiPre, mg8::DenseOrder, false>((MG_LAS unsigned char*)lds, 1024, S, E);
}

__device__ __forceinline__ void phase_ln1(const Params& p, int layer) {
    const int lane = threadIdx.x & 63, w = __builtin_amdgcn_readfirstlane(threadIdx.x >> 6);
    const int rbase = layer == 0 ? 0 : NCTX; const int npair = (NT - rbase) / 2;
    f32x4 lgv[4], lbv[4];
#pragma unroll
    for (int i = 0; i < 4; ++i) { lgv[i] = *(const f32x4*)(p.ln1_g + layer * DM + i * 256 + lane * 4); lbv[i] = *(const f32x4*)(p.ln1_b + layer * DM + i * 256 + lane * 4); }
    u32x2 nv[2][4];
#define LN1_LOAD(pi) do { _Pragma("unroll") for (int j = 0; j < 2; ++j) _Pragma("unroll") for (int i = 0; i < 4; ++i) nv[j][i] = *(const u32x2*)(p.PRE + (size_t)(rbase + (pi) * 2 + j) * DM + i * 256 + lane * 4); } while (0)
    const int pi0 = blockIdx.x * 8 + w, pstep = gridDim.x * 8;
    if (pi0 < npair) LN1_LOAD(pi0);
    for (int pi = pi0; pi < npair; pi += pstep) {
        f32x4 cv[2][4];
#pragma unroll
        for (int j = 0; j < 2; ++j)
#pragma unroll
            for (int i = 0; i < 4; ++i) cv[j][i] = bf4_to_f32(nv[j][i]);
        if (pi + pstep < npair) LN1_LOAD(pi + pstep);
        asm volatile("" ::: "memory");
#pragma unroll
        for (int j = 0; j < 2; ++j) {
            const int r = rbase + pi * 2 + j; float s = 0.f;
#pragma unroll
            for (int i = 0; i < 4; ++i) s += (cv[j][i][0] + cv[j][i][1]) + (cv[j][i][2] + cv[j][i][3]);
            const float mean = wave_sum(s) * (1.f / 1024.f); float q = 0.f;
#pragma unroll
            for (int i = 0; i < 4; ++i) { const f32x4 d = cv[j][i] - mean; q += (d[0] * d[0] + d[1] * d[1]) + (d[2] * d[2] + d[3] * d[3]); }
            const float rstd = rsqrtf(wave_sum(q) * (1.f / 1024.f) + 1e-5f);
            const float* md = p.MOD + ((size_t)layer * 9 + row_mod(r)) * 6144;
#pragma unroll
            for (int i = 0; i < 4; ++i) {
                const int col = i * 256 + lane * 4;
                const f32x4 y = (cv[j][i] - mean) * rstd * lgv[i] + lbv[i];
                *(u32x2*)(p.X1 + (size_t)r * DM + col) = f32_to_bf4(y);
                const f32x4 uu = y * (*(const f32x4*)(md + 4096 + col) + 1.f) + *(const f32x4*)(md + 3072 + col);
                *(u32x2*)(p.U + (size_t)r * DM + col) = f32_to_bf4(uu);
            }
        }
        asm volatile("" ::: "memory");
    }
#undef LN1_LOAD
}

__device__ __forceinline__ void select_range(const Params& p, int layer, const int t0, const int tstep, const int nrows);
__device__ __forceinline__ void cu_fence() {
    asm volatile("s_waitcnt vmcnt(0)" ::: "memory");
    if (threadIdx.x == 0) { __builtin_amdgcn_fence(__ATOMIC_ACQUIRE, "agent"); asm volatile("s_waitcnt vmcnt(0)" ::: "memory"); }
    __syncthreads();
}
__device__ __forceinline__ void phase_router(const Params& p, unsigned char* lds, int layer) {
    const int rbase = layer == 0 ? 0 : NCTX; const int nunit = (NT - rbase) / 256;
    if ((int)blockIdx.x < nunit || (int)gridDim.x <= nunit) {
        mg8::DenseOrder S; S.init(p.U + (size_t)rbase * DM, p.WT_ROUT + (size_t)layer * 256 * 1024, NT - rbase, 256, 1024, gridDim.x, blockIdx.x);
        mg8::EpiF32 E{p.LOGITS, 256, rbase, 256};
        mg8::gemm_phase<mg8::EpiF32, mg8::DenseOrder, false>((MG_LAS unsigned char*)lds, 1024, S, E);
        if ((int)gridDim.x > nunit) {
            cu_fence();
            mg8::Unit u0; S.next(0, u0);
            select_range(p, layer, u0.pm * 256 + (threadIdx.x >> 6), 8, u0.pm * 256 + 256);
        }
    }
    if ((int)blockIdx.x >= nunit || (int)gridDim.x <= nunit) {
        const int G2 = (int)gridDim.x <= nunit ? gridDim.x : gridDim.x - nunit, c2 = (int)gridDim.x <= nunit ? blockIdx.x : blockIdx.x - nunit;
        mg8::DenseOrder S; S.init(p.U + (size_t)rbase * DM, p.WT_SH13 + (size_t)layer * 512 * 1024, NT - rbase, 512, 1024, G2, c2);
        mg8::EpiAct E{p.ACT_SH};
        mg8::gemm_phase<mg8::EpiAct, mg8::DenseOrder, false>((MG_LAS unsigned char*)lds, 1024, S, E);
    }
}

__device__ __forceinline__ void select_range(const Params& p, int layer, const int t0, const int tstep, const int nrows) {
    const int lane = threadIdx.x & 63;
    const int rbase = layer == 0 ? 0 : NCTX;
    const f32x4 bias = *(const f32x4*)(p.router_bias + layer * 256 + lane * 4);
    int* cnt = p.CNT + layer * 256;
    const float NEG = -__builtin_inff();
    f32x4 lgn = {0.f, 0.f, 0.f, 0.f};
    if (t0 < nrows) lgn = *(const f32x4*)(p.LOGITS + (size_t)(rbase + t0) * 256 + lane * 4);
    for (int t = t0; t < nrows; t += tstep) {
        const f32x4 lg = lgn;
        if (t + tstep < nrows) lgn = *(const f32x4*)(p.LOGITS + (size_t)(rbase + t + tstep) * 256 + lane * 4);
        float sc0 = sigmoid_f(lg[0]), sc1 = sigmoid_f(lg[1]), sc2 = sigmoid_f(lg[2]), sc3 = sigmoid_f(lg[3]);
        float s0 = sc0 + bias[0], s1 = sc1 + bias[1], s2 = sc2 + bias[2], s3 = sc3 + bias[3];
        float a = fmaxf(s0, s1), b = fminf(s0, s1), c = fmaxf(s2, s3), d = fminf(s2, s3);
        float m1 = fmaxf(a, c), m2 = fmaxf(fminf(a, c), fmaxf(b, d));
#define SEL_MERGE(ctrl) do { const float o1 = DPPF(m1, ctrl, 0xF), o2 = DPPF(m2, ctrl, 0xF); const float n1 = fmaxf(m1, o1), n2 = fmaxf(fminf(m1, o1), fmaxf(m2, o2)); m1 = n1; m2 = n2; } while (0)
        SEL_MERGE(0xB1); SEL_MERGE(0x4E); SEL_MERGE(0x141);
#undef SEL_MERGE
        const float grp = m1 + m2; const int myg = lane >> 3; int rank = 0;
#pragma unroll
        for (int g = 0; g < 8; ++g) { const float sg = __int_as_float(__builtin_amdgcn_readlane(__float_as_int(grp), g * 8)); rank += (sg > grp || (sg == grp && g < myg)) ? 1 : 0; }
        if (rank >= 4) { s0 = NEG; s1 = NEG; s2 = NEG; s3 = NEG; }
        int my_e = 0; float my_s = 0.f, gsum = 0.f;
#pragma unroll 1
        for (int k = 0; k < 8; ++k) {
            float lm = s0; int li = 0;
            if (s1 > lm) { lm = s1; li = 1; }
            if (s2 > lm) { lm = s2; li = 2; }
            if (s3 > lm) { lm = s3; li = 3; }
            const float wmx = wave_max(lm);
            const unsigned long long bal = __ballot(lm == wmx);
            const int win = __ffsll((long long)bal) - 1;
            const float mysc = li == 0 ? sc0 : (li == 1 ? sc1 : (li == 2 ? sc2 : sc3));
            const int e = win * 4 + __builtin_amdgcn_readlane(li, win);
            const float se = __int_as_float(__builtin_amdgcn_readlane(__float_as_int(mysc), win));
            if (lane == win) { if (li == 0) s0 = NEG; else if (li == 1) s1 = NEG; else if (li == 2) s2 = NEG; else s3 = NEG; }
            if (lane == k) { my_e = e; my_s = se; }
            gsum += se;
        }
        if (lane < 8) {
            const int pos = atomicAdd(&cnt[my_e], 1);
            const size_t o = (size_t)t * 8 + lane;
            p.EIDX[o] = my_e; p.GATE[o] = my_s / gsum * 2.5f; p.POS[o] = pos;
        }
    }
}

__device__ __forceinline__ void phase_offsets(const Params& p, unsigned char* lds, int layer) {
    int* offs = (int*)lds;
    const int tid = threadIdx.x;
    const int rbase = layer == 0 ? 0 : NCTX; const int nrows = NT - rbase;
    const int* cnt = p.CNT + layer * 256;
    __syncthreads();
    if (tid == 0) { int a = 0; for (int e = 0; e < 256; ++e) { offs[e] = a; a += (cnt[e] + 255) & ~255; } offs[256] = a; }
    __syncthreads();
    const int ntr = offs[256] >> 8;
    if (blockIdx.x == 0) {
        if (tid == 0) p.META[layer * 64] = ntr;
        for (int i = tid; i < ntr; i += NTHR) { int lo = 0, hi = 255; const int s = i * 256; while (lo < hi) { const int mid = (lo + hi + 1) >> 1; if (offs[mid] <= s) lo = mid; else hi = mid - 1; }
            p.TILE_E[i] = lo; }
    }
    for (int i = blockIdx.x * NTHR + tid; i < nrows * 8; i += gridDim.x * NTHR) {
        const int e = p.EIDX[i]; const int slot = offs[e] + p.POS[i];
        p.SLOT_TOK[slot] = rbase + (i >> 3); p.SLOT_GATE[slot] = p.GATE[i]; p.TOKSLOT[i] = slot;
    }
    for (int i = blockIdx.x * NTHR + tid; i < nrows; i += gridDim.x * NTHR) p.SLOT_GATE[ntr * 256 + i] = 1.f;
    for (int e = blockIdx.x; e < 256; e += gridDim.x) {
        const int c = cnt[e], pe = (c + 255) & ~255;
        for (int s = c + tid; s < pe; s += NTHR) { p.SLOT_TOK[offs[e] + s] = rbase; p.SLOT_GATE[offs[e] + s] = 0.f; }
    }
}

__device__ __forceinline__ void phase_moe1(const Params& p, unsigned char* lds, int layer) {
    const int rbase = layer == 0 ? 0 : NCTX; const int nsh = (NT - rbase) / 256; const int ntr = p.META[layer * 64];
    mg8::MoeOrder S; S.ntr = ntr; S.npn = 2; S.nwg = ntr * 2; S.G = gridDim.x; S.c = blockIdx.x; S.K = 1024; S.rbase = rbase; S.gather = true;
    S.A = (const char*)p.U; S.Ash = nullptr; S.Wexp = (const char*)(p.WT_W13 + (size_t)layer * 256 * 512 * 1024); S.wstride = (size_t)512 * 1024 * 2; S.Wsh = (const char*)(p.WT_SH13 + (size_t)layer * 512 * 1024);
    S.tile_e = p.TILE_E; S.slot_tok = p.SLOT_TOK;
    mg8::EpiAct E{p.ACT};
    mg8::gemm_phase<mg8::EpiAct, mg8::MoeOrder, true>((MG_LAS unsigned char*)lds, 1024, S, E);
}
__device__ __forceinline__ void phase_moe2(const Params& p, unsigned char* lds, int layer) {
    const int rbase = layer == 0 ? 0 : NCTX; const int nsh = (NT - rbase) / 256; const int ntr = p.META[layer * 64];
    mg8::MoeOrder S; S.ntr = ntr; S.npn = 4; S.nwg = (ntr + nsh) * 4; S.G = gridDim.x; S.c = blockIdx.x; S.K = 256; S.rbase = rbase; S.gather = false;
    S.A = (const char*)p.ACT; S.Ash = (const char*)p.ACT_SH; S.Wexp = (const char*)(p.WT_W2 + (size_t)layer * 256 * 1024 * 256); S.wstride = (size_t)1024 * 256 * 2; S.Wsh = (const char*)(p.WT_SH2 + (size_t)layer * 1024 * 256);
    S.tile_e = p.TILE_E; S.slot_tok = p.SLOT_TOK;
    mg8::EpiYs E{p.YS, p.SLOT_GATE, ntr};
    mg8::gemm_phase<mg8::EpiYs, mg8::MoeOrder, false>((MG_LAS unsigned char*)lds, 256, S, E);
}
__device__ __forceinline__ int cb_slot(int routed, int shared, int lane) { return lane == 8 ? shared : routed; }
__device__ __forceinline__ void phase_combine(const Params& p, int layer) {
    const int lane = threadIdx.x & 63, w = __builtin_amdgcn_readfirstlane(threadIdx.x >> 6);
    const int rbase = layer == 0 ? 0 : NCTX; const int nrows = NT - rbase;
    const int ntr = p.META[layer * 64];
    f32x4 lgv[4], lbv[4];
#pragma unroll
    for (int i = 0; i < 4; ++i) { lgv[i] = *(const f32x4*)(p.ln2_g + layer * DM + i * 256 + lane * 4); lbv[i] = *(const f32x4*)(p.ln2_b + layer * DM + i * 256 + lane * 4); }
    const int t0 = blockIdx.x * 8 + w, tstep = gridDim.x * 8;
#define CB_SLOT(tt) cb_slot(p.TOKSLOT[(size_t)(tt) * 8 + (lane & 7)], ntr * 256 + (tt), lane)
#define CB_LOAD(tt, sl, Y_, X_) do { _Pragma("unroll") for (int k = 0; k < 9; ++k) { const int slot_ = __builtin_amdgcn_readlane(sl, k); const unsigned char* yr_ = (const unsigned char*)p.YS + (size_t)slot_ * DM; \
        _Pragma("unroll") for (int i = 0; i < 4; ++i) Y_[k][i] = *(const int*)(yr_ + i * 256 + lane * 4); } \
        _Pragma("unroll") for (int i = 0; i < 4; ++i) X_[i] = *(const u32x2*)(p.X1 + (size_t)(rbase + (tt)) * DM + i * 256 + lane * 4); } while (0)
    int yA[9][4]; u32x2 xA[4];
    int slB = 0, slC = 0;
    if (t0 < nrows) { const int sl0 = CB_SLOT(t0); CB_LOAD(t0, sl0, yA, xA); }
    if (t0 + tstep < nrows) slB = CB_SLOT(t0 + tstep);
    for (int t = t0; t < nrows; t += tstep) {
        const int r = rbase + t;
        f32x4 mo[4];
#pragma unroll
        for (int i = 0; i < 4; ++i) mo[i] = (f32x4){0.f, 0.f, 0.f, 0.f};
#pragma unroll
        for (int k = 0; k < 9; ++k)
#pragma unroll
            for (int i = 0; i < 4; ++i) { const f32x2_t lo = __builtin_amdgcn_cvt_pk_f32_fp8(yA[k][i], false), hi = __builtin_amdgcn_cvt_pk_f32_fp8(yA[k][i], true);
                mo[i][0] += lo.x; mo[i][1] += lo.y; mo[i][2] += hi.x; mo[i][3] += hi.y; }
        const float* md = p.MOD + ((size_t)layer * 9 + row_mod(r)) * 6144 + 5120;
        f32x4 v[4]; float s = 0.f;
#pragma unroll
        for (int i = 0; i < 4; ++i) { const int col = i * 256 + lane * 4; v[i] = bf4_to_f32(xA[i]) * DN_ALPHA + *(const f32x4*)(md + col) * (mo[i] * (1.f / 64.f)); s += (v[i][0] + v[i][1]) + (v[i][2] + v[i][3]); }
        const float mean = wave_sum(s) * (1.f / 1024.f); float q = 0.f;
#pragma unroll
        for (int i = 0; i < 4; ++i) { const f32x4 d = v[i] - mean; q += (d[0] * d[0] + d[1] * d[1]) + (d[2] * d[2] + d[3] * d[3]); }
        const float rstd = rsqrtf(wave_sum(q) * (1.f / 1024.f) + 1e-5f);
        asm volatile("" ::: "memory");
        if (t + 2 * tstep < nrows) slC = CB_SLOT(t + 2 * tstep);
        if (t + tstep < nrows) CB_LOAD(t + tstep, slB, yA, xA);
        asm volatile("" ::: "memory");
#pragma unroll
        for (int i = 0; i < 4; ++i) { const int col = i * 256 + lane * 4; const f32x4 ov = (v[i] - mean) * rstd * lgv[i] + lbv[i];
            if (layer == 0) *(u32x2*)(p.X2 + (size_t)r * DM + col) = f32_to_bf4(ov); else *(f32x4*)(p.out + (size_t)t * DM + col) = ov;
            if (layer == 0) { const float* m1 = p.MOD + ((size_t)9 + row_mod(r)) * 6144; const f32x4 hv = ov * (*(const f32x4*)(m1 + 1024 + col) + 1.f) + *(const f32x4*)(m1 + col); *(u32x2*)(p.HIN + (size_t)r * DM + col) = f32_to_bf4(hv); } }
        asm volatile("" ::: "memory");
        slB = slC;
    }
#undef CB_SLOT
#undef CB_LOAD
}

typedef float f32x2 __attribute__((ext_vector_type(2)));
__device__ __forceinline__ f32x2 cmul(f32x2 a, f32x2 b) { return (f32x2){a.x * b.x - a.y * b.y, a.x * b.y + a.y * b.x}; }
#define SQH 0.70710678118654752f
#define C16 0.92387953251128674f
#define S16 0.38268343236508977f
#define PX(i) ((i) + ((((i)) >> 4) << 1))
#define FFT_LDS_ELEMS 9216
__device__ __forceinline__ void bfly_dif8(f32x2 (&x)[8], const f32x2 w1) {
    const f32x2 w2 = cmul(w1, w1), w4 = cmul(w2, w2);
    { f32x2 a = x[0], b = x[4]; x[0] = a + b; x[4] = cmul(a - b, w1); }
    { f32x2 a = x[1], b = x[5]; x[1] = a + b; x[5] = cmul(a - b, cmul(w1, (f32x2){SQH, -SQH})); }
    { f32x2 a = x[2], b = x[6]; x[2] = a + b; x[6] = cmul(a - b, (f32x2){w1.y, -w1.x}); }
    { f32x2 a = x[3], b = x[7]; x[3] = a + b; x[7] = cmul(a - b, cmul(w1, (f32x2){-SQH, -SQH})); }
#pragma unroll
    for (int blk = 0; blk < 8; blk += 4) {
        { f32x2 a = x[blk], b = x[blk + 2]; x[blk] = a + b; x[blk + 2] = cmul(a - b, w2); }
        { f32x2 a = x[blk + 1], b = x[blk + 3]; x[blk + 1] = a + b; x[blk + 3] = cmul(a - b, (f32x2){w2.y, -w2.x}); }
    }
#pragma unroll
    for (int m = 0; m < 8; m += 2) { f32x2 a = x[m], b = x[m + 1]; x[m] = a + b; x[m + 1] = cmul(a - b, w4); }
}
__device__ __forceinline__ void bfly_dif8_unit(f32x2 (&x)[8]) {
    { f32x2 a = x[0], b = x[4]; x[0] = a + b; x[4] = a - b; }
    { f32x2 a = x[1], b = x[5]; x[1] = a + b; x[5] = cmul(a - b, (f32x2){SQH, -SQH}); }
    { f32x2 a = x[2], b = x[6]; x[2] = a + b; const f32x2 d = a - b; x[6] = (f32x2){d.y, -d.x}; }
    { f32x2 a = x[3], b = x[7]; x[3] = a + b; x[7] = cmul(a - b, (f32x2){-SQH, -SQH}); }
#pragma unroll
    for (int blk = 0; blk < 8; blk += 4) {
        { f32x2 a = x[blk], b = x[blk + 2]; x[blk] = a + b; x[blk + 2] = a - b; }
        { f32x2 a = x[blk + 1], b = x[blk + 3]; x[blk + 1] = a + b; const f32x2 d = a - b; x[blk + 3] = (f32x2){d.y, -d.x}; }
    }
#pragma unroll
    for (int m = 0; m < 8; m += 2) { f32x2 a = x[m], b = x[m + 1]; x[m] = a + b; x[m + 1] = a - b; }
}
__device__ __forceinline__ void bfly_dit8(f32x2 (&x)[8], const f32x2 w1) {
    const f32x2 w2 = cmul(w1, w1), w4 = cmul(w2, w2);
#pragma unroll
    for (int m = 0; m < 8; m += 2) { f32x2 a = x[m], b = cmul(x[m + 1], w4); x[m] = a + b; x[m + 1] = a - b; }
#pragma unroll
    for (int blk = 0; blk < 8; blk += 4) {
        { f32x2 a = x[blk], b = cmul(x[blk + 2], w2); x[blk] = a + b; x[blk + 2] = a - b; }
        { f32x2 a = x[blk + 1], b = cmul(x[blk + 3], (f32x2){-w2.y, w2.x}); x[blk + 1] = a + b; x[blk + 3] = a - b; }
    }
    { f32x2 a = x[0], b = cmul(x[4], w1); x[0] = a + b; x[4] = a - b; }
    { f32x2 a = x[1], b = cmul(x[5], cmul(w1, (f32x2){SQH, SQH})); x[1] = a + b; x[5] = a - b; }
    { f32x2 a = x[2], b = cmul(x[6], (f32x2){-w1.y, w1.x}); x[2] = a + b; x[6] = a - b; }
    { f32x2 a = x[3], b = cmul(x[7], cmul(w1, (f32x2){-SQH, SQH})); x[3] = a + b; x[7] = a - b; }
}
__device__ __forceinline__ void bfly_dit8_unit(f32x2 (&x)[8]) {
#pragma unroll
    for (int m = 0; m < 8; m += 2) { f32x2 a = x[m], b = x[m + 1]; x[m] = a + b; x[m + 1] = a - b; }
#pragma unroll
    for (int blk = 0; blk < 8; blk += 4) {
        { f32x2 a = x[blk], b = x[blk + 2]; x[blk] = a + b; x[blk + 2] = a - b; }
        { f32x2 a = x[blk + 1], b = (f32x2){-x[blk + 3].y, x[blk + 3].x}; x[blk + 1] = a + b; x[blk + 3] = a - b; }
    }
    { f32x2 a = x[0], b = x[4]; x[0] = a + b; x[4] = a - b; }
    { f32x2 a = x[1], b = cmul(x[5], (f32x2){SQH, SQH}); x[1] = a + b; x[5] = a - b; }
    { f32x2 a = x[2], b = (f32x2){-x[6].y, x[6].x}; x[2] = a + b; x[6] = a - b; }
    { f32x2 a = x[3], b = cmul(x[7], (f32x2){-SQH, SQH}); x[3] = a + b; x[7] = a - b; }
}
__device__ __forceinline__ void fft_dif8(f32x2* X, const int q) {
    const int qs = q + (q >> 3);
    __syncthreads();
#pragma unroll 1
    for (int o = threadIdx.x; o < 1024; o += NTHR) {
        const int pp = o & (q - 1), base = ((o - pp) << 3) + pp; f32x2* xb = X + PX(base);
        f32x2 x[8];
#pragma unroll
        for (int m = 0; m < 8; ++m) x[m] = xb[m * qs];
        float rev = -(float)pp / (float)(8 * q); asm volatile("" : "+v"(rev));
        bfly_dif8(x, (f32x2){__builtin_amdgcn_cosf(rev), __builtin_amdgcn_sinf(rev)});
#pragma unroll
        for (int m = 0; m < 8; ++m) xb[m * qs] = x[m];
    }
}
__device__ __forceinline__ void fft_dit8(f32x2* X, const int q) {
    const int qs = q + (q >> 3);
    __syncthreads();
#pragma unroll 1
    for (int o = threadIdx.x; o < 1024; o += NTHR) {
        const int pp = o & (q - 1), base = ((o - pp) << 3) + pp; f32x2* xb = X + PX(base);
        f32x2 x[8];
#pragma unroll
        for (int m = 0; m < 8; ++m) x[m] = xb[m * qs];
        float rev = (float)pp / (float)(8 * q); asm volatile("" : "+v"(rev));
        bfly_dit8(x, (f32x2){__builtin_amdgcn_cosf(rev), __builtin_amdgcn_sinf(rev)});
#pragma unroll
        for (int m = 0; m < 8; ++m) xb[m * qs] = x[m];
    }
}
__device__ __forceinline__ void fft_dif16_last(f32x2* X) {
    __syncthreads();
    f32x2* xp = X + 18 * threadIdx.x;
    f32x2 xe[8], xo[8];
#pragma unroll
    for (int k = 0; k < 8; ++k) { const f32x4 v = *(const f32x4*)(xp + 2 * k); xe[k] = (f32x2){v[0], v[1]}; xo[k] = (f32x2){v[2], v[3]}; }
    bfly_dif8_unit(xe);
    bfly_dif8(xo, (f32x2){C16, -S16});
#pragma unroll
    for (int k = 0; k < 8; ++k) { const f32x2 a = xe[k], b = xo[k]; *(f32x4*)(xp + 2 * k) = (f32x4){a.x + b.x, a.y + b.y, a.x - b.x, a.y - b.y}; }
}
__device__ __forceinline__ void fft_dit16_first(f32x2* X) {
    __syncthreads();
    f32x2* xp = X + 18 * threadIdx.x;
    f32x2 xe[8], xo[8];
#pragma unroll
    for (int k = 0; k < 8; ++k) { const f32x4 v = *(const f32x4*)(xp + 2 * k); xe[k] = (f32x2){v[0] + v[2], v[1] + v[3]}; xo[k] = (f32x2){v[0] - v[2], v[1] - v[3]}; }
    bfly_dit8_unit(xe);
    bfly_dit8(xo, (f32x2){C16, S16});
#pragma unroll
    for (int k = 0; k < 8; ++k) { const f32x2 a = xe[k], b = xo[k]; *(f32x4*)(xp + 2 * k) = (f32x4){a.x, a.y, b.x, b.y}; }
}
__device__ __forceinline__ void fft_dif8_zp(f32x2* X) {
    constexpr int q = 1024, qs = 1152;
    __syncthreads();
#pragma unroll 1
    for (int o = threadIdx.x; o < 1024; o += NTHR) {
        const int pp = o; f32x2* xb = X + PX(o);
        f32x2 x[8];
#pragma unroll
        for (int m = 0; m < 4; ++m) x[m] = xb[m * qs];
        float rev = -(float)pp / (float)(8 * q); asm volatile("" : "+v"(rev));
        const f32x2 w1 = {__builtin_amdgcn_cosf(rev), __builtin_amdgcn_sinf(rev)}; const f32x2 w2 = cmul(w1, w1), w4 = cmul(w2, w2);
        x[4] = cmul(x[0], w1);
        x[5] = cmul(x[1], cmul(w1, (f32x2){SQH, -SQH}));
        x[6] = cmul(x[2], (f32x2){w1.y, -w1.x});
        x[7] = cmul(x[3], cmul(w1, (f32x2){-SQH, -SQH}));
#pragma unroll
        for (int blk = 0; blk < 8; blk += 4) {
            { f32x2 a = x[blk], b = x[blk + 2]; x[blk] = a + b; x[blk + 2] = cmul(a - b, w2); }
            { f32x2 a = x[blk + 1], b = x[blk + 3]; x[blk + 1] = a + b; x[blk + 3] = cmul(a - b, (f32x2){w2.y, -w2.x}); }
        }
#pragma unroll
        for (int m = 0; m < 8; m += 2) { f32x2 a = x[m], b = x[m + 1]; x[m] = a + b; x[m + 1] = cmul(a - b, w4); }
#pragma unroll
        for (int m = 0; m < 8; ++m) xb[m * qs] = x[m];
    }
}
__device__ __forceinline__ void fft_dit8_half(f32x2* X) {
    constexpr int q = 1024, qs = 1152;
    __syncthreads();
#pragma unroll 1
    for (int o = threadIdx.x; o < 1024; o += NTHR) {
        const int pp = o; f32x2* xb = X + PX(o);
        f32x2 x[8];
#pragma unroll
        for (int m = 0; m < 8; ++m) x[m] = xb[m * qs];
        float rev = (float)pp / (float)(8 * q); asm volatile("" : "+v"(rev));
        const f32x2 w1 = {__builtin_amdgcn_cosf(rev), __builtin_amdgcn_sinf(rev)}; const f32x2 w2 = cmul(w1, w1), w4 = cmul(w2, w2);
#pragma unroll
        for (int m = 0; m < 8; m += 2) { f32x2 a = x[m], b = cmul(x[m + 1], w4); x[m] = a + b; x[m + 1] = a - b; }
#pragma unroll
        for (int blk = 0; blk < 8; blk += 4) {
            { f32x2 a = x[blk], b = cmul(x[blk + 2], w2); x[blk] = a + b; x[blk + 2] = a - b; }
            { f32x2 a = x[blk + 1], b = cmul(x[blk + 3], (f32x2){-w2.y, w2.x}); x[blk + 1] = a + b; x[blk + 3] = a - b; }
        }
        xb[0] = x[0] + cmul(x[4], w1);
        xb[qs] = x[1] + cmul(x[5], cmul(w1, (f32x2){SQH, SQH}));
        xb[2 * qs] = x[2] + cmul(x[6], (f32x2){-w1.y, w1.x});
        xb[3 * qs] = x[3] + cmul(x[7], cmul(w1, (f32x2){-SQH, SQH}));
    }
}
__device__ __forceinline__ void fft_mid16(f32x2* X, const f32x4 (&fv)[8]) {
    __syncthreads();
    f32x2* xp = X + 18 * threadIdx.x;
    f32x2 xe[8], xo[8];
#pragma unroll
    for (int k = 0; k < 8; ++k) { const f32x4 v = *(const f32x4*)(xp + 2 * k); xe[k] = (f32x2){v[0], v[1]}; xo[k] = (f32x2){v[2], v[3]}; }
    bfly_dif8_unit(xe);
    bfly_dif8(xo, (f32x2){C16, -S16});
#pragma unroll
    for (int k = 0; k < 8; ++k) {
        const f32x2 sm = cmul(xe[k] + xo[k], (f32x2){fv[k][0], fv[k][1]}), df = cmul(xe[k] - xo[k], (f32x2){fv[k][2], fv[k][3]});
        xe[k] = sm + df; xo[k] = sm - df; }
    bfly_dit8_unit(xe);
    bfly_dit8(xo, (f32x2){C16, S16});
#pragma unroll
    for (int k = 0; k < 8; ++k) { const f32x2 a = xe[k], b = xo[k]; *(f32x4*)(xp + 2 * k) = (f32x4){a.x, a.y, b.x, b.y}; }
}
__device__ __forceinline__ void fft_dif8_zp_regs(f32x2* X, const float (&zr)[8], const float (&zi)[8]) {
    constexpr int q = 1024, qs = 1152;
    __syncthreads();
#pragma unroll
    for (int j = 0; j < 2; ++j) {
        const int pp = threadIdx.x + 512 * j; f32x2* xb = X + PX(pp);
        f32x2 x[8];
#pragma unroll
        for (int m = 0; m < 4; ++m) x[m] = (f32x2){zr[2 * m + j], zi[2 * m + j]};
        float rev = -(float)pp / (float)(8 * q); asm volatile("" : "+v"(rev));
        const f32x2 w1 = {__builtin_amdgcn_cosf(rev), __builtin_amdgcn_sinf(rev)}; const f32x2 w2 = cmul(w1, w1), w4 = cmul(w2, w2);
        x[4] = cmul(x[0], w1);
        x[5] = cmul(x[1], cmul(w1, (f32x2){SQH, -SQH}));
        x[6] = cmul(x[2], (f32x2){w1.y, -w1.x});
        x[7] = cmul(x[3], cmul(w1, (f32x2){-SQH, -SQH}));
#pragma unroll
        for (int blk = 0; blk < 8; blk += 4) {
            { f32x2 a = x[blk], b = x[blk + 2]; x[blk] = a + b; x[blk + 2] = cmul(a - b, w2); }
            { f32x2 a = x[blk + 1], b = x[blk + 3]; x[blk + 1] = a + b; x[blk + 3] = cmul(a - b, (f32x2){w2.y, -w2.x}); }
        }
#pragma unroll
        for (int m = 0; m < 8; m += 2) { f32x2 a = x[m], b = x[m + 1]; x[m] = a + b; x[m + 1] = cmul(a - b, w4); }
#pragma unroll
        for (int m = 0; m < 8; ++m) xb[m * qs] = x[m];
    }
}
__device__ __forceinline__ void fft_dit8_half_regs(f32x2* X, f32x2 (&y)[8]) {
    constexpr int q = 1024, qs = 1152;
    __syncthreads();
#pragma unroll
    for (int j = 0; j < 2; ++j) {
        const int pp = threadIdx.x + 512 * j; const f32x2* xb = X + PX(pp);
        f32x2 x[8];
#pragma unroll
        for (int m = 0; m < 8; ++m) x[m] = xb[m * qs];
        float rev = (float)pp / (float)(8 * q); asm volatile("" : "+v"(rev));
        const f32x2 w1 = {__builtin_amdgcn_cosf(rev), __builtin_amdgcn_sinf(rev)}; const f32x2 w2 = cmul(w1, w1), w4 = cmul(w2, w2);
#pragma unroll
        for (int m = 0; m < 8; m += 2) { f32x2 a = x[m], b = cmul(x[m + 1], w4); x[m] = a + b; x[m + 1] = a - b; }
#pragma unroll
        for (int blk = 0; blk < 8; blk += 4) {
            { f32x2 a = x[blk], b = cmul(x[blk + 2], w2); x[blk] = a + b; x[blk + 2] = a - b; }
            { f32x2 a = x[blk + 1], b = cmul(x[blk + 3], (f32x2){-w2.y, w2.x}); x[blk + 1] = a + b; x[blk + 3] = a - b; }
        }
        y[j] = x[0] + cmul(x[4], w1);
        y[2 + j] = x[1] + cmul(x[5], cmul(w1, (f32x2){SQH, SQH}));
        y[4 + j] = x[2] + cmul(x[6], (f32x2){-w1.y, w1.x});
        y[6 + j] = x[3] + cmul(x[7], cmul(w1, (f32x2){-SQH, SQH}));
    }
}
__device__ __forceinline__ void fft_fwd(f32x2* X) { fft_dif8(X, 1024); fft_dif8(X, 128); fft_dif8(X, 16); fft_dif16_last(X); }

__device__ __forceinline__ void phase_filtfft(const Params& p, unsigned char* lds) {
    f32x2* X = (f32x2*)lds;
    for (int u = blockIdx.x; u < 1024; u += gridDim.x) {
        const float* g = p.G + (size_t)u * 8192;
        __syncthreads();
        for (int tau = threadIdx.x; tau < 8192; tau += NTHR) X[PX(tau)] = (f32x2){g[(tau + 4096) & 8191], 0.f};
        fft_fwd(X);
        __syncthreads();
        f32x2* o = p.FF + (size_t)u * 8192;
        for (int r = threadIdx.x; r < 8192; r += NTHR) o[r] = X[PX(r)] * (1.f / 8192.f);
    }
}
__device__ __forceinline__ void phase_shortconv(const Params& p, unsigned char* lds) {
    bf16_t* RAW = (bf16_t*)lds;
    const int tid = threadIdx.x, cc = tid >> 3, seg = tid & 7;
    u32x4 rm, rh = {0u, 0u, 0u, 0u}; float cw0, cw1, cw2, cbv;
#define SC_LOAD(uu) do { const int ct_ = (uu) % 24, tt_ = ((uu) / 24) & 63, b_ = (uu) / (24 * 64); \
        const bf16_t* pb_ = p.P + (size_t)(NCTX + b_ * 4096 + tt_ * 64) * ODW + ct_ * 64 + seg * 8; \
        rm = *(const u32x4*)(pb_ + (size_t)cc * ODW); \
        if (tid < 16) { const bool up_ = tid < 8; const bool ok_ = up_ ? (tt_ > 0) : (tt_ < 63); const ptrdiff_t ro_ = ok_ ? (up_ ? -(ptrdiff_t)ODW : (ptrdiff_t)64 * ODW) : 0; \
          rh = *(const u32x4*)(pb_ + ro_); if (!ok_) rh = (u32x4){0u, 0u, 0u, 0u}; } \
        const int c_ = ct_ * 64 + cc; cw0 = p.hy_conv_w[c_]; cw1 = p.hy_conv_w[1536 + c_]; cw2 = p.hy_conv_w[3072 + c_]; cbv = p.hy_conv_b[c_]; } while (0)
    const int NU = 8 * 64 * 24;
    SC_LOAD((int)blockIdx.x < NU ? (int)blockIdx.x : 0);
    for (int u = blockIdx.x; u < NU; u += gridDim.x) {
        const int ct = u % 24, tt = (u / 24) & 63, b = u / (24 * 64);
        __syncthreads();
        { unsigned* d = (unsigned*)(RAW + (cc + 1) * 66 + seg * 8); d[0] = rm.x; d[1] = rm.y; d[2] = rm.z; d[3] = rm.w; }
        if (tid < 16) { unsigned* d = (unsigned*)(RAW + (tid < 8 ? 0 : 65) * 66 + seg * 8); d[0] = rh.x; d[1] = rh.y; d[2] = rh.z; d[3] = rh.w; }
        const float w0 = cw0, w1 = cw1, w2 = cw2, wb = cbv;
        { const int un = u + (int)gridDim.x < NU ? u + (int)gridDim.x : u; SC_LOAD(un); }
        __syncthreads();
        float x[10];
#pragma unroll
        for (int k = 0; k < 10; ++k) x[k] = bf2f(RAW[(seg * 8 + k) * 66 + cc]);
        f32x4 o0, o1;
#pragma unroll
        for (int k = 0; k < 4; ++k) { o0[k] = wb + x[k] * w0 + x[k + 1] * w1 + x[k + 2] * w2; o1[k] = wb + x[k + 4] * w0 + x[k + 5] * w1 + x[k + 6] * w2; }
        const int cg = ct * 64 + cc; const int plane = cg >> 9, cl = cg & 511;
        *(bf16x8*)(p.UH + (((size_t)plane * 8 + b) * 512 + cl) * 4096 + tt * 64 + seg * 8) = pack8(o0, o1);
    }
#undef SC_LOAD
}
__device__ __forceinline__ void phase_hyena(const Params& p, unsigned char* lds, const int u0, const int u1, const int ust) {
    f32x2* X = (f32x2*)lds;
    const int tid = threadIdx.x;
    bf16_t nv0[8], nv1[8];
#define HY_LOADV(uu) do { const int c_ = (uu) >> 2, b0_ = ((uu) & 3) * 2; const bf16_t* v0p = p.UH + ((size_t)b0_ * 512 + c_) * 4096 + tid; const bf16_t* v1p = v0p + (size_t)512 * 4096; \
        _Pragma("unroll") for (int k = 0; k < 8; ++k) { nv0[k] = v0p[NTHR * k]; nv1[k] = v1p[NTHR * k]; } } while (0)
    if (u0 < u1) HY_LOADV(u0);
    for (int u = u0; u < u1; u += ust) {
        const int c = u >> 2, b0 = (u & 3) * 2, b1 = b0 + 1;
        float zr[8], zi[8];
#pragma unroll
        for (int k = 0; k < 8; ++k) { zr[k] = bf2f(nv0[k]); zi[k] = bf2f(nv1[k]); }
#pragma unroll 1
        for (int n = 0; n < 2; ++n) {
            if (n == 1) { const int un = u + ust < u1 ? u + ust : u; HY_LOADV(un); }
            const f32x2* ff = p.FF + ((size_t)n * 512 + c) * 8192 + 16 * tid;
            f32x4 fv[8];
#pragma unroll
            for (int k = 0; k < 8; ++k) fv[k] = *(const f32x4*)(ff + 2 * k);
            const bf16_t* g0p = p.UH + ((size_t)((n + 1) * 8 + b0) * 512 + c) * 4096; const bf16_t* g1p = p.UH + ((size_t)((n + 1) * 8 + b1) * 512 + c) * 4096;
            bf16_t g0[8], g1[8];
#pragma unroll
            for (int k = 0; k < 8; ++k) { g0[k] = g0p[tid + NTHR * k]; g1[k] = g1p[tid + NTHR * k]; }
            const float bias = p.hy_bias[n * 512 + c];
            fft_dif8_zp_regs(X, zr, zi); fft_dif8(X, 128); fft_dif8(X, 16);
            fft_mid16(X, fv);
            fft_dit8(X, 16); fft_dit8(X, 128);
            f32x2 y[8]; fft_dit8_half_regs(X, y);
#pragma unroll
            for (int k = 0; k < 8; ++k) {
                const int t = tid + NTHR * k;
                zr[k] = bf2f(g0[k]) * (y[k].x + zr[k] * bias); zi[k] = bf2f(g1[k]) * (y[k].y + zi[k] * bias);
                if (n == 1) { p.Z1[((size_t)b0 * 512 + c) * 4096 + t] = f2bf(zr[k]); p.Z1[((size_t)b1 * 512 + c) * 4096 + t] = f2bf(zi[k]); }
            }
        }
    }
}
__device__ __forceinline__ void phase_zt2y(const Params& p, unsigned char* lds) {
    float* T = (float*)lds;
    const int tid = threadIdx.x, cc = tid >> 3, seg = tid & 7;
    const int NU = 8 * 64 * 8;
    u32x4 nw;
#define ZT_LOAD(uu) do { const int ct_ = (uu) & 7, tt_ = ((uu) >> 3) & 63, b_ = (uu) >> 9; nw = *(const u32x4*)(p.Z1 + ((size_t)b_ * 512 + ct_ * 64 + cc) * 4096 + tt_ * 64 + seg * 8); } while (0)
    ZT_LOAD((int)blockIdx.x < NU ? (int)blockIdx.x : 0);
    for (int u = blockIdx.x; u < NU; u += gridDim.x) {
        const int ct = u & 7, tt = (u >> 3) & 63, b = u >> 9;
        const u32x4 iw = nw; const f32x4 i0 = bf4_to_f32((u32x2){iw.x, iw.y}), i1 = bf4_to_f32((u32x2){iw.z, iw.w});
        { const int un = u + (int)gridDim.x < NU ? u + (int)gridDim.x : u; ZT_LOAD(un); }
        asm volatile("" ::: "memory");
        __syncthreads();
#pragma unroll
        for (int e = 0; e < 4; ++e) { T[cc * 65 + seg * 8 + e] = i0[e]; T[cc * 65 + seg * 8 + 4 + e] = i1[e]; }
        __syncthreads();
        const int t = tid >> 3, cs = tid & 7; f32x4 o0, o1;
#pragma unroll
        for (int e = 0; e < 4; ++e) { o0[e] = T[(cs * 8 + e) * 65 + t]; o1[e] = T[(cs * 8 + 4 + e) * 65 + t]; }
        *(bf16x8*)(p.Y + (size_t)(NCTX + b * 4096 + tt * 64 + t) * DM + ct * 64 + cs * 8) = pack8(o0, o1);
    }
#undef ZT_LOAD
}
struct RwRaw { f32x4 own, sh; };
__device__ __forceinline__ RwRaw rw_raw4(const Params& p, int r, int cc) {
    const bf16_t* pr = p.P + (size_t)r * ODW + 1536 + cc;
    const bool isctx = r < NCTX; const int t = isctx ? (r & 255) : ((r - NCTX) & 4095); const int gr = t >> 6, gc = t & 63;
    const bool v0 = isctx ? (t > 0) : (gc > 0), v1 = isctx ? (t < 255) : (gc < 63), v2 = isctx ? (t > 0) : (gr > 0), v3 = isctx ? (t < 255) : (gr < 63);
    const int o2 = isctx ? -ODW : -64 * ODW, o3 = isctx ? ODW : 64 * ODW;
    const bf16_t x0 = pr[v0 ? -ODW : 0], x1 = pr[(v1 ? ODW : 0) + 1], x2 = pr[(v2 ? o2 : 0) + 2], x3 = pr[(v3 ? o3 : 0) + 3];
    RwRaw R; R.own = bf4_to_f32(*(const u32x2*)pr);
    R.sh[0] = v0 ? bf2f(x0) : 0.f; R.sh[1] = v1 ? bf2f(x1) : 0.f; R.sh[2] = v2 ? bf2f(x2) : 0.f; R.sh[3] = v3 ? bf2f(x3) : 0.f;
    return R;
}
__device__ __forceinline__ f32x4 rw_mix(const RwRaw& R, const f32x4 mu4) { return R.own + mu4 * (R.sh - R.own); }
__device__ __forceinline__ f32x4 rw_mix4(const Params& p, int r, int cc) { const RwRaw R = rw_raw4(p, r, cc); return rw_mix(R, *(const f32x4*)(p.rw_mu + cc)); }
__device__ __forceinline__ float fsig(float x) { return __builtin_amdgcn_rcpf(1.f + __expf(-x)); }
struct RwRaw8 { u32x4 own, n0, n1, n2, n3; };
__device__ __forceinline__ float red8(float x);
__device__ __forceinline__ float sum4(f32x4 v);
__device__ __forceinline__ RwRaw8 rw_raw8(const Params& p, int r, int col) {
    const bf16_t* pr = p.P + (size_t)r * ODW + col;
    const bool isctx = r < NCTX; const int t = isctx ? (r & 255) : ((r - NCTX) & 4095); const int gr = t >> 6, gc = t & 63;
    const bool v0 = isctx ? (t > 0) : (gc > 0), v1 = isctx ? (t < 255) : (gc < 63), v2 = isctx ? (t > 0) : (gr > 0), v3 = isctx ? (t < 255) : (gr < 63);
    const int o2 = isctx ? -ODW : -64 * ODW, o3 = isctx ? ODW : 64 * ODW;
    RwRaw8 R; R.own = *(const u32x4*)pr; R.n0 = *(const u32x4*)(pr + (v0 ? -ODW : 0)); R.n1 = *(const u32x4*)(pr + (v1 ? ODW : 0)); R.n2 = *(const u32x4*)(pr + (v2 ? o2 : 0)); R.n3 = *(const u32x4*)(pr + (v3 ? o3 : 0));
    return R;
}
__device__ __forceinline__ void rw_mix8(const RwRaw8& R, int r, const f32x4 mu0, const f32x4 mu1, f32x4& m0, f32x4& m1) {
    const bool isctx = r < NCTX; const int t = isctx ? (r & 255) : ((r - NCTX) & 4095); const int gr = t >> 6, gc = t & 63;
    const bool v0 = isctx ? (t > 0) : (gc > 0), v1 = isctx ? (t < 255) : (gc < 63), v2 = isctx ? (t > 0) : (gr > 0), v3 = isctx ? (t < 255) : (gr < 63);
    const f32x4 o0 = bf4_to_f32((u32x2){R.own.x, R.own.y}), o1 = bf4_to_f32((u32x2){R.own.z, R.own.w});
    const f32x4 s0 = {v0 ? __uint_as_float(R.n0.x << 16) : 0.f, v1 ? __uint_as_float(R.n1.x & 0xffff0000u) : 0.f, v2 ? __uint_as_float(R.n2.y << 16) : 0.f, v3 ? __uint_as_float(R.n3.y & 0xffff0000u) : 0.f};
    const f32x4 s1 = {v0 ? __uint_as_float(R.n0.z << 16) : 0.f, v1 ? __uint_as_float(R.n1.z & 0xffff0000u) : 0.f, v2 ? __uint_as_float(R.n2.w << 16) : 0.f, v3 ? __uint_as_float(R.n3.w & 0xffff0000u) : 0.f};
    m0 = o0 + mu0 * (s0 - o0); m1 = o1 + mu1 * (s1 - o1);
}
__device__ __forceinline__ void phase_rwstreams(const Params& p, unsigned char* lds) {
    constexpr int XS = 328, KS = 520;
    constexpr int TR = 64;
    bf16_t* X = (bf16_t*)lds;
    float* ss = (float*)(X + TR * XS);
    bf16_t* KMX = (bf16_t*)(ss + TR * 8);
    const int tid = threadIdx.x, lane = tid & 63, h = tid >> 6, q4 = lane >> 4, l15 = lane & 15;
    for (int ti = blockIdx.x; ti < NT / TR; ti += gridDim.x) {
        const int tile = mg8::xcd_remap(ti, NT / TR);
        const int r0 = tile * TR;
        __syncthreads();
        {
#define RWX_ONE(n_) do { const int it = tid + (n_) * NTHR; const int row = it / 40, cc = (it % 40) * 8; \
            f32x4 m0, m1; rw_mix8(xr[(n_) % 3], r0 + row, *(const f32x4*)(p.rw_mu + 1536 + cc), *(const f32x4*)(p.rw_mu + 1536 + cc + 4), m0, m1); \
            if (cc < 128) { _Pragma("unroll") for (int e = 0; e < 4; ++e) { m0[e] = 1.f - 2.f * __builtin_amdgcn_rcpf(1.f + __expf(2.f * m0[e])); m1[e] = 1.f - 2.f * __builtin_amdgcn_rcpf(1.f + __expf(2.f * m1[e])); } } \
            else if (cc >= 192) { _Pragma("unroll") for (int e = 0; e < 4; ++e) { m0[e] = fsig(m0[e]); m1[e] = fsig(m1[e]); } } \
            *(bf16x8*)(X + row * XS + cc) = pack8(m0, m1); } while (0)
#define RWX_LD(n_) do { const int it = tid + (n_) * NTHR; xr[(n_) % 3] = rw_raw8(p, r0 + it / 40, 3072 + (it % 40) * 8); } while (0)
            RwRaw8 xr[3];
            RWX_LD(0); RWX_LD(1); RWX_LD(2);
            RWX_ONE(0); RWX_LD(3); RWX_ONE(1); RWX_LD(4); RWX_ONE(2); RWX_ONE(3); RWX_ONE(4);
#undef RWX_ONE
#undef RWX_LD
        }
        {
            constexpr int BT = 4, NBT = TR * 192 / (NTHR * BT);
            RwRaw8 raw[BT]; f32x4 mu[BT][2];
#define RKV_LOAD(b_) do { _Pragma("unroll") for (int j = 0; j < BT; ++j) { const int it = tid + ((b_) * BT + j) * NTHR; const int c8 = (it % 192) * 8; \
            raw[j] = rw_raw8(p, r0 + it / 192, 1536 + c8); mu[j][0] = *(const f32x4*)(p.rw_mu + c8); mu[j][1] = *(const f32x4*)(p.rw_mu + c8 + 4); } } while (0)
            RKV_LOAD(0);
#pragma unroll 1
            for (int bt = 0; bt < NBT; ++bt) {
                bf16x8 outv[BT];
#pragma unroll
                for (int j = 0; j < BT; ++j) {
                    const int it = tid + (bt * BT + j) * NTHR; const int row = it / 192, g8 = it % 192;
                    f32x4 m0, m1; rw_mix8(raw[j], r0 + row, mu[j][0], mu[j][1], m0, m1);
                    outv[j] = pack8(m0, m1);
                    if (g8 >= 64 && g8 < 128) {
                        const int kq = (g8 - 64) * 8;
                        const f32x4 a4 = m0 * *(const f32x4*)(p.rw_k_k + kq), b4 = m1 * *(const f32x4*)(p.rw_k_k + kq + 4);
                        const float sacc = red8(sum4(a4 * a4) + sum4(b4 * b4));
                        if ((lane & 7) == 0) ss[row * 8 + (kq >> 6)] = sacc;
                        *(bf16x8*)(KMX + row * KS + kq) = outv[j];
                    }
                }
                asm volatile("" ::: "memory");
                { const int nb = bt + 1 < NBT ? bt + 1 : bt; RKV_LOAD(nb); }
                asm volatile("" ::: "memory");
#pragma unroll
                for (int j = 0; j < BT; ++j) {
                    const int it = tid + (bt * BT + j) * NTHR; const int row = it / 192, g8 = it % 192; const size_t ro = (size_t)(r0 + row) * 512;
                    if (g8 < 64) *(bf16x8*)(p.RR + ro + g8 * 8) = outv[j];
                    else if (g8 >= 128) *(bf16x8*)(p.VV + ro + (g8 - 128) * 8) = outv[j];
                }
                asm volatile("" ::: "memory");
            }
#undef RKV_LOAD
        }
        __syncthreads();
#pragma unroll 4
        for (int it = tid; it < TR * 128; it += NTHR) {
            const int row = it >> 7, kq = it & 127;
            const u32x2 mk = *(const u32x2*)(KMX + row * KS + kq * 4);
            const f32x4 k4 = {__uint_as_float(mk.x << 16), __uint_as_float(mk.x & 0xffff0000u), __uint_as_float(mk.y << 16), __uint_as_float(mk.y & 0xffff0000u)};
            const float rn = __builtin_amdgcn_rsqf(fmaxf(ss[row * 8 + (kq >> 4)], 1e-24f));
            *(u32x2*)(p.KK + (size_t)(r0 + row) * 512 + kq * 4) = f32_to_bf4(k4 * *(const f32x4*)(p.rw_k_k + kq * 4) * rn);
        }
        bf16x8 nwf[2], nwb[2], nwa[2], nwg[4];
#define RWM_LOAD(ct_) do { const int cw_ = h * 64 + (ct_) * 16 + l15; \
            _Pragma("unroll") for (int ks = 0; ks < 2; ++ks) { nwf[ks] = *(const bf16x8*)(p.WT_RWF + (size_t)cw_ * 64 + ks * 32 + q4 * 8); nwb[ks] = *(const bf16x8*)(p.WT_RWB + (size_t)cw_ * 64 + ks * 32 + q4 * 8); nwa[ks] = *(const bf16x8*)(p.WT_RWA + (size_t)cw_ * 64 + ks * 32 + q4 * 8); } \
            _Pragma("unroll") for (int ks = 0; ks < 4; ++ks) nwg[ks] = *(const bf16x8*)(p.WT_RWG + (size_t)cw_ * 128 + ks * 32 + q4 * 8); \
            } while (0)
        RWM_LOAD(0);
#pragma unroll 1
        for (int ct = 0; ct < 4; ++ct) {
            const int c0 = h * 64 + ct * 16 + q4 * 4;
            bf16x8 wf[2], wb[2], wa[2], wg[4];
#pragma unroll
            for (int ks = 0; ks < 2; ++ks) { wf[ks] = nwf[ks]; wb[ks] = nwb[ks]; wa[ks] = nwa[ks]; }
#pragma unroll
            for (int ks = 0; ks < 4; ++ks) wg[ks] = nwg[ks];
            const f32x4 w0f = *(const f32x4*)(p.rw_w0 + c0), w0b = *(const f32x4*)(p.rw_w0 + 512 + c0), a0 = *(const f32x4*)(p.rw_a0 + c0), kkw = *(const f32x4*)(p.rw_k_k + c0), kaw = *(const f32x4*)(p.rw_k_a + c0);
            { const int ctn = ct < 3 ? ct + 1 : 3; RWM_LOAD(ctn); }
#pragma unroll 1
            for (int rt = 0; rt < TR / 16; ++rt) {
                const int rloc = rt * 16 + l15; const int row = r0 + rloc;
                f32x4 aF = {0.f, 0.f, 0.f, 0.f}, aB = aF, aA = aF, aG = aF;
                const bf16_t* xr = X + rloc * XS + q4 * 8;
#pragma unroll
                for (int ks = 0; ks < 2; ++ks) {
                    aF = __builtin_amdgcn_mfma_f32_16x16x32_bf16(wf[ks], *(const bf16x8*)(xr + ks * 32), aF, 0, 0, 0);
                    aB = __builtin_amdgcn_mfma_f32_16x16x32_bf16(wb[ks], *(const bf16x8*)(xr + 64 + ks * 32), aB, 0, 0, 0);
                    aA = __builtin_amdgcn_mfma_f32_16x16x32_bf16(wa[ks], *(const bf16x8*)(xr + 128 + ks * 32), aA, 0, 0, 0);
                }
#pragma unroll
                for (int ks = 0; ks < 4; ++ks) aG = __builtin_amdgcn_mfma_f32_16x16x32_bf16(wg[ks], *(const bf16x8*)(xr + 192 + ks * 32), aG, 0, 0, 0);
                const u32x2 mk = *(const u32x2*)(KMX + rloc * KS + c0);
                const f32x4 k4 = {__uint_as_float(mk.x << 16), __uint_as_float(mk.x & 0xffff0000u), __uint_as_float(mk.y << 16), __uint_as_float(mk.y & 0xffff0000u)};
                const float rn = __builtin_amdgcn_rsqf(fmaxf(ss[rloc * 8 + h], 1e-24f));
                const size_t o = (size_t)row * 512 + c0;
                f32x4 ldf, ldb, bvv, kp;
#pragma unroll
                for (int e = 0; e < 4; ++e) {
                    ldf[e] = -0.60653065971f * fsig(w0f[e] + aF[e]); ldb[e] = -0.60653065971f * fsig(w0b[e] + aB[e]);
                    const float av = fsig(a0[e] + aA[e]);
                    bvv[e] = k4[e] * kkw[e] * rn * av; kp[e] = k4[e] * (1.f + (av - 1.f) * kaw[e]);
                }
                *(u32x2*)(p.DEC + o) = f32_to_bf4(ldf); *(u32x2*)(p.DEC + (size_t)NT * 512 + o) = f32_to_bf4(ldb);
                *(u32x2*)(p.BV + o) = f32_to_bf4(bvv); *(u32x2*)(p.KP + o) = f32_to_bf4(kp); *(u32x2*)(p.GT + o) = f32_to_bf4(aG + 0.f);
            }
        }
    }
}
#define RW_NUNIT 8704
__device__ __forceinline__ void phase_rwprep(const Params& p, unsigned char* lds) {
    constexpr int SL = 64 * 72;
    float* MT = (float*)lds;
    float* ptot = MT + 64 * 68;
    float* gcv = ptot + 512;
    bf16_t* L = (bf16_t*)(gcv + 64);
    bf16_t *sBp = L, *sKp = L + SL, *sKKm = L + 2 * SL, *sRg = L + 3 * SL, *sBpT = L + 4 * SL, *sKpT = L + 5 * SL, *sKKmT = L + 6 * SL, *sVT = L + 7 * SL, *sNT = L + 8 * SL, *sArT = L + 9 * SL, *sNrT = L + 10 * SL;
    bf16_t *sX2 = sBp, *sTmT = sKp, *sWn = sKKm, *sU2n = sNT;
    const int tid = threadIdx.x, lane = tid & 63, w = tid >> 6, q4 = lane >> 4, l15 = lane & 15;
    bf16_t* PK = L + 8 * SL;
    u32x4 pq[6];
#define RWP_LOAD(uu) do { const int c_ = (uu) % 68, h_ = ((uu) / 68) & 7, b_ = ((uu) / (68 * 8)) & 7, dir_ = (uu) / (68 * 64); \
        const size_t o_ = (size_t)row_of(dir_, b_, c_ * 64 + (tid >> 3)) * 512 + h_ * 64 + (tid & 7) * 8; \
        pq[0] = *(const u32x4*)(p.DEC + (size_t)dir_ * NT * 512 + o_); pq[1] = *(const u32x4*)(p.KK + o_); pq[2] = *(const u32x4*)(p.BV + o_); \
        pq[3] = *(const u32x4*)(p.KP + o_); pq[4] = *(const u32x4*)(p.RR + o_); pq[5] = *(const u32x4*)(p.VV + o_); } while (0)
    if ((int)blockIdx.x < RW_NUNIT) RWP_LOAD((int)blockIdx.x);
    for (int u = blockIdx.x; u < RW_NUNIT; u += gridDim.x) {
        const int c = u % 68, h = (u / 68) & 7, b = (u / (68 * 8)) & 7, dir = u / (68 * 64);
        __syncthreads();
#pragma unroll
        for (int s6 = 0; s6 < 6; ++s6) *(u32x4*)(PK + s6 * 4096 + tid * 8) = pq[s6];
        { const int un = u + (int)gridDim.x < RW_NUNIT ? u + (int)gridDim.x : u; RWP_LOAD(un); }
        __syncthreads();
        {
            const int k = lane, part = w;
            float lcv[8], ldv[8], kkv[8], bvv[8], kpv[8], rv[8], pvv[8]; float lc = 0.f;
#pragma unroll
            for (int tt = 0; tt < 8; ++tt) {
                const bf16_t* pk = PK + (w * 8 + tt) * 64 + lane;
                ldv[tt] = bf2f(pk[0]); kkv[tt] = bf2f(pk[4096]); bvv[tt] = bf2f(pk[2 * 4096]); kpv[tt] = bf2f(pk[3 * 4096]); rv[tt] = bf2f(pk[4 * 4096]); pvv[tt] = bf2f(pk[5 * 4096]);
                lc += ldv[tt]; lcv[tt] = lc;
            }
            ptot[part * 64 + k] = lc;
            *(bf16x8*)(sVT + lane * 72 + w * 8) = pack8((f32x4){pvv[0], pvv[1], pvv[2], pvv[3]}, (f32x4){pvv[4], pvv[5], pvv[6], pvv[7]});
            __syncthreads();
            float off = 0.f, tot = 0.f;
#pragma unroll
            for (int pp = 0; pp < 8; ++pp) { const float tv = ptot[pp * 64 + k]; if (pp < part) off += tv; tot += tv; }
            if (part == 0) gcv[k] = __expf(tot);
            float xa[8], xb[8], xc[8];
#pragma unroll
            for (int tt = 0; tt < 8; ++tt) {
                const int j = part * 8 + tt; const float lw = lcv[tt] + off;
                const float eg = __expf(lw), ig = __expf(-lw), egm = __expf(lw - ldv[tt]);
                xa[tt] = kkv[tt] * egm; xb[tt] = bvv[tt] * ig; xc[tt] = kpv[tt] * ig;
                sKKm[j * 72 + k] = f2bf(xa[tt]); sBp[j * 72 + k] = f2bf(xb[tt]); sKp[j * 72 + k] = f2bf(xc[tt]); sRg[j * 72 + k] = f2bf(rv[tt] * eg);
            }
            *(bf16x8*)(sKKmT + k * 72 + part * 8) = pack8((f32x4){xa[0], xa[1], xa[2], xa[3]}, (f32x4){xa[4], xa[5], xa[6], xa[7]});
            *(bf16x8*)(sBpT + k * 72 + part * 8) = pack8((f32x4){xb[0], xb[1], xb[2], xb[3]}, (f32x4){xb[4], xb[5], xb[6], xb[7]});
            *(bf16x8*)(sKpT + k * 72 + part * 8) = pack8((f32x4){xc[0], xc[1], xc[2], xc[3]}, (f32x4){xc[4], xc[5], xc[6], xc[7]});
        }
        __syncthreads();
#pragma unroll
        for (int rep = 0; rep < 2; ++rep) {
            const int pos = w + rep * 8, tt_ = pos >> 2, jt_ = pos & 3;
            f32x4 aM = {0.f, 0.f, 0.f, 0.f}, aN = aM, aA = aM, aR = aM;
#pragma unroll
            for (int ks = 0; ks < 2; ++ks) {
                const bf16x8 fbp = *(const bf16x8*)(sBp + (jt_ * 16 + l15) * 72 + ks * 32 + q4 * 8), fkp = *(const bf16x8*)(sKp + (jt_ * 16 + l15) * 72 + ks * 32 + q4 * 8);
                const bf16x8 fkk = *(const bf16x8*)(sKKm + (tt_ * 16 + l15) * 72 + ks * 32 + q4 * 8), frg = *(const bf16x8*)(sRg + (tt_ * 16 + l15) * 72 + ks * 32 + q4 * 8);
                aM = __builtin_amdgcn_mfma_f32_16x16x32_bf16(fbp, fkk, aM, 0, 0, 0); aN = __builtin_amdgcn_mfma_f32_16x16x32_bf16(fkp, fkk, aN, 0, 0, 0);
                aA = __builtin_amdgcn_mfma_f32_16x16x32_bf16(fbp, frg, aA, 0, 0, 0); aR = __builtin_amdgcn_mfma_f32_16x16x32_bf16(fkp, frg, aR, 0, 0, 0);
            }
            const int t = tt_ * 16 + l15, j0 = jt_ * 16 + q4 * 4;
#pragma unroll
            for (int e = 0; e < 4; ++e) { const bool st = (j0 + e) < t, le = (j0 + e) <= t; aM[e] = st ? aM[e] : 0.f; aN[e] = st ? aN[e] : 0.f; aA[e] = le ? aA[e] : 0.f; aR[e] = le ? aR[e] : 0.f; }
#pragma unroll
            for (int e = 0; e < 4; ++e) MT[t * 68 + ((j0 + e) & 7) * 8 + ((j0 + e) >> 3)] = aM[e];
            u32x2 wv; wv.x = pk2(aN[0], aN[1]); wv.y = pk2(aN[2], aN[3]); *(u32x2*)(sNT + t * 72 + j0) = wv;
            wv.x = pk2(aA[0], aA[1]); wv.y = pk2(aA[2], aA[3]); *(u32x2*)(sArT + t * 72 + j0) = wv;
            wv.x = pk2(aR[0], aR[1]); wv.y = pk2(aR[2], aR[3]); *(u32x2*)(sNrT + t * 72 + j0) = wv;
        }
        __syncthreads();
        {
#pragma unroll
            for (int rep = 0; rep < 2; ++rep) {
                const int tile = w * 2 + rep, vt_ = tile >> 2, tt_ = tile & 3;
                f32x4 acc = {0.f, 0.f, 0.f, 0.f};
#pragma unroll
                for (int ks = 0; ks < 2; ++ks) {
                    const bf16x8 fa = *(const bf16x8*)(sNT + (tt_ * 16 + l15) * 72 + ks * 32 + q4 * 8), fb = *(const bf16x8*)(sVT + (vt_ * 16 + l15) * 72 + ks * 32 + q4 * 8);
                    acc = __builtin_amdgcn_mfma_f32_16x16x32_bf16(fa, fb, acc, 0, 0, 0);
                }
                u32x2 wv; wv.x = pk2(acc[0], acc[1]); wv.y = pk2(acc[2], acc[3]); *(u32x2*)(sX2 + (vt_ * 16 + l15) * 72 + tt_ * 16 + q4 * 4) = wv;
            }
            const int srow = w * 8 + (lane >> 3), sub = lane & 7;
            float tm8[8];
#pragma unroll
            for (int jj = 0; jj < 8; ++jj) tm8[jj] = 0.f;
#pragma unroll
            for (int tb = 0; tb < 8; ++tb) {
                f32x4 mA[8], mB[8];
#pragma unroll
                for (int e = 0; e < 8; ++e) { mA[e] = *(const f32x4*)(MT + (tb * 8 + e) * 68 + sub * 8); if (tb >= 4) mB[e] = *(const f32x4*)(MT + (tb * 8 + e) * 68 + sub * 8 + 4); else mB[e] = (f32x4){0.f, 0.f, 0.f, 0.f}; }
#pragma unroll
                for (int e = 0; e < 8; ++e) {
                    const int t = tb * 8 + e;
                    float part = tm8[0] * mA[e][0], part1 = 0.f;
                    if (t > 8) part1 = tm8[1] * mA[e][1];
                    if (t > 16) part += tm8[2] * mA[e][2];
                    if (t > 24) part1 += tm8[3] * mA[e][3];
                    if (t > 32) part += tm8[4] * mB[e][0];
                    if (t > 40) part1 += tm8[5] * mB[e][1];
                    if (t > 48) part += tm8[6] * mB[e][2];
                    if (t > 56) part1 += tm8[7] * mB[e][3];
                    part += part1;
                    part += __int_as_float(__builtin_amdgcn_update_dpp(0, __float_as_int(part), 0xB1, 0xF, 0xF, false));
                    part += __int_as_float(__builtin_amdgcn_update_dpp(0, __float_as_int(part), 0x4E, 0xF, 0xF, false));
                    part += __int_as_float(__builtin_amdgcn_update_dpp(0, __float_as_int(part), 0x141, 0xF, 0xF, false));
                    const float sacc = ((t == srow) ? 1.f : 0.f) - part;
                    if (sub == (t & 7)) { tm8[t >> 3] = sacc; sTmT[t * 72 + srow] = f2bf(sacc); }
                }
            }
        }
        __syncthreads();
#pragma unroll
        for (int rep = 0; rep < 4; ++rep) {
            const int tile = w * 4 + rep, it_ = tile >> 2, tt_ = tile & 3;
            const bf16_t* rhs = it_ < 4 ? sKKmT + (it_ * 16 + l15) * 72 : sX2 + ((it_ - 4) * 16 + l15) * 72;
            f32x4 acc = {0.f, 0.f, 0.f, 0.f};
#pragma unroll
            for (int ks = 0; ks < 2; ++ks) {
                const bf16x8 fa = *(const bf16x8*)(sTmT + (tt_ * 16 + l15) * 72 + ks * 32 + q4 * 8), fb = *(const bf16x8*)(rhs + ks * 32 + q4 * 8);
                acc = __builtin_amdgcn_mfma_f32_16x16x32_bf16(fa, fb, acc, 0, 0, 0);
            }
            bf16_t* dst = it_ < 4 ? sWn + (it_ * 16 + l15) * 72 : sU2n + ((it_ - 4) * 16 + l15) * 72;
            u32x2 wv; wv.x = pk2(-acc[0], -acc[1]); wv.y = pk2(-acc[2], -acc[3]); *(u32x2*)(dst + tt_ * 16 + q4 * 4) = wv;
        }
        __syncthreads();
        {
            const int kind = w >> 1;
            bf16_t* GM = p.GMT + (size_t)u * 4096; bf16_t* QM = p.QMT + (size_t)u * 4096; bf16_t* HM = p.HMB + (size_t)u * 4096; bf16_t* OM = p.OMB + (size_t)u * 4096;
#pragma unroll 1
            for (int rep = 0; rep < 8; ++rep) {
                const int tile = (w & 1) * 8 + rep, rt_ = tile >> 2, ct_ = tile & 3;
                const bf16_t* bmat = (kind < 2) ? sBpT : sArT;
                const bf16_t* amat = (kind == 0 || kind == 2) ? sWn : sU2n;
                f32x4 acc = {0.f, 0.f, 0.f, 0.f};
                if (kind == 0 || kind == 2) {
#pragma unroll
                    for (int ks = 0; ks < 2; ++ks) {
                        const bf16x8 fa = *(const bf16x8*)(amat + (ct_ * 16 + l15) * 72 + ks * 32 + q4 * 8), fb = *(const bf16x8*)(bmat + (rt_ * 16 + l15) * 72 + ks * 32 + q4 * 8);
                        acc = __builtin_amdgcn_mfma_f32_16x16x32_bf16(fa, fb, acc, 0, 0, 0);
                    }
                    const int r = rt_ * 16 + l15, cc = ct_ * 16 + q4 * 4;
                    if (kind == 0) { const float g = gcv[r]; u32x2 wv; wv.x = pk2(g * ((cc == r ? 1.f : 0.f) + acc[0]), g * ((cc + 1 == r ? 1.f : 0.f) + acc[1])); wv.y = pk2(g * ((cc + 2 == r ? 1.f : 0.f) + acc[2]), g * ((cc + 3 == r ? 1.f : 0.f) + acc[3])); *(u32x2*)(GM + r * 64 + cc) = wv; }
                    else { const u32x2 rg = *(const u32x2*)(sRg + r * 72 + cc);
                        u32x2 wv; wv.x = pk2(acc[0] + __uint_as_float(rg.x << 16), acc[1] + __uint_as_float(rg.x & 0xffff0000u)); wv.y = pk2(acc[2] + __uint_as_float(rg.y << 16), acc[3] + __uint_as_float(rg.y & 0xffff0000u)); *(u32x2*)(QM + r * 64 + cc) = wv; }
                } else {
                    const bf16_t* b2 = (kind == 1) ? sKpT : sNrT;
#pragma unroll
                    for (int ks = 0; ks < 2; ++ks) {
                        const bf16x8 fa = *(const bf16x8*)(bmat + (rt_ * 16 + l15) * 72 + ks * 32 + q4 * 8), fb = *(const bf16x8*)(amat + (ct_ * 16 + l15) * 72 + ks * 32 + q4 * 8);
                        acc = __builtin_amdgcn_mfma_f32_16x16x32_bf16(fa, fb, acc, 0, 0, 0);
                        const bf16x8 fa2 = *(const bf16x8*)(b2 + (rt_ * 16 + l15) * 72 + ks * 32 + q4 * 8), fb2 = *(const bf16x8*)(sVT + (ct_ * 16 + l15) * 72 + ks * 32 + q4 * 8);
                        acc = __builtin_amdgcn_mfma_f32_16x16x32_bf16(fa2, fb2, acc, 0, 0, 0);
                    }
                    const int vv = ct_ * 16 + l15, r0 = rt_ * 16 + q4 * 4;
                    if (kind == 1) { const f32x4 g4 = *(const f32x4*)(gcv + r0); acc = acc * g4; }
                    u32x2 wv; wv.x = pk2(acc[0], acc[1]); wv.y = pk2(acc[2], acc[3]);
                    *(u32x2*)((kind == 1 ? HM : OM) + vv * 64 + r0) = wv;
                }
            }
        }
    }
}
#undef RWP_LOAD
__device__ __forceinline__ void phase_rwseq(const Params& p, unsigned char* lds_) {
    MG_LAS unsigned char* lds = (MG_LAS unsigned char*)lds_;
    const int tid = threadIdx.x, lane = tid & 63, w = __builtin_amdgcn_readfirstlane(tid >> 6), q4 = lane >> 4, l15 = lane & 15;
    constexpr int STG = 32768;
    for (int unit = blockIdx.x; unit < 128; unit += gridDim.x) {
        const int h = unit & 7, b = (unit >> 3) & 7, dir = unit >> 6;
        __syncthreads();
        if (w >= 4) {
            const int lw = w - 4;
            const char* base = (const char*)((lw == 0 ? p.GMT : (lw == 1 ? p.QMT : (lw == 2 ? p.HMB : p.OMB))) + (size_t)unit * 68 * 4096);
            int voff[8];
#pragma unroll
            for (int i = 0; i < 8; ++i) { const int r = i * 8 + (lane >> 3); voff[i] = r * 128 + (((lane & 7) ^ ((r >> 1) & 7)) * 16); }
#define RWS_ISSUE(cc) do { _Pragma("unroll") for (int i = 0; i < 8; ++i) \
            __builtin_amdgcn_global_load_lds((const unsigned*)(base + (size_t)(cc) * 8192 + voff[i]), (MG_LAS unsigned*)(lds + ((cc) & 3) * STG + lw * 8192 + i * 1024), 16, 0, 0); } while (0)
            RWS_ISSUE(0); RWS_ISSUE(1); RWS_ISSUE(2);
            asm volatile("s_waitcnt vmcnt(16)" ::: "memory");
            __builtin_amdgcn_s_barrier();
#pragma unroll 1
            for (int c = 0; c < 68; ++c) {
                if (c + 3 < 68) { RWS_ISSUE(c + 3); asm volatile("s_waitcnt vmcnt(16)" ::: "memory"); }
                else asm volatile("s_waitcnt vmcnt(0)" ::: "memory");
                __builtin_amdgcn_s_barrier();
            }
#undef RWS_ISSUE
        } else {
            const int vs = w;
            f32x4 Sacc[4];
#pragma unroll
            for (int t = 0; t < 4; ++t) Sacc[t] = (f32x4){0.f, 0.f, 0.f, 0.f};
            const int sw = l15 >> 1, rowoff = l15 * 128, hb = (q4 & 1) * 8;
            int goff[2][2], hoff[4];
#pragma unroll
            for (int ks = 0; ks < 2; ++ks)
#pragma unroll
                for (int hl = 0; hl < 2; ++hl) goff[ks][hl] = rowoff + (((ks * 4 + hl * 2 + (q4 >> 1)) ^ sw) * 16) + hb;
#pragma unroll
            for (int kt = 0; kt < 4; ++kt) hoff[kt] = vs * 2048 + rowoff + (((kt * 2 + (q4 >> 1)) ^ sw) * 16) + hb;
            asm volatile("" ::: "memory"); __builtin_amdgcn_s_barrier(); asm volatile("" ::: "memory");
#pragma unroll 1
            for (int c = 0; c < 68; ++c) {
                MG_LAS const unsigned char* st = lds + (c & 3) * STG;
                bf16x8 sb[2];
#pragma unroll
                for (int ks = 0; ks < 2; ++ks) sb[ks] = pack8(Sacc[2 * ks], Sacc[2 * ks + 1]);
                if (c >= 4) {
#pragma unroll
                    for (int tt_ = 0; tt_ < 4; ++tt_) {
                        const u32x2 o2 = *(MG_LAS const u32x2*)(st + 3 * 8192 + hoff[tt_]);
                        f32x4 acc = {__uint_as_float(o2.x << 16), __uint_as_float(o2.x & 0xffff0000u), __uint_as_float(o2.y << 16), __uint_as_float(o2.y & 0xffff0000u)};
#pragma unroll
                        for (int ks = 0; ks < 2; ++ks) { const u32x2 lo2 = *(MG_LAS const u32x2*)(st + 8192 + tt_ * 2048 + goff[ks][0]), hi2 = *(MG_LAS const u32x2*)(st + 8192 + tt_ * 2048 + goff[ks][1]);
                            u32x4 a4; a4.x = lo2.x; a4.y = lo2.y; a4.z = hi2.x; a4.w = hi2.y;
                            acc = __builtin_amdgcn_mfma_f32_16x16x32_bf16(__builtin_bit_cast(bf16x8, a4), sb[ks], acc, 0, 0, 0); }
#pragma unroll
                        for (int e = 0; e < 4; ++e) { const int row = row_of(dir, b, c * 64 + tt_ * 16 + q4 * 4 + e); p.O[((size_t)dir * NT + row) * 512 + h * 64 + vs * 16 + l15] = f2bf(acc[e]); }
                    }
                }
#pragma unroll
                for (int kt = 0; kt < 4; ++kt) {
                    const u32x2 h2 = *(MG_LAS const u32x2*)(st + 2 * 8192 + hoff[kt]);
                    f32x4 acc = {__uint_as_float(h2.x << 16), __uint_as_float(h2.x & 0xffff0000u), __uint_as_float(h2.y << 16), __uint_as_float(h2.y & 0xffff0000u)};
#pragma unroll
                    for (int ks = 0; ks < 2; ++ks) { const u32x2 lo2 = *(MG_LAS const u32x2*)(st + kt * 2048 + goff[ks][0]), hi2 = *(MG_LAS const u32x2*)(st + kt * 2048 + goff[ks][1]);
                        u32x4 a4; a4.x = lo2.x; a4.y = lo2.y; a4.z = hi2.x; a4.w = hi2.y;
                        acc = __builtin_amdgcn_mfma_f32_16x16x32_bf16(__builtin_bit_cast(bf16x8, a4), sb[ks], acc, 0, 0, 0); }
                    Sacc[kt] = acc;
                }
                asm volatile("" ::: "memory"); __builtin_amdgcn_s_barrier(); asm volatile("" ::: "memory");
            }
        }
    }
}
__device__ __forceinline__ float red8(float x) { x += DPPF(x, 0xB1, 0xF); x += DPPF(x, 0x4E, 0xF); x += DPPF(x, 0x141, 0xF); return x; }
__device__ __forceinline__ float red16(float x) { x = red8(x); x += DPPF(x, 0x140, 0xF); return x; }
__device__ __forceinline__ float sum4(f32x4 v) { return (v[0] + v[1]) + (v[2] + v[3]); }
__device__ __forceinline__ void phase_readout1(const Params& p) {
    const int lane = threadIdx.x & 63, h = __builtin_amdgcn_readfirstlane(threadIdx.x >> 6);
    const int sub = lane >> 3, ch = h * 64 + (lane & 7) * 8;
    const f32x4 lg0 = *(const f32x4*)(p.rw_ln_g + ch), lg1 = *(const f32x4*)(p.rw_ln_g + ch + 4), lb0 = *(const f32x4*)(p.rw_ln_b + ch), lb1 = *(const f32x4*)(p.rw_ln_b + ch + 4);
    const f32x4 rk0 = *(const f32x4*)(p.rw_r_k + ch), rk1 = *(const f32x4*)(p.rw_r_k + ch + 4);
    u32x4 q[4][6];
#define RO1_LOAD(bi) do { _Pragma("unroll") for (int g = 0; g < 4; ++g) { const unsigned o_ = ((unsigned)(NCTX + (bi) * 32 + g * 8 + sub) * 512u + (unsigned)ch) * 2u; \
        q[g][0] = *(const u32x4*)((const char*)p.O + o_); q[g][1] = *(const u32x4*)((const char*)(p.O + (size_t)NT * 512) + o_); q[g][2] = *(const u32x4*)((const char*)p.RR + o_); q[g][3] = *(const u32x4*)((const char*)p.KP + o_); \
        q[g][4] = *(const u32x4*)((const char*)p.VV + o_); q[g][5] = *(const u32x4*)((const char*)p.GT + o_); } } while (0)
    constexpr int NITR = NLAT / 32;
    if ((int)blockIdx.x < NITR) RO1_LOAD((int)blockIdx.x);
    for (int bi = blockIdx.x; bi < NITR; bi += gridDim.x) {
        bf16x8 outv[4];
#pragma unroll
        for (int g = 0; g < 4; ++g) {
#define LO2(v) ((u32x2){(v).x, (v).y})
#define HI2(v) ((u32x2){(v).z, (v).w})
            const f32x4 a0 = bf4_to_f32(LO2(q[g][0])) + bf4_to_f32(LO2(q[g][1])), a1 = bf4_to_f32(HI2(q[g][0])) + bf4_to_f32(HI2(q[g][1]));
            const float mean = red8(sum4(a0) + sum4(a1)) * (1.f / 64.f);
            const f32x4 d0 = a0 - mean, d1 = a1 - mean;
            const float var = red8(sum4(d0 * d0) + sum4(d1 * d1)) * (1.f / 64.f);
            const float rstd = rsqrtf(var + 64e-5f);
            const f32x4 r0 = bf4_to_f32(LO2(q[g][2])), r1 = bf4_to_f32(HI2(q[g][2])), k0 = bf4_to_f32(LO2(q[g][3])), k1 = bf4_to_f32(HI2(q[g][3]));
            const float bs = red8(sum4(r0 * k0 * rk0) + sum4(r1 * k1 * rk1));
            const f32x4 v0 = bf4_to_f32(LO2(q[g][4])), v1 = bf4_to_f32(HI2(q[g][4])), t0 = bf4_to_f32(LO2(q[g][5])), t1 = bf4_to_f32(HI2(q[g][5]));
            outv[g] = pack8((d0 * rstd * lg0 + lb0 + v0 * bs) * t0, (d1 * rstd * lg1 + lb1 + v1 * bs) * t1);
        }
        asm volatile("" ::: "memory");
        { const int bn = bi + (int)gridDim.x < NITR ? bi + (int)gridDim.x : bi; RO1_LOAD(bn); }
        asm volatile("" ::: "memory");
#pragma unroll
        for (int g = 0; g < 4; ++g) *(bf16x8*)((char*)p.Y + ((unsigned)(NCTX + bi * 32 + g * 8 + sub) * (unsigned)DM + 512u + (unsigned)ch) * 2u) = outv[g];
    }
#undef RO1_LOAD
}

#ifdef PROBE_BUF
__global__ void __launch_bounds__(NTHR) k_probe(Params p) { for (size_t i = (size_t)blockIdx.x * NTHR + threadIdx.x; i < (size_t)NLAT * DM; i += (size_t)gridDim.x * NTHR) {
        float z;
#if PROBE_KIND == 1
        const unsigned q = ((unsigned)i >> 1); z = 0.f; if (q < (unsigned)(NT * 8)) z = (i & 1) ? p.GATE[q] : (float)p.EIDX[q];
#elif PROBE_KIND == 2
        const unsigned q = (unsigned)i; const unsigned ts = q >> 8; z = bf2f(p.ACT[(size_t)p.TOKSLOT[ts] * 256 + (q & 255)]);
#elif PROBE_KIND == 4
        const unsigned q = (unsigned)i; const unsigned ts = q >> 10; z = bf2f(p.YS[((size_t)p.META[0] * 256 + ts) * 1024 + (q & 1023)]);
#elif PROBE_KIND == 6
        const unsigned q = (unsigned)i; const unsigned ts = q >> 8; z = 0.f; if (ts < NT) z = bf2f(p.ACT[((size_t)p.META[0] * 256 + ts) * 256 + (q & 255)]);
#elif PROBE_KIND == 7
        const unsigned q = (unsigned)i; z = 0.f; if (q < 2u * 256u * 1024u) z = p.sh_w2[q]; else if (q < 2u * 256u * 1024u + 2u * 1024u * 512u) z = p.sh_w13[q - 2u * 256u * 1024u];
#elif PROBE_KIND == 5
        const unsigned q = (unsigned)i; const unsigned ts = (q >> 10) * 8 + 3; z = bf2f(p.YS[(size_t)p.TOKSLOT[ts] * 1024 + (q & 1023)]);
#elif PROBE_KIND == 3
        const unsigned q = (unsigned)i; const unsigned ts = q >> 8; z = bf2f(p.YS[(size_t)p.TOKSLOT[ts] * 1024 + (q & 255)]);
#else
        const float* src = (const float*)p.PROBE_BUF; z = src[i + PROBE_OFF];
#endif
        if (!(fabsf(z) < 1e4f)) z = 100.f; p.out[i] = z; } }
#endif

#define XB_TMO      128
#define XB_XCNT(j)  (256  + 64 * (j))
#define XB_XSUB(j)  (1280 + 64 * (j))
#define XB_XGEN(j)  (2304 + 64 * (j))
#define XB_TOP      3328
#define XB_TOPGEN   3392
#define XCD_BAR_WORDS 3456
#define XB_SPIN_CAP (1u << 18)
#define LAS __attribute__((address_space(3)))

__device__ __forceinline__ unsigned xb_ld(unsigned* p)              { return __hip_atomic_load(p, __ATOMIC_RELAXED, __HIP_MEMORY_SCOPE_AGENT); }
__device__ __forceinline__ unsigned xb_add(unsigned* p, unsigned v) { return __hip_atomic_fetch_add(p, v, __ATOMIC_RELAXED, __HIP_MEMORY_SCOPE_AGENT); }
__device__ __forceinline__ unsigned xb_xcc_id() { return (unsigned)__builtin_amdgcn_s_getreg((3 << 11) | 20) & 0xFu; }
#define XB_SPIN(cond, bar) do { unsigned _sp = 0; while (cond) { __builtin_amdgcn_s_sleep(1); \
    if ((++_sp & 255u) == 0u) { if (xb_ld(&(bar)[XB_TMO])) break; if (_sp > XB_SPIN_CAP) { atomicAdd(&(bar)[XB_TMO], 1u); break; } } } } while (0)

struct XcdBarrier {
    unsigned* bar; unsigned x;
    volatile LAS unsigned* st;
};

__device__ __forceinline__ XcdBarrier xcd_barrier_post(unsigned* bar, volatile LAS unsigned* st) {
    XcdBarrier b; b.bar = bar; b.x = xb_xcc_id(); b.st = st;
    if (threadIdx.x == 0) (void)xb_add(&bar[XB_XCNT(b.x)], 1u);
    return b;
}
__device__ __forceinline__ void xcd_barrier_complete(unsigned* bar, unsigned x, unsigned& nloc, unsigned& nx) {
    const unsigned G = gridDim.x * gridDim.y * gridDim.z;
    unsigned sum, cnt, mine, sp = 0u;
    for (;;) {
        sum = 0u; cnt = 0u; mine = 0u;
#pragma unroll
        for (unsigned j = 0; j < 16; ++j) { const unsigned c = xb_ld(&bar[XB_XCNT(j)]); sum += c; cnt += (c > 0u) ? 1u : 0u; mine = (j == x) ? c : mine; }
        if (sum == G) break;
        __builtin_amdgcn_s_sleep(1);
        if ((++sp & 255u) == 0u) { if (xb_ld(&bar[XB_TMO])) break; if (sp > XB_SPIN_CAP) { atomicAdd(&bar[XB_TMO], 1u); break; } }
    }
    nloc = mine > 0u ? mine : 1u; nx = cnt > 0u ? cnt : 1u;
}

__device__ __forceinline__ void xcd_barrier(const XcdBarrier& b) {
    asm volatile("s_waitcnt vmcnt(0)" ::: "memory");
    __syncthreads();
    if (threadIdx.x == 0) {
        unsigned* bar = b.bar;
        __builtin_amdgcn_s_waitcnt(0);
        unsigned nloc = b.st[0], nx = b.st[1];
        if (nloc == 0u) { xcd_barrier_complete(bar, b.x, nloc, nx); b.st[0] = nloc; b.st[1] = nx; }
        const unsigned old = xb_add(&bar[XB_XSUB(b.x)], 1u);
        const unsigned gen = old / nloc;
        if (old + 1u == (gen + 1u) * nloc) {
            __builtin_amdgcn_fence(__ATOMIC_RELEASE, "agent");
            asm volatile("s_waitcnt vmcnt(0)" ::: "memory");
            const unsigned og = xb_add(&bar[XB_TOP], 1u);
            const unsigned tg = og / nx;
            if (og + 1u == (tg + 1u) * nx) xb_add(&bar[XB_TOPGEN], 1u);
            else XB_SPIN(xb_ld(&bar[XB_TOPGEN]) == tg, bar);
            __builtin_amdgcn_fence(__ATOMIC_ACQUIRE, "agent");
            xb_add(&bar[XB_XGEN(b.x)], 1u);
            asm volatile("s_waitcnt vmcnt(0)" ::: "memory");
        } else {
            XB_SPIN(xb_ld(&bar[XB_XGEN(b.x)]) == gen, bar);
            __builtin_amdgcn_fence(__ATOMIC_ACQUIRE, "agent");
            asm volatile("s_waitcnt vmcnt(0)" ::: "memory");
        }
    }
    __syncthreads();
}


__global__ void __launch_bounds__(NTHR, 2) k_fwd(Params p_, int lo, int hi) {
#if defined(__HIP_DEVICE_COMPILE__)
    typedef const __attribute__((address_space(4))) Params* KP;
    const KP kp0 = (KP)__builtin_amdgcn_kernarg_segment_ptr();
#define LOADP KP kq = kp0; asm volatile("" : "+s"(kq)); Params p; __builtin_memcpy(&p, kq, sizeof(Params));
#else
#define LOADP const Params& p = p_;
#endif
    extern __shared__ __attribute__((aligned(16))) unsigned char lds[];
    if (threadIdx.x < 4) ((unsigned*)(lds + 147456))[threadIdx.x] = 0u;
    __syncthreads();
    XcdBarrier bar; bar.bar = nullptr; bar.x = 0; bar.st = nullptr;
#if defined(__HIP_DEVICE_COMPILE__)
    if (hi - lo > 1) bar = xcd_barrier_post((unsigned*)kp0->BAR, (volatile LAS unsigned*)(lds + 147456));
#endif
#define SEAM(k) if (lo <= (k) && (k) + 1 < hi) xcd_barrier(bar);
#ifndef ONLY
#define ONLY -1
#endif
#define IN(k) ((ONLY < 0 || ONLY == (k)) && lo <= (k) && (k) < hi)
#ifndef DUPMASK
#define DUPMASK 0u
#endif
#define PH(k, ...) if (IN(k)) { LOADP __VA_ARGS__ } SEAM(k) if ((DUPMASK >> (k)) & 1u) { xcd_barrier(bar); if (IN(k)) { LOADP __VA_ARGS__ } xcd_barrier(bar); }
    PH(0, if (blockIdx.x == 0) { for (int e = threadIdx.x; e < 512; e += NTHR) p.CNT[e] = 0; if (threadIdx.x < 128) p.META[threadIdx.x] = 0; } phase_mod(p, lds); phase_filt(p, lds); phase_convw(p, lds, 0, blockIdx.x, gridDim.x);)
    PH(2, phase_filtfft(p, lds); phase_hin0(p);)
    PH(1, phase_inproj(p, lds, 0);)
    PH(3, phase_rec0(p, lds);)
    PH(4, phase_readout0(p);)
    PH(5, phase_outproj(p, lds, 0);)
    PH(6, phase_ln1(p, 0);)
    PH(7, phase_router(p, lds, 0);)
    if ((int)gridDim.x <= (NT / 256)) { PH(8, select_range(p, 0, blockIdx.x * 8 + (threadIdx.x >> 6), gridDim.x * 8, NT);) }
    PH(9, phase_offsets(p, lds, 0);)
    PH(10, phase_moe1(p, lds, 0);)
    PH(11, phase_moe2(p, lds, 0);)
    PH(12, phase_combine(p, 0);)
    PH(13, phase_inproj(p, lds, 1);)
    PH(14, phase_shortconv(p, lds);)
    PH(27, phase_rwstreams(p, lds);
           { int u0, u1, ust; const int b = blockIdx.x;
             if (gridDim.x == 256) { u0 = b < 32 ? 3 * b : (b < 192 ? 96 + 9 * (b - 32) : 1536 + 8 * (b - 192)); u1 = u0 + (b < 32 ? 3 : (b < 192 ? 9 : 8)); ust = 1; }
             else { u0 = b; u1 = 2048; ust = gridDim.x; }
             phase_hyena(p, lds, u0, u1, ust); })
    PH(16, phase_rwprep(p, lds);)
    PH(17, if (blockIdx.x >= 128 && gridDim.x > 128) phase_convw_r(p, lds, 1, 0, conv_count(1) - RWSEQ_CONV, blockIdx.x - 128, gridDim.x - 128);
           else { phase_rwseq(p, lds); __syncthreads(); if (gridDim.x <= 128) phase_convw(p, lds, 1, blockIdx.x, gridDim.x); else phase_convw_r(p, lds, 1, conv_count(1) - RWSEQ_CONV, RWSEQ_CONV, blockIdx.x, 128); })
    PH(18, phase_readout1(p); phase_zt2y(p, lds);)
    PH(19, phase_outproj(p, lds, 1);)
    PH(20, phase_ln1(p, 1);)
    PH(21, phase_router(p, lds, 1);)
    if ((int)gridDim.x <= (NLAT / 256)) { PH(22, select_range(p, 1, blockIdx.x * 8 + (threadIdx.x >> 6), gridDim.x * 8, NLAT);) }
    PH(23, phase_offsets(p, lds, 1);)
    PH(24, phase_moe1(p, lds, 1);)
    PH(25, phase_moe2(p, lds, 1);)
    PH(26, phase_combine(p, 1);)
#undef IN
}
#define N_PHASES 28
#define LDS_BYTES (147456 + 64)

extern "C" void kernel_launch(void* const* d_in, const int* in_sizes, int n_in, void* d_out, int out_size, void* d_ws, size_t ws_size, hipStream_t stream) {
    Params p;
    memset(&p, 0, sizeof(p));
    if (n_in != 45) { fprintf(stderr, "kernel_launch: expected 45 inputs, got %d\n", n_in); return; }
    const float** pin = (const float**)&p;
    for (int i = 0; i < 45; ++i) pin[i] = (const float*)d_in[i];
    p.out = (float*)d_out;
    size_t off = 0;
    unsigned char* ws = (unsigned char*)d_ws;
    auto take = [&](size_t bytes) { void* r = ws + off; off += (bytes + 255) & ~(size_t)255; return r; };
    p.BAR = (unsigned*)take(16384);
    p.CNT = (int*)take(2 * 256 * 4);
    p.META = (int*)take(2 * 64 * 4);
    const size_t zero_bytes = off;
    p.MOD = (float*)take((size_t)2 * 9 * 6144 * 4);
    p.G = (float*)take((size_t)2 * 8192 * 512 * 4);
    p.P = (bf16_t*)take((size_t)NT * EVW * 4);
    p.LA = nullptr;
    p.O = (bf16_t*)take((size_t)2 * NT * 1024 * 2);
    p.Y = (bf16_t*)take((size_t)NT * 1024 * 2);
    p.PRE = (bf16_t*)take((size_t)NT * 1024 * 2);
    p.X1 = (bf16_t*)take((size_t)NT * 1024 * 2);
    p.U = (bf16_t*)take((size_t)NT * 1024 * 2);
    p.LOGITS = (float*)take((size_t)NT * 256 * 4);
    p.EIDX = (int*)take((size_t)NT * 8 * 4); p.GATE = (float*)take((size_t)NT * 8 * 4); p.POS = (int*)take((size_t)NT * 8 * 4); p.TOKSLOT = (int*)take((size_t)NT * 8 * 4);
    p.TILE_E = (int*)take(2048 * 4);
    p.SLOT_TOK = (int*)take((size_t)MAXSLOT * 4); p.SLOT_GATE = (float*)take((size_t)MAXSLOT * 4);
    unsigned char* regA = (unsigned char*)take((size_t)MAXSLOT * 1024 * 2 + (size_t)MAXSLOT * 256 * 2);
    p.YS = (bf16_t*)regA; p.ACT = (bf16_t*)(regA + (size_t)MAXSLOT * 1024 * 2);
    { size_t o2 = 0; auto sub = [&](size_t bytes) { void* r = regA + o2; o2 += (bytes + 255) & ~(size_t)255; return r; };
      p.UH = (bf16_t*)sub((size_t)NLAT * 1536 * 2); p.Z1 = (bf16_t*)sub((size_t)NLAT * 512 * 2);
      p.RR = (bf16_t*)sub((size_t)NT * 512 * 2); p.KP = (bf16_t*)sub((size_t)NT * 512 * 2); p.VV = (bf16_t*)sub((size_t)NT * 512 * 2);
      p.KK = (bf16_t*)sub((size_t)NT * 512 * 2); p.BV = (bf16_t*)sub((size_t)NT * 512 * 2); p.GT = (bf16_t*)sub((size_t)NT * 512 * 2);
      p.DEC = (bf16_t*)sub((size_t)2 * NT * 512 * 2);
      if (o2 > (size_t)MAXSLOT * 1024 * 2 + (size_t)MAXSLOT * 256 * 2) { fprintf(stderr, "kernel_launch: region A overflow\n"); return; } }
    { unsigned char* rp = (unsigned char*)p.P; p.GMT = (bf16_t*)rp; p.QMT = (bf16_t*)(rp + (size_t)RW_NUNIT * 4096 * 2); p.HMB = (bf16_t*)(rp + (size_t)RW_NUNIT * 4096 * 4); p.OMB = (bf16_t*)(rp + (size_t)RW_NUNIT * 4096 * 6); }
    p.X2 = (bf16_t*)take((size_t)NT * 1024 * 2);
    p.FF = (f32x2_p)take((size_t)2 * 512 * 8192 * 8);
    p.HIN = (bf16_t*)take((size_t)NT * 1024 * 2);
    p.ACT_SH = (bf16_t*)take((size_t)NT * 256 * 2);
    p.WT_EVIN = (bf16_t*)take((size_t)4352 * 1024 * 2); p.WT_EVOUT = (bf16_t*)take((size_t)1024 * 1024 * 2);
    p.WT_ODIN = (bf16_t*)take((size_t)3584 * 1024 * 2); p.WT_ODOUT = (bf16_t*)take((size_t)1024 * 1024 * 2);
    p.WT_ROUT = (bf16_t*)take((size_t)2 * 256 * 1024 * 2); p.WT_SH13 = (bf16_t*)take((size_t)2 * 512 * 1024 * 2); p.WT_SH2 = (bf16_t*)take((size_t)2 * 1024 * 256 * 2);
    p.WT_RWF = (bf16_t*)take(512 * 64 * 2); p.WT_RWB = (bf16_t*)take(512 * 64 * 2); p.WT_RWA = (bf16_t*)take(512 * 64 * 2); p.WT_RWG = (bf16_t*)take(512 * 128 * 2);
    p.WT_W13 = (bf16_t*)take((size_t)2 * 256 * 512 * 1024 * 2); p.WT_W2 = (bf16_t*)take((size_t)2 * 256 * 1024 * 256 * 2);
    if (off > ws_size) { fprintf(stderr, "kernel_launch: workspace too small: need %zu, have %zu\n", off, ws_size); return; }
    static bool attr_done = false;
    if (!attr_done) { (void)hipFuncSetAttribute((const void*)k_fwd, hipFuncAttributeMaxDynamicSharedMemorySize, LDS_BYTES); attr_done = true; }
    (void)hipMemsetAsync(d_ws, 0, zero_bytes, stream);
#ifdef PROBE_BUF
    for (int ph = 0; ph <= PROBE_UPTO; ++ph) hipLaunchKernelGGL(k_fwd, dim3(256), dim3(NTHR), LDS_BYTES, stream, p, ph, ph + 1);
    hipLaunchKernelGGL(k_fwd, dim3(256), dim3(NTHR), LDS_BYTES, stream, p, 98, 99);
    hipLaunchKernelGGL(k_fwd, dim3(256), dim3(NTHR), LDS_BYTES, stream, p, 98, 99);
    hipLaunchKernelGGL(k_probe, dim3(1024), dim3(NTHR), 0, stream, p);
#else
#ifdef MULTI_LAUNCH
    for (int ph = 0; ph < N_PHASES; ++ph) {
        hipLaunchKernelGGL(k_fwd, dim3(256), dim3(NTHR), LDS_BYTES, stream, p, ph, ph + 1);
    }
#else
    static int grid = 0;
    if (grid == 0) {
        int dev = 0, cus = 0, per_cu = 0;
        (void)hipGetDevice(&dev); (void)hipDeviceGetAttribute(&cus, hipDeviceAttributeMultiprocessorCount, dev);
        if (hipOccupancyMaxActiveBlocksPerMultiprocessor(&per_cu, (const void*)k_fwd, NTHR, LDS_BYTES) != hipSuccess || per_cu < 1) { fprintf(stderr, "kernel_launch: occupancy query says %d blocks per CU\n", per_cu); per_cu = 1; }
        (void)hipGetLastError();
        grid = cus > 0 ? cus : 256;
    }
    hipLaunchKernelGGL(k_fwd, dim3(grid), dim3(NTHR), LDS_BYTES, stream, p, 0, N_PHASES);
#endif
#endif
}
```
